# Optimizing an MI355X kernel written in HIP

```python
import math
import jax, jax.numpy as jnp
from jax import lax
import numpy as np

D_MODEL = 1024
BATCH = 16
SEQ = 2048
DEPTH = 2
DEC_BATCH = 32
DEC_SEQ = 64
PAST_LEN = 2048

CHUNK = 64
PREV_CHUNKS = 8
BAND_PREV = PREV_CHUNKS * CHUNK
BAND = BAND_PREV + CHUNK
MAX_REL = 128
N_REL = 2 * MAX_REL + 1
HA = 8
DA = 64
HB = 4
DB = 64
EB = 2 * DB
GROUP_W = HA * DA
MIX_W = 2 * GROUP_W
D_IN = 6 * GROUP_W
D_FF = 2816
Q_BLOCK = 128
ROPE_THETA = 10000.0
EPS = 1e-6
NEG = -1e30

kernel_name = "hybrid_chunkband_diffattn_macaron_step"


def rms_norm(x, g):
    xf = x.astype(jnp.float32)
    y = xf * lax.rsqrt(jnp.mean(xf * xf, axis=-1, keepdims=True) + EPS)
    return (y * g.astype(jnp.float32)).astype(x.dtype)


def rope(x, pos):
    d = x.shape[-1]
    half = d // 2
    inv = ROPE_THETA ** (-jnp.arange(half, dtype=jnp.float32) * 2.0 / d)
    ang = pos.astype(jnp.float32)[:, None] * inv[None, :]
    cos = jnp.cos(ang)[:, None, :]
    sin = jnp.sin(ang)[:, None, :]
    xf = x.astype(jnp.float32)
    x1, x2 = xf[..., :half], xf[..., half:]
    return jnp.concatenate([x1 * cos - x2 * sin, x2 * cos + x1 * sin], axis=-1).astype(x.dtype)


def ffn_half(x, g, w_gate, w_up, w_down):
    h = rms_norm(x, g)
    a = jax.nn.silu(jnp.einsum('bsd,df->bsf', h, w_gate)) * jnp.einsum('bsd,df->bsf', h, w_up)
    return x + 0.5 * jnp.einsum('bsf,fd->bsd', a, w_down)


def project(h, w_in, g_qa, g_ka, g_qb, g_kb, pos):
    b, s, _ = h.shape
    z = jnp.einsum('bsd,de->bse', h, w_in)
    qa, ka, va, qb, kb, vb = jnp.split(z, 6, axis=-1)
    qa = rms_norm(qa.reshape(b, s, HA, DA), g_qa)
    ka = rms_norm(ka.reshape(b, s, HA, DA), g_ka)
    va = va.reshape(b, s, HA, DA)
    qb = rope(rms_norm(qb.reshape(b, s, 2 * HB, DB), g_qb), pos).reshape(b, s, HB, 2, DB)
    kb = rope(rms_norm(kb.reshape(b, s, 2 * HB, DB), g_kb), pos).reshape(b, s, HB, 2, DB)
    vb = vb.reshape(b, s, HB, EB)
    return qa, ka, va, qb, kb, vb


def rel_bias_lookup(table, qpos, kpos):
    idx = jnp.clip(qpos[:, None] - kpos[None, :], -MAX_REL, MAX_REL) + MAX_REL
    return table[:, idx]


def band_core(q, k, v, bias, valid):
    s = jnp.einsum('bqhd,bkhd->bhqk', q, k).astype(jnp.float32) * (DA ** -0.5)
    s = s + bias[None].astype(jnp.float32)
    s = jnp.where(valid[None, None, None, :], s, NEG)
    p = jax.nn.softmax(s, axis=-1).astype(v.dtype)
    return jnp.einsum('bhqk,bkhd->bqhd', p, v)


def band_attn_prompt(q, k, v, bias):
    b, s, h, d = q.shape
    nc = s // CHUNK
    pad = ((0, 0), (BAND_PREV, 0), (0, 0), (0, 0))
    kp = jnp.pad(k, pad)
    vp = jnp.pad(v, pad)
    qc = jnp.moveaxis(q.reshape(b, nc, CHUNK, h, d), 1, 0)
    rows = jnp.arange(BAND)

    def one_chunk(args):
        c, qch = args
        start = c * CHUNK
        kband = lax.dynamic_slice_in_dim(kp, start, BAND, axis=1)
        vband = lax.dynamic_slice_in_dim(vp, start, BAND, axis=1)
        valid = rows >= BAND_PREV - start
        return band_core(qch, kband, vband, bias, valid)

    out = lax.map(one_chunk, (jnp.arange(nc), qc))
    return jnp.moveaxis(out, 0, 1).reshape(b, s, h * d)


def diff_core(q, k, v, mask, lam):
    s = jnp.einsum('bqhmd,bkhmd->bhmqk', q, k).astype(jnp.float32) * (DB ** -0.5)
    s = jnp.where(mask[None, None, None], s, NEG)
    p = jax.nn.softmax(s, axis=-1)
    a = p[:, :, 0] - lam * p[:, :, 1]
    return jnp.einsum('bhqk,bkhe->bqhe', a.astype(v.dtype), v)


def diff_attn_prompt(q, k, v, lam):
    b, s = q.shape[0], q.shape[1]
    nb = s // Q_BLOCK
    qblk = jnp.moveaxis(q.reshape(b, nb, Q_BLOCK, HB, 2, DB), 1, 0)
    kchunk = jnp.arange(s) // CHUNK

    def one_block(args):
        i, qb = args
        qchunk = (i * Q_BLOCK + jnp.arange(Q_BLOCK)) // CHUNK
        mask = kchunk[None, :] <= qchunk[:, None]
        return diff_core(qb, k, v, mask, lam)

    out = lax.map(one_block, (jnp.arange(nb), qblk))
    return jnp.moveaxis(out, 0, 1).reshape(b, s, HB, EB)


def diff_post(o, g_sub, lam_init):
    b, s = o.shape[0], o.shape[1]
    return (rms_norm(o, g_sub) * (1.0 - lam_init)).reshape(b, s, HB * EB)


def out_proj(oa, ob, w_out):
    return jnp.einsum('bse,ed->bsd', jnp.concatenate([oa, ob], axis=-1), w_out)


def setup_inputs(seed: int = 0) -> dict:
    key = jax.random.key(seed)
    ks = jax.random.split(key, 32)
    f = jnp.float32
    nrm = lambda k, shape, scale: jax.random.normal(k, shape, f) * scale
    gain = lambda k, shape: 1.0 + 0.02 * jax.random.normal(k, shape, f)
    a_len = min(BAND_PREV, PAST_LEN)
    return {
        'x_prompt': nrm(ks[0], (BATCH, SEQ, D_MODEL), 1.0),
        'x_sample': nrm(ks[1], (DEC_BATCH, DEC_SEQ, D_MODEL), 1.0),
        'cache_a_k': nrm(ks[2], (DEPTH, DEC_BATCH, a_len, HA, DA), 1.0),
        'cache_a_v': nrm(ks[3], (DEPTH, DEC_BATCH, a_len, HA, DA), 1.0),
        'cache_b_k': nrm(ks[4], (DEPTH, DEC_BATCH, PAST_LEN, HB, EB), 1.0),
        'cache_b_v': nrm(ks[5], (DEPTH, DEC_BATCH, PAST_LEN, HB, EB), 1.0),
        'g_ffn1': gain(ks[6], (DEPTH, D_MODEL)),
        'w1_gate': nrm(ks[7], (DEPTH, D_MODEL, D_FF), D_MODEL ** -0.5),
        'w1_up': nrm(ks[8], (DEPTH, D_MODEL, D_FF), D_MODEL ** -0.5),
        'w1_down': nrm(ks[9], (DEPTH, D_FF, D_MODEL), D_FF ** -0.5),
        'g_mix': gain(ks[10], (DEPTH, D_MODEL)),
        'w_in': nrm(ks[11], (DEPTH, D_MODEL, D_IN), D_MODEL ** -0.5),
        'g_qa': gain(ks[12], (DEPTH, DA)),
        'g_ka': gain(ks[13], (DEPTH, DA)),
        'g_qb': gain(ks[14], (DEPTH, DB)),
        'g_kb': gain(ks[15], (DEPTH, DB)),
        'rel_bias': nrm(ks[16], (DEPTH, HA, N_REL), 0.1),
        'lam_q1': nrm(ks[17], (DEPTH, DB), 0.1),
        'lam_k1': nrm(ks[18], (DEPTH, DB), 0.1),
        'lam_q2': nrm(ks[19], (DEPTH, DB), 0.1),
        'lam_k2': nrm(ks[20], (DEPTH, DB), 0.1),
        'g_sub': gain(ks[21], (DEPTH, EB)),
        'w_out': nrm(ks[22], (DEPTH, MIX_W, D_MODEL), MIX_W ** -0.5),
        'g_ffn2': gain(ks[23], (DEPTH, D_MODEL)),
        'w2_gate': nrm(ks[24], (DEPTH, D_MODEL, D_FF), D_MODEL ** -0.5),
        'w2_up': nrm(ks[25], (DEPTH, D_MODEL, D_FF), D_MODEL ** -0.5),
        'w2_down': nrm(ks[26], (DEPTH, D_FF, D_MODEL), D_FF ** -0.5),
    }


def reference(x_prompt, x_sample, cache_a_k, cache_a_v, cache_b_k, cache_b_v,
              g_ffn1, w1_gate, w1_up, w1_down, g_mix, w_in, g_qa, g_ka, g_qb, g_kb,
              rel_bias, lam_q1, lam_k1, lam_q2, lam_k2, g_sub, w_out,
              g_ffn2, w2_gate, w2_up, w2_down):
    bp, s = x_prompt.shape[0], x_prompt.shape[1]
    bd, t = x_sample.shape[0], x_sample.shape[1]
    past = cache_b_k.shape[2]
    a_len = cache_a_k.shape[2]
    keep_p = min(BAND_PREV, s)

    pos_p = jnp.arange(s)
    pos_s = past + jnp.arange(t)
    band_q = BAND_PREV + jnp.arange(CHUNK)
    band_k = jnp.arange(BAND)
    kpos_a = jnp.concatenate([past - a_len + jnp.arange(a_len), pos_s])
    valid_s = jnp.ones((a_len + t,), dtype=bool)
    mask_s = jnp.ones((t, past + t), dtype=bool)

    yp, ys = x_prompt, x_sample
    pak, pav, pbk, pbv, sak, sav, sbk, sbv = [], [], [], [], [], [], [], []
    for l in range(DEPTH):
        lam_init = 0.8 - 0.6 * math.exp(-0.3 * l)
        lam = (jnp.exp(jnp.sum(lam_q1[l].astype(jnp.float32) * lam_k1[l].astype(jnp.float32)))
               - jnp.exp(jnp.sum(lam_q2[l].astype(jnp.float32) * lam_k2[l].astype(jnp.float32)))
               + lam_init)

        yp = ffn_half(yp, g_ffn1[l], w1_gate[l], w1_up[l], w1_down[l])
        qa, ka, va, qb, kb, vb = project(rms_norm(yp, g_mix[l]), w_in[l], g_qa[l], g_ka[l], g_qb[l], g_kb[l], pos_p)
        oa = band_attn_prompt(qa, ka, va, rel_bias_lookup(rel_bias[l], band_q, band_k))
        ob = diff_post(diff_attn_prompt(qb, kb, vb, lam), g_sub[l], lam_init)
        yp = yp + out_proj(oa, ob, w_out[l])
        yp = ffn_half(yp, g_ffn2[l], w2_gate[l], w2_up[l], w2_down[l])
        pak.append(ka[:, s - keep_p:])
        pav.append(va[:, s - keep_p:])
        pbk.append(kb.reshape(bp, s, HB, EB))
        pbv.append(vb)

        ys = ffn_half(ys, g_ffn1[l], w1_gate[l], w1_up[l], w1_down[l])
        qa, ka, va, qb, kb, vb = project(rms_norm(ys, g_mix[l]), w_in[l], g_qa[l], g_ka[l], g_qb[l], g_kb[l], pos_s)
        ka_all = jnp.concatenate([cache_a_k[l], ka], axis=1)
        va_all = jnp.concatenate([cache_a_v[l], va], axis=1)
        oa = band_core(qa, ka_all, va_all, rel_bias_lookup(rel_bias[l], pos_s, kpos_a), valid_s).reshape(bd, t, GROUP_W)
        kb_all = jnp.concatenate([cache_b_k[l].reshape(bd, past, HB, 2, DB), kb], axis=1)
        vb_all = jnp.concatenate([cache_b_v[l], vb], axis=1)
        ob = diff_post(diff_core(qb, kb_all, vb_all, mask_s, lam), g_sub[l], lam_init)
        ys = ys + out_proj(oa, ob, w_out[l])
        ys = ffn_half(ys, g_ffn2[l], w2_gate[l], w2_up[l], w2_down[l])
        sak.append(ka)
        sav.append(va)
        sbk.append(kb.reshape(bd, t, HB, EB))
        sbv.append(vb)

    return (yp, ys,
            jnp.stack(pak), jnp.stack(pav), jnp.stack(pbk), jnp.stack(pbv),
            jnp.stack(sak), jnp.stack(sav), jnp.stack(sbk), jnp.stack(sbv))
```

```cpp
#include <hip/hip_runtime.h>
#include <hip/hip_cooperative_groups.h>
#include <cstdio>
#include <cstdint>
#include <cstddef>
namespace cg = cooperative_groups;
__device__ __forceinline__ int lane_id_fresh() { int l; asm volatile("v_mbcnt_lo_u32_b32 %0, -1, 0\n\tv_mbcnt_hi_u32_b32 %0, -1, %0" : "=v"(l)); return l; }
#ifndef PG8_PFD
#define PG8_PFD 4
#endif
namespace pg8 {
#define PG8_LAS __attribute__((address_space(3)))
typedef unsigned short bf16_t;
typedef short bf16x8 __attribute__((ext_vector_type(8)));
typedef float f32x4 __attribute__((ext_vector_type(4)));
typedef unsigned u32x4 __attribute__((ext_vector_type(4)));
constexpr int BM = 256, BK = 64, HALF = 128, HTB = HALF * BK * 2  , STAGE_BYTES = 8 * HTB, NXCD = 8, WGM = 8;

__host__ __device__ __forceinline__ int lds_byte(int r, int c) { const int st = (r >> 4) * 2 + (c >> 5), rr = r & 15, cc = c & 31, ob = rr * 64 + cc * 2; return st * 1024 + (ob ^ (((ob >> 9) & 1) << 5)); }
__host__ __device__ __forceinline__ void stage_rc(int b, int& R, int& C) { const int st = b / 1024, sb = b % 1024, swz = sb ^ (((sb >> 9) & 1) << 5); R = (st >> 1) * 16 + swz / 64; C = (st & 1) * 32 + (swz % 64) / 2; }
__host__ __device__ __forceinline__ int perm32(int rho) { const int n = rho >> 4, i = rho & 15; return 8 * (i >> 2) + 4 * n + (i & 3); }

struct Unit { int pm, pn, hm; };
struct Gemm { const bf16_t* A; const bf16_t* Bt; int M, N, K, ld; int blocked; };

struct StaticOrder {
    int nM, nN, nwg, G, c, rev, wgm;
    __host__ __device__ void init(int M, int N, int G_, int c_, int rev_ = 0, int wgm_ = WGM) { nM = M / BM; nN = N / BM; nwg = nM * nN; G = G_; c = c_; rev = rev_; wgm = wgm_; }
    __host__ __device__ __forceinline__ void tile(int wgid, Unit& u) const {
        { const int q = nwg / NXCD, r = nwg % NXCD, xcd = wgid % NXCD, off = wgid / NXCD; wgid = (xcd < r ? xcd * (q + 1) : r * (q + 1) + (xcd - r) * q) + off; }
        const int nig = wgm * nN, gid = wgid / nig, fm = gid * wgm, gsz = (nM - fm) < wgm ? (nM - fm) : wgm;
        u.pm = fm + ((wgid % nig) % gsz); u.pn = (wgid % nig) / gsz; u.hm = 3;
        if (rev) u.pm = nM - 1 - u.pm;
    }
    __host__ __device__ bool next(int i, Unit& u) const {
        const long L = (long)i * G + c; if (L >= nwg) return false;
        tile((int)L, u); return true;
    }
    __device__ __forceinline__ void a_ready(const Unit&) const {}
    __device__ __forceinline__ void done(const Unit&) const {}
};
struct TailSplitOrder : StaticOrder {
    __host__ __device__ bool next(int i, Unit& u) const {
        const int nfull = (nwg / G) * G, L = i * G + c;
        if (L < nfull) { tile(L, u); return true; }
        const int idx = L - nfull;
        if (idx >= 2 * (nwg - nfull)) return false;
        tile(nfull + (idx >> 1), u); u.hm = 1 << (idx & 1); return true;
    }
};

__device__ __forceinline__ unsigned cvt_pk_bf16(float lo, float hi) { unsigned r; asm volatile("v_cvt_pk_bf16_f32 %0, %1, %2" : "=v"(r) : "v"(lo), "v"(hi)); return r; }
typedef float f32x2 __attribute__((ext_vector_type(2)));
template <class Epi, class Sched, bool ALIGN_EPI = false, bool SP2 = false>
__device__ __forceinline__ void gemm_phase(PG8_LAS unsigned char* lds, const Gemm g, const Sched& S, const Epi& E, int wave_in) {
    int tid_l = wave_in * 64 + lane_id_fresh(); asm volatile("" : "+v"(tid_l));
    const int tid = tid_l, wid = __builtin_amdgcn_readfirstlane(tid >> 6), lane = tid & 63, wr = wid >> 2, wc = wid & 3, fr = lane & 15, fq = lane >> 4;
    const int nt = g.K / BK, K = g.blocked ? BK : g.ld;
    unsigned voffA[2], voffB[2];
#pragma unroll
    for (int i = 0; i < 2; ++i) { int R, C; stage_rc(tid * 16 + i * 8192, R, C); const int Rb = Epi::PERM ? ((R & ~31) + perm32(R & 31)) : R;
        voffA[i] = (unsigned)(R * K + C) * 2u; voffB[i] = (unsigned)(Rb * K + C) * 2u; }
    const size_t kstep = g.blocked ? (size_t)(BM * BK * 2) : (size_t)(BK * 2);
    const size_t hstep = (size_t)HALF * K * 2;
    const size_t tstep = g.blocked ? (size_t)nt * (BM * BK * 2) : 2 * hstep;
    const unsigned ldsw = (unsigned)wid * 1024u;
    const int aoff = lds_byte(wr * 64 + fr, fq * 8), boff = lds_byte(wc * 32 + fr, fq * 8);
#define PG8_SA(b, h) (((b) * 2 + (h)) * HTB)
#define PG8_SB(b, h) ((4 + (b) * 2 + (h)) * HTB)
#define PG8_STAGE(bufoff, gbase, voff) do { _Pragma("unroll") for (int _i = 0; _i < 2; ++_i) \
        __builtin_amdgcn_global_load_lds((const unsigned*)((const char*)(gbase) + (voff)[_i]), (PG8_LAS unsigned*)(lds + (bufoff) + ldsw + _i * 8192), 16, 0, 0); } while (0)
#define PG8_LDA(dst, b, h) do { _Pragma("unroll") for (int m = 0; m < 4; ++m) _Pragma("unroll") for (int k = 0; k < 2; ++k) dst[m][k] = *(const PG8_LAS bf16x8*)(lds + PG8_SA(b, h) + aoff + m * 2048 + k * 1024); } while (0)
#define PG8_LDB(dst, b, h) do { _Pragma("unroll") for (int n = 0; n < 2; ++n) _Pragma("unroll") for (int k = 0; k < 2; ++k) dst[n][k] = *(const PG8_LAS bf16x8*)(lds + PG8_SB(b, h) + boff + n * 2048 + k * 1024); } while (0)
#define PG8_MMA(ai, bj, At, Bt) do { __builtin_amdgcn_s_setprio(1); _Pragma("unroll") for (int m = 0; m < 4; ++m) _Pragma("unroll") for (int n = 0; n < 2; ++n) _Pragma("unroll") for (int k = 0; k < 2; ++k) \
        acc[ai][bj][m][n] = __builtin_amdgcn_mfma_f32_16x16x32_bf16(Bt[n][k], At[m][k], acc[ai][bj][m][n], 0, 0, 0); __builtin_amdgcn_s_setprio(0); } while (0)
#define PG8_WAIT_V(n) asm volatile("s_waitcnt vmcnt(" #n ")" ::: "memory")
#define PG8_WAIT_L(n) asm volatile("s_waitcnt lgkmcnt(" #n ")" ::: "memory")
#define PG8_BAR __builtin_amdgcn_s_barrier()
#define PG8_SCHED __builtin_amdgcn_sched_barrier(0)
    Unit cur, nxt; int ui = 0;
    if (!S.next(0, cur)) return;
    f32x4 acc[2][2][4][2];
#pragma unroll
    for (int a = 0; a < 2; ++a)
#pragma unroll
        for (int b = 0; b < 2; ++b)
#pragma unroll
            for (int m = 0; m < 4; ++m)
#pragma unroll
                for (int n = 0; n < 2; ++n) acc[a][b][m][n] = (f32x4){0.f, 0.f, 0.f, 0.f};
    bf16x8 At[4][2], B0[2][2], B1[2][2];
    const char* cA = (const char*)g.A + (size_t)cur.pm * tstep; const char* cB = (const char*)g.Bt + (size_t)cur.pn * tstep;
    S.a_ready(cur);
    if constexpr (SP2) {
        PG8_STAGE(PG8_SB(0, 0), cB, voffB); PG8_STAGE(PG8_SB(0, 1), cB + hstep, voffB); PG8_STAGE(PG8_SA(0, 0), cA, voffA); PG8_STAGE(PG8_SA(0, 1), cA + hstep, voffA);
        if (wr == 1) PG8_BAR;
        PG8_WAIT_V(2); PG8_BAR;
        PG8_STAGE(PG8_SB(1, 0), cB + kstep, voffB); PG8_STAGE(PG8_SA(1, 0), cA + kstep, voffA); PG8_STAGE(PG8_SB(1, 1), cB + hstep + kstep, voffB);
        PG8_WAIT_V(6); PG8_BAR;
    } else {
        PG8_STAGE(PG8_SB(0, 0), cB, voffB); PG8_STAGE(PG8_SA(0, 0), cA, voffA); PG8_STAGE(PG8_SB(0, 1), cB + hstep, voffB); PG8_STAGE(PG8_SA(0, 1), cA + hstep, voffA);
        if (wr == 1) PG8_BAR;
        PG8_WAIT_V(4); PG8_BAR;
        PG8_STAGE(PG8_SB(1, 0), cB + kstep, voffB); PG8_STAGE(PG8_SA(1, 0), cA + kstep, voffA); PG8_STAGE(PG8_SB(1, 1), cB + hstep + kstep, voffB);
        PG8_WAIT_V(6); PG8_BAR;
    }
    for (;;) {
        const bool has_next = S.next(ui + 1, nxt);
        const char* nA = has_next ? (const char*)g.A + (size_t)nxt.pm * tstep : cA; const char* nB = has_next ? (const char*)g.Bt + (size_t)nxt.pn * tstep : cB;
        for (int t = 0; t < nt; t += 2) {
            const bool last = (t == nt - 2);
            const char* a1 = cA + (size_t)(t + 1) * kstep;
            const char* a2 = last ? nA : cA + (size_t)(t + 2) * kstep; const char* b2 = last ? nB : cB + (size_t)(t + 2) * kstep;
            const char* a3 = a2 + kstep; const char* b3 = b2 + kstep;
            if (last && has_next) S.a_ready(nxt);
            if constexpr (SP2) {
            PG8_LDB(B0, 0, 0); PG8_LDB(B1, 0, 1); PG8_SCHED; PG8_LDA(At, 0, 0); PG8_STAGE(PG8_SA(1, 1), a1 + hstep, voffA);
            PG8_WAIT_V(8); PG8_WAIT_L(0); PG8_BAR; if (cur.hm & 1) { PG8_MMA(0, 0, At, B0); PG8_MMA(0, 1, At, B1); } PG8_BAR; PG8_SCHED;
            PG8_LDA(At, 0, 1); PG8_STAGE(PG8_SB(0, 0), b2, voffB); PG8_STAGE(PG8_SB(0, 1), b2 + hstep, voffB); PG8_STAGE(PG8_SA(0, 0), a2, voffA);
            PG8_WAIT_V(8); PG8_WAIT_L(0); PG8_BAR; if (cur.hm & 2) { PG8_MMA(1, 0, At, B0); PG8_MMA(1, 1, At, B1); } PG8_BAR; PG8_SCHED;
            PG8_LDB(B0, 1, 0); PG8_LDB(B1, 1, 1); PG8_SCHED; PG8_LDA(At, 1, 0); PG8_STAGE(PG8_SA(0, 1), a2 + hstep, voffA);
            PG8_WAIT_V(8); PG8_WAIT_L(0); PG8_BAR; if (cur.hm & 1) { PG8_MMA(0, 0, At, B0); PG8_MMA(0, 1, At, B1); } PG8_BAR; PG8_SCHED;
            PG8_LDA(At, 1, 1); PG8_STAGE(PG8_SB(1, 0), b3, voffB); PG8_STAGE(PG8_SB(1, 1), b3 + hstep, voffB); PG8_STAGE(PG8_SA(1, 0), a3, voffA);
            PG8_WAIT_V(8); PG8_WAIT_L(0); PG8_BAR; if (cur.hm & 2) { PG8_MMA(1, 0, At, B0); PG8_MMA(1, 1, At, B1); } PG8_BAR; PG8_SCHED;
            } else {
            PG8_LDB(B0, 0, 0); PG8_SCHED; PG8_LDA(At, 0, 0); PG8_STAGE(PG8_SA(1, 1), a1 + hstep, voffA);
            PG8_WAIT_L(8); PG8_BAR; PG8_WAIT_L(0); PG8_MMA(0, 0, At, B0); PG8_BAR; PG8_SCHED;
            PG8_LDB(B1, 0, 1); PG8_STAGE(PG8_SB(0, 0), b2, voffB);
            PG8_BAR; PG8_WAIT_L(0); PG8_MMA(0, 1, At, B1); PG8_BAR;
            PG8_LDA(At, 0, 1); PG8_STAGE(PG8_SA(0, 0), a2, voffA);
            PG8_BAR; PG8_WAIT_L(0); PG8_MMA(1, 0, At, B0); PG8_BAR; PG8_SCHED;
            PG8_STAGE(PG8_SB(0, 1), b2 + hstep, voffB);
            PG8_WAIT_V(6); PG8_BAR; PG8_MMA(1, 1, At, B1); PG8_BAR;
            PG8_LDB(B0, 1, 0); PG8_SCHED; PG8_LDA(At, 1, 0); PG8_STAGE(PG8_SA(0, 1), a2 + hstep, voffA);
            PG8_WAIT_L(8); PG8_BAR; PG8_WAIT_L(0); PG8_MMA(0, 0, At, B0); PG8_BAR; PG8_SCHED;
            PG8_LDB(B1, 1, 1); PG8_STAGE(PG8_SB(1, 0), b3, voffB);
            PG8_BAR; PG8_WAIT_L(0); PG8_MMA(0, 1, At, B1); PG8_BAR;
            PG8_LDA(At, 1, 1); PG8_STAGE(PG8_SA(1, 0), a3, voffA);
            PG8_BAR; PG8_WAIT_L(0); PG8_MMA(1, 0, At, B0); PG8_BAR; PG8_SCHED;
            PG8_STAGE(PG8_SB(1, 1), b3 + hstep, voffB);
            PG8_WAIT_V(6); PG8_BAR; PG8_MMA(1, 1, At, B1); PG8_BAR;
            }
        }
        if constexpr (ALIGN_EPI) { if (wr == 0) PG8_BAR; }
        if constexpr (!Epi::AFTER_DRAIN) { E(acc, cur, wr, wc, fr, fq); S.done(cur); }
        if (!has_next) break;
#pragma unroll
        for (int a = 0; a < 2; ++a)
#pragma unroll
            for (int b = 0; b < 2; ++b)
#pragma unroll
                for (int m = 0; m < 4; ++m)
#pragma unroll
                    for (int n = 0; n < 2; ++n) acc[a][b][m][n] = (f32x4){0.f, 0.f, 0.f, 0.f};
        cur = nxt; cA = nA; cB = nB; ++ui;
        if constexpr (ALIGN_EPI) { if (wr == 1) PG8_BAR; }
    }
    PG8_WAIT_V(0);
    if constexpr (!ALIGN_EPI) { if (wr == 0) PG8_BAR; }
    PG8_BAR;
    if constexpr (Epi::AFTER_DRAIN) { E.fused(acc, cur, wr, wc, fr, fq, lds, wid, lane); S.done(cur); }
#undef PG8_SA
#undef PG8_SB
#undef PG8_STAGE
#undef PG8_LDA
#undef PG8_LDB
#undef PG8_MMA
#undef PG8_WAIT_V
#undef PG8_WAIT_L
#undef PG8_BAR
#undef PG8_SCHED
}
}
using pg8::bf16_t; using pg8::bf16x8; using pg8::f32x4; using pg8::u32x4; using pg8::Unit; using pg8::cvt_pk_bf16;
typedef float f32x16 __attribute__((ext_vector_type(16)));
typedef unsigned u32x2 __attribute__((ext_vector_type(2)));
#define LAS __attribute__((address_space(3)))

constexpr int DM = 1024, SEQ = 2048, DSEQ = 64;
constexpr int MP = 16 * 2048, MS = 32 * 64, MT = MP + MS;
constexpr int DFF = 2816, LDP = 2880;
constexpr int KSA_ROWS = 576, KSB_ROWS = 2112;
constexpr float EPS = 1e-6f, LOG2E = 1.4426950408889634f, QSCALE = 0.125f * 1.4426950408889634f;
constexpr int NPHASE = 15;
#ifndef DOWN_WGM
#define DOWN_WGM 8
#endif
constexpr size_t MiB = 1u << 20;
constexpr size_t WS_CTL = 0, WS_BAR = 65536, WS_SSQ = 1 * MiB, WS_ROPE = 2 * MiB, WS_W = 4 * MiB;
constexpr size_t W_GU1 = 0, W_D1 = 11 * MiB, W_IN = 17 * MiB, W_OUT = 23 * MiB, W_GU2 = 25 * MiB, W_D2 = 36 * MiB, W_LAYER = 42 * MiB;
constexpr size_t WS_XB = 88 * MiB, WS_A = 156 * MiB, WS_QA = WS_A, WS_QB = WS_A + 34 * MiB, WS_O = WS_A + 68 * MiB;
constexpr size_t WS_KAP = 352 * MiB, WS_KBP = 384 * MiB, WS_VAP = 416 * MiB, WS_VBP = 448 * MiB;
constexpr size_t WS_KSA = 480 * MiB, WS_VSA = 516 * MiB, WS_KSB = 552 * MiB, WS_VSB = 684 * MiB, WS_END = 816 * MiB;
static_assert(W_D2 + (size_t)1024 * LDP * 2 <= W_LAYER && WS_W + 2 * W_LAYER <= WS_XB && WS_A + (size_t)MT * LDP * 2 <= WS_KAP, "d_ws map");
constexpr size_t OUT_YP = 0, OUT_YS = 33554432, OUT_PAK = 35651584, OUT_PAV = 44040192, OUT_PBK = 52428800, OUT_PBV = 85983232,
                 OUT_SAK = 119537664, OUT_SAV = 121634816, OUT_SBK = 123731968, OUT_SBV = 125829120;
constexpr int LDS_BYTES = 147456;

struct Args { const float* in[27]; float* out; unsigned char* ws; int ph_lo, ph_hi, coop, pad; };
typedef const __attribute__((address_space(4))) Args* KArgP;

__device__ const double ROPE_INV[32] = {1.0, 0.7498942093324559, 0.5623413251903491, 0.4216965034285822, 0.31622776601683794, 0.23713737056616552, 0.1778279410038923, 0.1333521432163324, 0.1, 0.07498942093324558, 0.05623413251903491, 0.042169650342858224, 0.03162277660168379, 0.023713737056616554, 0.01778279410038923, 0.01333521432163324, 0.01, 0.007498942093324558, 0.005623413251903491, 0.004216965034285823, 0.0031622776601683794, 0.0023713737056616554, 0.0017782794100389228, 0.001333521432163324, 0.001, 0.0007498942093324559, 0.0005623413251903491, 0.00042169650342858224, 0.00031622776601683794, 0.00023713737056616554, 0.00017782794100389227, 0.0001333521432163324};

__device__ __forceinline__ float shx(float v, int lane, int m) { return __builtin_bit_cast(float, __builtin_amdgcn_ds_bpermute((lane ^ m) << 2, __builtin_bit_cast(int, v))); }
__device__ __forceinline__ float wave_sum(float v, int lane) {
#pragma unroll
    for (int o = 1; o < 64; o <<= 1) v += shx(v, lane, o);
    return v;
}
__device__ __forceinline__ float wave_max(float v, int lane) {
#pragma unroll
    for (int o = 1; o < 64; o <<= 1) v = fmaxf(v, shx(v, lane, o));
    return v;
}
__device__ __forceinline__ float fast_rcp(float x) { return __builtin_amdgcn_rcpf(x); }
__device__ __forceinline__ float fast_exp2(float x) { return __builtin_amdgcn_exp2f(x); }

struct EpiSwiGLU {
    static constexpr bool PERM = true, AFTER_DRAIN = false;
    bf16_t* O; const float* ssq;
    __device__ __forceinline__ void operator()(const f32x4 (&acc)[2][2][4][2], const Unit& u, int wr, int wc, int fr, int fq) const {
        const int row0 = u.pm * 256 + wr * 64 + fr, col0 = u.pn * 128 + wc * 32 + 8 * fq;
        float sq[2][4];
#pragma unroll
        for (int ai = 0; ai < 2; ++ai)
#pragma unroll
            for (int m = 0; m < 4; ++m) sq[ai][m] = ssq[row0 + ai * 128 + m * 16];
#pragma unroll
        for (int ai = 0; ai < 2; ++ai)
#pragma unroll
            for (int m = 0; m < 4; ++m) {
                if (!((u.hm >> ai) & 1)) continue;
                const int row = row0 + ai * 128 + m * 16;
                const float rstd = rsqrtf(sq[ai][m] * (1.0f / DM) + EPS);
                float o[8];
#pragma unroll
                for (int n = 0; n < 2; ++n)
#pragma unroll
                    for (int i = 0; i < 4; ++i) {
                        const float g = acc[ai][0][m][n][i] * rstd, up = acc[ai][1][m][n][i] * rstd;
                        const float sg = g * fast_rcp(1.0f + fast_exp2(-g * LOG2E));
                        o[n * 4 + i] = sg * up;
                    }
                u32x4 w; w.x = cvt_pk_bf16(o[0], o[1]); w.y = cvt_pk_bf16(o[2], o[3]); w.z = cvt_pk_bf16(o[4], o[5]); w.w = cvt_pk_bf16(o[6], o[7]);
                *(u32x4*)(O + (((size_t)(row >> 8) * (DFF / 64) + (col0 >> 6)) * 256 + (row & 255)) * 64 + (col0 & 63)) = w;
            }
    }
};
struct EpiResid {
    static constexpr bool PERM = false, AFTER_DRAIN = false;
    const float* xin_p; const float* xin_s; float* xout; bf16_t* xb; float* ssq; float scale;
    __device__ __forceinline__ void operator()(const f32x4 (&acc)[2][2][4][2], const Unit& u, int wr, int wc, int fr, int fq) const {
        const int col0 = u.pn * 256 + wc * 32 + 4 * fq;
#pragma unroll
        for (int ai = 0; ai < 2; ++ai) {
            if (!((u.hm >> ai) & 1)) continue;
            const int rowb = u.pm * 256 + ai * 128 + wr * 64 + fr;
            const float* xi = (rowb < MP) ? xin_p + (size_t)rowb * DM : xin_s + (size_t)(rowb - MP) * DM;
            f32x4 pre[4][2][2];
#pragma unroll
            for (int m = 0; m < 4; ++m)
#pragma unroll
                for (int bj = 0; bj < 2; ++bj)
#pragma unroll
                    for (int n = 0; n < 2; ++n) pre[m][bj][n] = *(const f32x4*)(xi + (size_t)m * 16 * DM + col0 + bj * 128 + n * 16);
#pragma unroll
            for (int m = 0; m < 4; ++m) {
                const int row = rowb + m * 16;
                float sq = 0.f;
#pragma unroll
                for (int bj = 0; bj < 2; ++bj)
#pragma unroll
                    for (int n = 0; n < 2; ++n) {
                        const int c = col0 + bj * 128 + n * 16;
                        const f32x4 v = pre[m][bj][n] + acc[ai][bj][m][n] * scale;
                        *(f32x4*)(xout + (size_t)row * DM + c) = v;
                        u32x2 w; w.x = cvt_pk_bf16(v[0], v[1]); w.y = cvt_pk_bf16(v[2], v[3]);
                        *(u32x2*)(xb + (size_t)row * DM + c) = w;
                        sq += (v[0] * v[0] + v[1] * v[1]) + (v[2] * v[2] + v[3] * v[3]);
                    }
                sq += shx(sq, fr + 16 * fq, 16); sq += shx(sq, fr + 16 * fq, 32);
                if (fq == 0) atomicAdd(ssq + row, sq);
            }
        }
    }
};
struct EpiQK {
    static constexpr bool PERM = true, AFTER_DRAIN = false;
    const float* ssq; unsigned char* ws; float* out; KArgP kap; int l;
    __device__ __forceinline__ void operator()(const f32x4 (&acc)[2][2][4][2], const Unit& u, int wr, int wc, int fr, int fq) const {
        const int sec = u.pn >> 1, hd = 4 * (u.pn & 1) + wc;
        const float* gp = kap->in[12 + sec] + l * 64;
        const float* rope = (const float*)(ws + WS_ROPE);
        bf16_t* QA = (bf16_t*)(ws + WS_QA); bf16_t* QB = (bf16_t*)(ws + WS_QB); bf16_t* KAP = (bf16_t*)(ws + WS_KAP); bf16_t* KBP = (bf16_t*)(ws + WS_KBP);
        bf16_t* KSA = (bf16_t*)(ws + WS_KSA) + (size_t)l * 32 * KSA_ROWS * 512; bf16_t* KSB = (bf16_t*)(ws + WS_KSB) + (size_t)l * 32 * KSB_ROWS * 512;
        float* oPAK = out + OUT_PAK + (size_t)l * 16 * 512 * 512; float* oPBK = out + OUT_PBK + (size_t)l * MP * 512;
        float* oSAK = out + OUT_SAK + (size_t)l * MS * 512; float* oSBK = out + OUT_SBK + (size_t)l * MS * 512;
        f32x4 gl[2], gh[2];
#pragma unroll
        for (int n = 0; n < 2; ++n) { gl[n] = *(const f32x4*)(gp + 8 * fq + 4 * n); gh[n] = *(const f32x4*)(gp + 32 + 8 * fq + 4 * n); }
        const int cbase = hd * 64 + 8 * fq;
        float sqr[2][4];
#pragma unroll
        for (int ai = 0; ai < 2; ++ai)
#pragma unroll
            for (int m = 0; m < 4; ++m) sqr[ai][m] = ssq[u.pm * 256 + ai * 128 + wr * 64 + m * 16 + fr];
#pragma unroll
        for (int ai = 0; ai < 2; ++ai)
#pragma unroll
            for (int m = 0; m < 4; ++m) {
                if (!((u.hm >> ai) & 1)) continue;
                const int row = u.pm * 256 + ai * 128 + wr * 64 + m * 16 + fr;
                const float rstd = rsqrtf(sqr[ai][m] * (1.0f / DM) + EPS);
                f32x4 y[2][2]; float ss = 0.f;
#pragma unroll
                for (int bj = 0; bj < 2; ++bj)
#pragma unroll
                    for (int n = 0; n < 2; ++n) { const f32x4 v = acc[ai][bj][m][n] * rstd; y[bj][n] = v; ss += (v[0] * v[0] + v[1] * v[1]) + (v[2] * v[2] + v[3] * v[3]); }
                ss += shx(ss, fr + 16 * fq, 16); ss += shx(ss, fr + 16 * fq, 32);
                const float rr = rsqrtf(ss * (1.0f / 64.0f) + EPS);
#pragma unroll
                for (int n = 0; n < 2; ++n) { y[0][n] = y[0][n] * rr * gl[n]; y[1][n] = y[1][n] * rr * gh[n]; }
                const bool prompt = row < MP;
                const int sp = row & 2047, bp = row >> 11, ts = (row - MP) & 63, bs = (row - MP) >> 6;
                if (sec >= 2) {
                    const int pos = prompt ? sp : 2048 + ts;
                    const float* cs = rope + (size_t)pos * 64 + 8 * fq;
#pragma unroll
                    for (int n = 0; n < 2; ++n) {
                        const f32x4 c = *(const f32x4*)(cs + 4 * n), s = *(const f32x4*)(cs + 32 + 4 * n);
                        const f32x4 x1 = y[0][n], x2 = y[1][n];
                        y[0][n] = x1 * c - x2 * s; y[1][n] = x2 * c + x1 * s;
                    }
                }
                if (sec == 0 || sec == 2) {
                    bf16_t* dst = (sec == 0 ? QA : QB) + (size_t)row * 512 + cbase;
#pragma unroll
                    for (int bj = 0; bj < 2; ++bj) {
                        const f32x4 a = y[bj][0] * QSCALE, b = y[bj][1] * QSCALE;
                        u32x4 w; w.x = cvt_pk_bf16(a[0], a[1]); w.y = cvt_pk_bf16(a[2], a[3]); w.z = cvt_pk_bf16(b[0], b[1]); w.w = cvt_pk_bf16(b[2], b[3]);
                        *(u32x4*)(dst + 32 * bj) = w;
                    }
                } else {
                    bf16_t* dst; float* fo = nullptr;
                    if (sec == 1) {
                        if (prompt) { dst = KAP + (size_t)row * 512; if (sp >= 1536) fo = oPAK + (size_t)(bp * 512 + sp - 1536) * 512; }
                        else { dst = KSA + (size_t)(bs * KSA_ROWS + 512 + ts) * 512; fo = oSAK + (size_t)(row - MP) * 512; }
                    } else {
                        if (prompt) { dst = KBP + (size_t)row * 512; fo = oPBK + (size_t)row * 512; }
                        else { dst = KSB + (size_t)(bs * KSB_ROWS + 2048 + ts) * 512; fo = oSBK + (size_t)(row - MP) * 512; }
                    }
#pragma unroll
                    for (int bj = 0; bj < 2; ++bj) {
                        const f32x4 a = y[bj][0], b = y[bj][1];
                        u32x4 w; w.x = cvt_pk_bf16(a[0], a[1]); w.y = cvt_pk_bf16(a[2], a[3]); w.z = cvt_pk_bf16(b[0], b[1]); w.w = cvt_pk_bf16(b[2], b[3]);
                        *(u32x4*)(dst + cbase + 32 * bj) = w;
                        if (fo) { *(f32x4*)(fo + cbase + 32 * bj) = a; *(f32x4*)(fo + cbase + 32 * bj + 4) = b; }
                    }
                }
            }
    }
};
struct EpiVt {
    static constexpr bool PERM = true, AFTER_DRAIN = false;
    const float* ssq; unsigned char* ws; float* out; int l;
    __device__ __forceinline__ void operator()(const f32x4 (&acc)[2][2][4][2], const Unit& u, int wr, int wc, int fr, int fq) const {
        bf16_t* VAP = (bf16_t*)(ws + WS_VAP); bf16_t* VBP = (bf16_t*)(ws + WS_VBP);
        bf16_t* VSA = (bf16_t*)(ws + WS_VSA) + (size_t)l * 32 * 512 * KSA_ROWS; bf16_t* VSB = (bf16_t*)(ws + WS_VSB) + (size_t)l * 32 * 512 * KSB_ROWS;
        float* oPAV = out + OUT_PAV + (size_t)l * 16 * 512 * 512; float* oPBV = out + OUT_PBV + (size_t)l * MP * 512;
        float* oSAV = out + OUT_SAV + (size_t)l * MS * 512; float* oSBV = out + OUT_SBV + (size_t)l * MS * 512;
        const int grp = u.pm >> 1;
        const bool prompt = u.pn < (MP / 256);
        f32x4 rs[2][2];
#pragma unroll
        for (int bj = 0; bj < 2; ++bj)
#pragma unroll
            for (int n = 0; n < 2; ++n) {
                const f32x4 q = *(const f32x4*)(ssq + u.pn * 256 + bj * 128 + wc * 32 + 8 * fq + 4 * n);
                f32x4 r; r[0] = rsqrtf(q[0] * (1.0f / DM) + EPS); r[1] = rsqrtf(q[1] * (1.0f / DM) + EPS); r[2] = rsqrtf(q[2] * (1.0f / DM) + EPS); r[3] = rsqrtf(q[3] * (1.0f / DM) + EPS);
                rs[bj][n] = r;
            }
#pragma unroll
        for (int bj = 0; bj < 2; ++bj) {
            const int tok = u.pn * 256 + bj * 128 + wc * 32 + 8 * fq;
            const int bp = tok >> 11, sp = tok & 2047, tt = tok - MP, bs = tt >> 6, ts = tt & 63;
            bf16_t* vdst; size_t vld; float* fo = nullptr;
            if (prompt) { vdst = (grp == 0 ? VAP : VBP) + (size_t)bp * 512 * 2048 + sp; vld = 2048;
                if (grp == 0) { if (sp >= 1536) fo = oPAV + (size_t)(bp * 512 + sp - 1536) * 512; } else fo = oPBV + (size_t)tok * 512; }
            else { if (grp == 0) { vdst = VSA + (size_t)bs * 512 * KSA_ROWS + 512 + ts; vld = KSA_ROWS; fo = oSAV + (size_t)tt * 512; }
                   else { vdst = VSB + (size_t)bs * 512 * KSB_ROWS + 2048 + ts; vld = KSB_ROWS; fo = oSBV + (size_t)tt * 512; } }
#pragma unroll
            for (int ai = 0; ai < 2; ++ai)
#pragma unroll
                for (int m = 0; m < 4; ++m) {
                    if (!((u.hm >> ai) & 1)) continue;
                    const int hrow = (ai * 128 + wr * 64 + m * 16 + fr) + (u.pm & 1) * 256;
                    const f32x4 a = acc[ai][bj][m][0] * rs[bj][0], b = acc[ai][bj][m][1] * rs[bj][1];
                    u32x4 w; w.x = cvt_pk_bf16(a[0], a[1]); w.y = cvt_pk_bf16(a[2], a[3]); w.z = cvt_pk_bf16(b[0], b[1]); w.w = cvt_pk_bf16(b[2], b[3]);
                    *(u32x4*)(vdst + (size_t)hrow * vld) = w;
                    if (fo) {
#pragma unroll
                        for (int i = 0; i < 4; ++i) { fo[(size_t)i * 512 + hrow] = a[i]; fo[(size_t)(4 + i) * 512 + hrow] = b[i]; }
                    }
                }
        }
    }
};
#define XB_TMO      128
#define XB_XCNT(j)  (256  + 64 * (j))
#define XB_XSUB(j)  (1280 + 64 * (j))
#define XB_XGEN(j)  (2304 + 64 * (j))
#define XB_TOP      3328
#define XB_TOPGEN   3392
#define XCD_BAR_WORDS 3456
#define XB_SPIN_CAP (1u << 18)

__device__ __forceinline__ unsigned xb_ld(unsigned* p)              { return __hip_atomic_load(p, __ATOMIC_RELAXED, __HIP_MEMORY_SCOPE_AGENT); }
__device__ __forceinline__ unsigned xb_add(unsigned* p, unsigned v) { return __hip_atomic_fetch_add(p, v, __ATOMIC_RELAXED, __HIP_MEMORY_SCOPE_AGENT); }
__device__ __forceinline__ unsigned xb_xcc_id() { return (unsigned)__builtin_amdgcn_s_getreg((3 << 11) | 20) & 0xFu; }
#define XB_SPIN(cond, bar) do { unsigned _sp = 0; while (cond) { __builtin_amdgcn_s_sleep(1); \
    if ((++_sp & 255u) == 0u) { if (xb_ld(&(bar)[XB_TMO])) break; if (_sp > XB_SPIN_CAP) { atomicAdd(&(bar)[XB_TMO], 1u); break; } } } } while (0)

struct XcdBarrier {
    unsigned* bar; unsigned x;
    volatile LAS unsigned* st;
};

__device__ __forceinline__ XcdBarrier xcd_barrier_post(unsigned* bar, volatile LAS unsigned* st) {
    XcdBarrier b; b.bar = bar; b.x = xb_xcc_id(); b.st = st;
    if (threadIdx.x == 0) (void)xb_add(&bar[XB_XCNT(b.x)], 1u);
    return b;
}
__device__ __forceinline__ void xcd_barrier_complete(unsigned* bar, unsigned x, unsigned& nloc, unsigned& nx) {
    const unsigned G = gridDim.x * gridDim.y * gridDim.z;
    unsigned sum, cnt, mine, sp = 0u;
    for (;;) {
        sum = 0u; cnt = 0u; mine = 0u;
#pragma unroll
        for (unsigned j = 0; j < 16; ++j) { const unsigned c = xb_ld(&bar[XB_XCNT(j)]); sum += c; cnt += (c > 0u) ? 1u : 0u; mine = (j == x) ? c : mine; }
        if (sum == G) break;
        __builtin_amdgcn_s_sleep(1);
        if ((++sp & 255u) == 0u) { if (xb_ld(&bar[XB_TMO])) break; if (sp > XB_SPIN_CAP) { atomicAdd(&bar[XB_TMO], 1u); break; } }
    }
    nloc = mine > 0u ? mine : 1u; nx = cnt > 0u ? cnt : 1u;
}

__device__ __forceinline__ void xcd_barrier(const XcdBarrier& b) {
    asm volatile("s_waitcnt vmcnt(0)" ::: "memory");
    __syncthreads();
    if (threadIdx.x == 0) {
        unsigned* bar = b.bar;
        __builtin_amdgcn_s_waitcnt(0);
        unsigned nloc = b.st[0], nx = b.st[1];
        if (nloc == 0u) { xcd_barrier_complete(bar, b.x, nloc, nx); b.st[0] = nloc; b.st[1] = nx; }
        const unsigned old = xb_add(&bar[XB_XSUB(b.x)], 1u);
        const unsigned gen = old / nloc;
        if (old + 1u == (gen + 1u) * nloc) {
            __builtin_amdgcn_fence(__ATOMIC_RELEASE, "agent");
            asm volatile("s_waitcnt vmcnt(0)" ::: "memory");
            const unsigned og = xb_add(&bar[XB_TOP], 1u);
            const unsigned tg = og / nx;
            if (og + 1u == (tg + 1u) * nx) xb_add(&bar[XB_TOPGEN], 1u);
            else XB_SPIN(xb_ld(&bar[XB_TOPGEN]) == tg, bar);
            __builtin_amdgcn_fence(__ATOMIC_ACQUIRE, "agent");
            xb_add(&bar[XB_XGEN(b.x)], 1u);
            asm volatile("s_waitcnt vmcnt(0)" ::: "memory");
        } else {
            XB_SPIN(xb_ld(&bar[XB_XGEN(b.x)]) == gen, bar);
            __builtin_amdgcn_fence(__ATOMIC_ACQUIRE, "agent");
            asm volatile("s_waitcnt vmcnt(0)" ::: "memory");
        }
    }
    __syncthreads();
}
__device__ __forceinline__ int map_row(int kind, int n) {
    if (kind == 0) return n;
    if (kind == 1) return 256 * (n >> 7) + (n & 127);
    if (kind == 2) return 256 * (n >> 7) + 128 + (n & 127);
    const int sec = n >> 9, w = n & 511;
    if (sec == 2) return 2048 + w;
    if (sec == 5) return 2560 + w;
    const int qsec = sec == 0 ? 0 : sec == 1 ? 1 : sec == 3 ? 2 : 3;
    const int c = qsec * 512 + w, pn = c >> 8, ww = c & 255, hw = ww >> 6, d = ww & 63;
    return 256 * pn + 128 * (d >> 5) + 32 * hw + (d & 31);
}
__device__ __forceinline__ void transpose_item(const float* src, int ld_src, int k0, int n0, const float* gain, bf16_t* dst, size_t ld_dst, int kind, LAS float* scr, int lane) {
#pragma unroll 8
    for (int i = 0; i < 32; ++i) {
        const int kk = 2 * i + (lane >> 5);
        float v = src[(size_t)(k0 + kk) * ld_src + n0 + (lane & 31)];
        if (gain) v *= gain[k0 + kk];
        scr[kk * 33 + (lane & 31)] = v;
    }
    asm volatile("s_waitcnt lgkmcnt(0)" ::: "memory");
    const int c = lane & 7;
#pragma unroll
    for (int j = 0; j < 4; ++j) {
        const int n = (lane >> 3) + 8 * j; const LAS float* s = scr + (8 * c) * 33 + n;
        u32x4 o; o.x = cvt_pk_bf16(s[0 * 33], s[1 * 33]); o.y = cvt_pk_bf16(s[2 * 33], s[3 * 33]); o.z = cvt_pk_bf16(s[4 * 33], s[5 * 33]); o.w = cvt_pk_bf16(s[6 * 33], s[7 * 33]);
        if (kind == 4) { const int row = n0 + n; *(u32x4*)(dst + (((size_t)(row >> 8) * (DFF / 64) + (k0 >> 6)) * 256 + (row & 255)) * 64 + 8 * c) = o; }
        else *(u32x4*)(dst + (size_t)map_row(kind, n0 + n) * ld_dst + k0 + 8 * c) = o;
    }
    asm volatile("s_waitcnt lgkmcnt(0)" ::: "memory");
}
__device__ __forceinline__ void do_job(const float* src, int R, int C, const float* gain, bf16_t* dst, size_t ld_dst, int kind, int item, LAS float* scr, int lane) {
    const int nblk = C >> 5, kb = item / nblk, nb = item - kb * nblk;
    (void)R;
    transpose_item(src, C, 64 * kb, 32 * nb, gain, dst, ld_dst, kind, scr, lane);
}

__device__ __forceinline__ void convert_caches(KArgP A, LAS unsigned char* lds, int l, int gw, int NGW, int wave) {
    int lane_l = lane_id_fresh(); asm volatile("" : "+v"(lane_l)); const int lane = lane_l;
    unsigned char* ws = A->ws;
    LAS float* scr = (LAS float*)(lds + wave * 16384);
    constexpr int I_CAV = 32 * 128, I_CBV = 32 * 512;
    for (int it = gw; it < I_CAV + I_CBV; it += NGW) {
        if (it < I_CAV) {
            const int lb = l * 32 + (it >> 7), item = it & 127;
            do_job(A->in[3] + (size_t)lb * 512 * 512, 512, 512, nullptr, (bf16_t*)(ws + WS_VSA) + (size_t)lb * 512 * KSA_ROWS, KSA_ROWS, 0, item, scr, lane);
        } else {
            const int r = it - I_CAV, lb = l * 32 + (r >> 9), item = r & 511;
            do_job(A->in[5] + (size_t)lb * 2048 * 512, 2048, 512, nullptr, (bf16_t*)(ws + WS_VSB) + (size_t)lb * 512 * KSB_ROWS, KSB_ROWS, 0, item, scr, lane);
        }
    }
    for (int r = gw; r < 32 * 512 + 32 * 2048; r += NGW) {
        const float* s; bf16_t* d;
        if (r < 32 * 512) { const int lb = l * 32 + (r >> 9), key = r & 511; s = A->in[2] + ((size_t)lb * 512 + key) * 512; d = (bf16_t*)(ws + WS_KSA) + (size_t)(lb * KSA_ROWS + key) * 512; }
        else { const int q = r - 32 * 512, lb = l * 32 + (q >> 11), key = q & 2047; s = A->in[4] + ((size_t)lb * 2048 + key) * 512; d = (bf16_t*)(ws + WS_KSB) + (size_t)(lb * KSB_ROWS + key) * 512; }
        const f32x4 a = *(const f32x4*)(s + 8 * lane), b = *(const f32x4*)(s + 8 * lane + 4);
        u32x4 w; w.x = cvt_pk_bf16(a[0], a[1]); w.y = cvt_pk_bf16(a[2], a[3]); w.z = cvt_pk_bf16(b[0], b[1]); w.w = cvt_pk_bf16(b[2], b[3]);
        *(u32x4*)(d + 8 * lane) = w;
    }
}

__device__ __forceinline__ void prologue(KArgP A, LAS unsigned char* lds, int gw, int NGW, int wave) {
    int lane_l = lane_id_fresh(); asm volatile("" : "+v"(lane_l)); const int lane = lane_l;
    unsigned char* ws = A->ws;
    LAS float* scr = (LAS float*)(lds + wave * 16384);
    constexpr int I_GU = 16 * 88, I_D = 44 * 32, I_IN = 16 * 96, I_O = 16 * 32;
    constexpr int I_LAYER = 4 * I_GU + 2 * I_D + I_IN + I_O;
    constexpr int I_W = 2 * I_LAYER;
    for (int it = gw; it < I_W; it += NGW) {
        {
            const int l = it / I_LAYER; int r = it - l * I_LAYER;
            unsigned char* wl = ws + WS_W + (size_t)l * W_LAYER;
            const float* gf1 = A->in[6] + l * DM; const float* gmx = A->in[10] + l * DM; const float* gf2 = A->in[23] + l * DM;
            if (r < I_GU) { do_job(A->in[7] + (size_t)l * DM * DFF, DM, DFF, gf1, (bf16_t*)(wl + W_GU1), DM, 1, r, scr, lane); continue; } r -= I_GU;
            if (r < I_GU) { do_job(A->in[8] + (size_t)l * DM * DFF, DM, DFF, gf1, (bf16_t*)(wl + W_GU1), DM, 2, r, scr, lane); continue; } r -= I_GU;
            if (r < I_D)  { do_job(A->in[9] + (size_t)l * DM * DFF, DFF, DM, nullptr, (bf16_t*)(wl + W_D1), LDP, 4, r, scr, lane); continue; } r -= I_D;
            if (r < I_IN) { do_job(A->in[11] + (size_t)l * DM * 3072, DM, 3072, gmx, (bf16_t*)(wl + W_IN), DM, 3, r, scr, lane); continue; } r -= I_IN;
            if (r < I_O)  { do_job(A->in[22] + (size_t)l * DM * DM, DM, DM, nullptr, (bf16_t*)(wl + W_OUT), DM, 0, r, scr, lane); continue; } r -= I_O;
            if (r < I_GU) { do_job(A->in[24] + (size_t)l * DM * DFF, DM, DFF, gf2, (bf16_t*)(wl + W_GU2), DM, 1, r, scr, lane); continue; } r -= I_GU;
            if (r < I_GU) { do_job(A->in[25] + (size_t)l * DM * DFF, DM, DFF, gf2, (bf16_t*)(wl + W_GU2), DM, 2, r, scr, lane); continue; } r -= I_GU;
            do_job(A->in[26] + (size_t)l * DM * DFF, DFF, DM, nullptr, (bf16_t*)(wl + W_D2), LDP, 4, r, scr, lane);
        }
    }
    convert_caches(A, lds, 0, gw, NGW, wave);
    convert_caches(A, lds, 1, gw, NGW, wave);
    float* ssq = (float*)(ws + WS_SSQ);
    bf16_t* xb = (bf16_t*)(ws + WS_XB);
    for (int r = gw; r < MT; r += NGW) {
        const float* xr = (r < MP) ? A->in[0] + (size_t)r * DM : A->in[1] + (size_t)(r - MP) * DM;
        float s = 0.f;
#pragma unroll
        for (int j = 0; j < 4; ++j) {
            const f32x4 v = *(const f32x4*)(xr + 256 * j + 4 * lane);
            s += (v[0] * v[0] + v[1] * v[1]) + (v[2] * v[2] + v[3] * v[3]);
            u32x2 w; w.x = cvt_pk_bf16(v[0], v[1]); w.y = cvt_pk_bf16(v[2], v[3]);
            *(u32x2*)(xb + (size_t)r * DM + 256 * j + 4 * lane) = w;
        }
        s = wave_sum(s, lane);
        if (lane == 0) ssq[r] = s;
    }
    for (int i = gw * 64 + lane; i < 6 * MT; i += NGW * 64) ssq[MT + i] = 0.f;
    float* rope = (float*)(ws + WS_ROPE);
    for (int i = gw * 64 + lane; i < 2112 * 32; i += NGW * 64) {
        const int pos = i >> 5, j = i & 31;
        const double a = (double)((float)pos * (float)ROPE_INV[j]);
        const double kq = __builtin_rint(a * 0.63661977236758134308);
        const double rr = (a - kq * 1.5707963267948966192) - kq * 6.123233995736766e-17;
        const double r2 = rr * rr;
        const double sn = rr * (1.0 + r2 * (-1.0 / 6 + r2 * (1.0 / 120 + r2 * (-1.0 / 5040 + r2 * (1.0 / 362880 + r2 * (-1.0 / 39916800 + r2 * (1.0 / 6227020800.0)))))));
        const double cn = 1.0 + r2 * (-0.5 + r2 * (1.0 / 24 + r2 * (-1.0 / 720 + r2 * (1.0 / 40320 + r2 * (-1.0 / 3628800 + r2 * (1.0 / 479001600 + r2 * (-1.0 / 87178291200.0)))))));
        const int q = ((int)kq) & 3;
        const double c = q == 0 ? cn : q == 1 ? -sn : q == 2 ? -cn : sn;
        const double s = q == 0 ? sn : q == 1 ? cn : q == 2 ? -sn : -cn;
        rope[(size_t)pos * 64 + j] = (float)c; rope[(size_t)pos * 64 + 32 + j] = (float)s;
    }
    if (gw == 0) {
        unsigned* ctl = (unsigned*)(ws + WS_CTL);
        float* cst = (float*)(ws + WS_CTL + 4096);
        if (lane < 16) ctl[lane] = 0u;
        for (int i = lane; i < XCD_BAR_WORDS; i += 64) ((unsigned*)(ws + WS_BAR))[i] = 0u;
        for (int l = 0; l < 2; ++l) {
            const float mqa = wave_max(fabsf(A->in[12][l * 64 + lane]), lane), mka = wave_max(fabsf(A->in[13][l * 64 + lane]), lane);
            const float mqb = wave_max(fabsf(A->in[14][l * 64 + lane]), lane), mkb = wave_max(fabsf(A->in[15][l * 64 + lane]), lane);
            float mb = 0.f;
            for (int i = lane; i < 8 * 257; i += 64) mb = fmaxf(mb, fabsf(A->in[16][l * 8 * 257 + i]));
            mb = wave_max(mb, lane);
            const float d1 = wave_sum(A->in[17][l * 64 + lane] * A->in[18][l * 64 + lane], lane), d2 = wave_sum(A->in[19][l * 64 + lane] * A->in[20][l * 64 + lane], lane);
            const float lam_init = l == 0 ? 0.2f : 0.35550906759096934f;
            if (lane == 0) {
                cst[l * 8 + 0] = LOG2E * (8.0f * mqa * mka + mb);
                cst[l * 8 + 1] = LOG2E * (8.0f * mqb * mkb);
                cst[l * 8 + 2] = expf(d1) - expf(d2) + lam_init;
                cst[l * 8 + 3] = 1.0f - lam_init;
            }
        }
    }
}

__device__ __forceinline__ int swap23(int r) { return (r & 19) | ((r & 4) << 1) | ((r & 8) >> 1); }
__device__ __forceinline__ f32x16 mfma32(bf16x8 a, bf16x8 b, f32x16 c) { return __builtin_amdgcn_mfma_f32_32x32x16_bf16(a, b, c, 0, 0, 0); }
__device__ __forceinline__ bf16x8 pack8(const f32x16& p, int s) {
    u32x4 w; w.x = cvt_pk_bf16(p[8 * s + 0], p[8 * s + 1]); w.y = cvt_pk_bf16(p[8 * s + 2], p[8 * s + 3]); w.z = cvt_pk_bf16(p[8 * s + 4], p[8 * s + 5]); w.w = cvt_pk_bf16(p[8 * s + 6], p[8 * s + 7]);
    return __builtin_bit_cast(bf16x8, w);
}
constexpr int ATT_BUF = 32768, ATT_WAVE = 65536, ATT_BW = 131072 + 64;

__device__ __forceinline__ void attn_a_block(const bf16_t* Qw, const bf16_t* Kb, const bf16_t* Vtb, int ldv, int T, int t_lo, int t_hi, int t_self, int qoff,
                                             bf16_t* Outw, LAS unsigned char* lds, int wave, int lane_in) {
    int lane = lane_in; asm volatile("" : "+v"(lane));
    const int r32 = lane & 31, hi = lane >> 5;
    const bool active = t_lo <= t_hi;
    const LAS float* E = (const LAS float*)(lds + ATT_WAVE + wave * 8192);
    bf16x8 qf[4];
#pragma unroll
    for (int d0 = 0; d0 < 4; ++d0) qf[d0] = active ? *(const bf16x8*)(Qw + (size_t)r32 * 512 + 16 * d0 + 8 * hi) : (bf16x8){0, 0, 0, 0, 0, 0, 0, 0};
    f32x16 o0, o1;
#pragma unroll
    for (int r = 0; r < 16; ++r) { o0[r] = 0.f; o1[r] = 0.f; }
    float l = 0.f;
    const float cfar = E[192];
    const int key_l = 8 * wave + (lane & 7), c8 = lane >> 3;
    const bf16_t* kg = Kb + (size_t)key_l * 512 + 8 * c8;
    const bf16_t* vg = Vtb + (size_t)key_l * ldv + 8 * c8;
    const int koff = ((key_l >> 5) * 4 + (c8 >> 1)) * 1024 + (swap23(key_l & 31) + 32 * (c8 & 1)) * 16;
    const int voff = 8192 + (((c8 >> 2) * 2 + (key_l >> 5)) * 2 + ((c8 >> 1) & 1)) * 1024 + ((key_l & 31) + 32 * (c8 & 1)) * 16;
    constexpr int ABUF = 16384;
    u32x4 skA = *(const u32x4*)kg, svA = *(const u32x4*)vg, skB = skA, svB = svA;
    if (T > 1) { skB = *(const u32x4*)(kg + (size_t)64 * 512); svB = *(const u32x4*)(vg + 64); }
    *(LAS u32x4*)(lds + koff) = skA; *(LAS u32x4*)(lds + voff) = svA;
    __syncthreads();
    int cb = 0;
#define A_STEP(t, LK, LV, WK, WV) do { \
        if ((t) + 2 < T) { LK = *(const u32x4*)(kg + (size_t)((t) + 2) * 64 * 512); LV = *(const u32x4*)(vg + ((t) + 2) * 64); } \
        if ((t) >= t_lo && (t) <= t_hi) { \
            const LAS bf16x8* KF = (const LAS bf16x8*)(lds + cb * ABUF); \
            const LAS bf16x8* VF = KF + 512; \
            _Pragma("unroll") for (int j = 0; j < 2; ++j) { \
                f32x16 sa; \
                const int relbase = 64 * (t_self - (t)) - 32 * j + qoff; \
                if (relbase - 31 >= 128) { _Pragma("unroll") for (int r = 0; r < 16; ++r) sa[r] = cfar; } \
                else { const int bi = relbase + 64 + r32 - 8 * hi - 23; _Pragma("unroll") for (int r = 0; r < 16; ++r) sa[r] = E[bi + 23 - (r & 7) - 16 * (r >> 3)]; } \
                _Pragma("unroll") for (int d0 = 0; d0 < 4; ++d0) sa = mfma32(KF[(j * 4 + d0) * 64 + lane], qf[d0], sa); \
                float ps = 0.f; \
                _Pragma("unroll") for (int r = 0; r < 16; ++r) { sa[r] = fast_exp2(sa[r]); ps += sa[r]; } \
                l += ps; \
                const bf16x8 p0 = pack8(sa, 0), p1 = pack8(sa, 1); \
                o0 = mfma32(VF[((j * 2 + 0) * 2 + 0) * 64 + lane], p0, o0); o0 = mfma32(VF[((j * 2 + 0) * 2 + 1) * 64 + lane], p1, o0); \
                o1 = mfma32(VF[((j * 2 + 1) * 2 + 0) * 64 + lane], p0, o1); o1 = mfma32(VF[((j * 2 + 1) * 2 + 1) * 64 + lane], p1, o1); \
            } \
        } \
        const int nb = cb == 2 ? 0 : cb + 1; \
        if ((t) + 1 < T) { *(LAS u32x4*)(lds + nb * ABUF + koff) = WK; *(LAS u32x4*)(lds + nb * ABUF + voff) = WV; } \
        cb = nb; \
        __syncthreads(); \
    } while (0)
    for (int t = 0; t < T; t += 2) {
        A_STEP(t, skA, svA, skB, svB);
        if (t + 1 < T) A_STEP(t + 1, skB, svB, skA, svA);
    }
#undef A_STEP
    if (active) {
        const int le = lane_id_fresh(), r32e = le & 31, hie = le >> 5;
        l += shx(l, le, 32);
        const float inv = 1.0f / l;
#pragma unroll
        for (int g = 0; g < 4; ++g) {
            u32x2 w0, w1;
            w0.x = cvt_pk_bf16(o0[4 * g] * inv, o0[4 * g + 1] * inv); w0.y = cvt_pk_bf16(o0[4 * g + 2] * inv, o0[4 * g + 3] * inv);
            w1.x = cvt_pk_bf16(o1[4 * g] * inv, o1[4 * g + 1] * inv); w1.y = cvt_pk_bf16(o1[4 * g + 2] * inv, o1[4 * g + 3] * inv);
            *(u32x2*)(Outw + (size_t)r32e * DM + 8 * g + 4 * hie) = w0;
            *(u32x2*)(Outw + (size_t)r32e * DM + 32 + 8 * g + 4 * hie) = w1;
        }
    }
}
__device__ __forceinline__ void attn_b_block(const bf16_t* Qw, const bf16_t* Kb, const bf16_t* Vtb, int ldv, int T, int tlim, float nshift, float lam, float post, const float* gsub,
                                             bf16_t* Outw, LAS unsigned char* lds, int wave, int lane_in) {
    int lane = lane_in; asm volatile("" : "+v"(lane));
    const int r32 = lane & 31, hi = lane >> 5;
    LAS bf16x8* Qs = (LAS bf16x8*)(lds + ATT_WAVE + wave * 8192);
    if (tlim > 0) {
#pragma unroll
        for (int m = 0; m < 2; ++m)
#pragma unroll
            for (int d0 = 0; d0 < 4; ++d0) Qs[(m * 4 + d0) * 64 + lane] = *(const bf16x8*)(Qw + (size_t)r32 * 512 + 64 * m + 16 * d0 + 8 * hi);
    }
    f32x16 o1[4], o2[4];
#pragma unroll
    for (int db = 0; db < 4; ++db)
#pragma unroll
        for (int r = 0; r < 16; ++r) { o1[db][r] = 0.f; o2[db][r] = 0.f; }
    float l1 = 0.f, l2 = 0.f;
    const int key_l = 8 * wave + (lane & 7), c8 = lane >> 3;
    const bf16_t* kg = Kb + (size_t)key_l * 512 + 8 * c8;
    const int koff = ((key_l >> 5) * 8 + (c8 >> 1)) * 1024 + (swap23(key_l & 31) + 32 * (c8 & 1)) * 16;
    const int d_l = 16 * wave + (lane & 7);
    const bf16_t* vg = Vtb + (size_t)d_l * ldv + 8 * c8;
    const int voff = 16384 + (((c8 >> 2) * 4 + (d_l >> 5)) * 2 + ((c8 >> 1) & 1)) * 1024 + ((d_l & 31) + 32 * (c8 & 1)) * 16;
    u32x4 sk0 = *(const u32x4*)kg, sk1 = *(const u32x4*)(kg + 64), sv0 = *(const u32x4*)vg, sv1 = *(const u32x4*)(vg + (size_t)8 * ldv);
    *(LAS u32x4*)(lds + koff) = sk0; *(LAS u32x4*)(lds + koff + 4096) = sk1; *(LAS u32x4*)(lds + voff) = sv0; *(LAS u32x4*)(lds + voff + 128) = sv1;
    __syncthreads();
    for (int t = 0; t < T; ++t) {
        const bool more = t + 1 < T;
        if (more) {
            const bf16_t* kn = kg + (size_t)(t + 1) * 64 * 512; const bf16_t* vn = vg + (t + 1) * 64;
            sk0 = *(const u32x4*)kn; sk1 = *(const u32x4*)(kn + 64); sv0 = *(const u32x4*)vn; sv1 = *(const u32x4*)(vn + (size_t)8 * ldv);
        }
        if (t < tlim) {
            const LAS bf16x8* KF = (const LAS bf16x8*)(lds + (t & 1) * ATT_BUF);
            const LAS bf16x8* VF = KF + 1024;
#pragma unroll
            for (int j = 0; j < 2; ++j) {
                bf16x8 pa[2], pb[2];
                {
                    f32x16 sa;
#pragma unroll
                    for (int r = 0; r < 16; ++r) sa[r] = nshift;
#pragma unroll
                    for (int d0 = 0; d0 < 4; ++d0) sa = mfma32(KF[((j * 2 + 0) * 4 + d0) * 64 + lane], Qs[d0 * 64 + lane], sa);
                    float ps = 0.f;
#pragma unroll
                    for (int r = 0; r < 16; ++r) { sa[r] = fast_exp2(sa[r]); ps += sa[r]; }
                    l1 += ps; pa[0] = pack8(sa, 0); pa[1] = pack8(sa, 1);
                }
                {
                    f32x16 sa;
#pragma unroll
                    for (int r = 0; r < 16; ++r) sa[r] = nshift;
#pragma unroll
                    for (int d0 = 0; d0 < 4; ++d0) sa = mfma32(KF[((j * 2 + 1) * 4 + d0) * 64 + lane], Qs[(4 + d0) * 64 + lane], sa);
                    float ps = 0.f;
#pragma unroll
                    for (int r = 0; r < 16; ++r) { sa[r] = fast_exp2(sa[r]); ps += sa[r]; }
                    l2 += ps; pb[0] = pack8(sa, 0); pb[1] = pack8(sa, 1);
                }
#pragma unroll
                for (int db = 0; db < 4; ++db)
#pragma unroll
                    for (int s = 0; s < 2; ++s) {
                        const bf16x8 vf = VF[((j * 4 + db) * 2 + s) * 64 + lane];
                        o1[db] = mfma32(vf, pa[s], o1[db]); o2[db] = mfma32(vf, pb[s], o2[db]);
                    }
            }
        }
        if (more) {
            LAS unsigned char* nb = lds + ((t + 1) & 1) * ATT_BUF;
            *(LAS u32x4*)(nb + koff) = sk0; *(LAS u32x4*)(nb + koff + 4096) = sk1; *(LAS u32x4*)(nb + voff) = sv0; *(LAS u32x4*)(nb + voff + 128) = sv1;
        }
        __syncthreads();
    }
    if (tlim > 0) {
        const int le = lane_id_fresh(), r32e = le & 31, hie = le >> 5;
        l1 += shx(l1, le, 32); l2 += shx(l2, le, 32);
        const float i1 = 1.0f / l1, i2 = lam / l2;
        float ss = 0.f;
#pragma unroll
        for (int db = 0; db < 4; ++db)
#pragma unroll
            for (int r = 0; r < 16; ++r) { const float v = o1[db][r] * i1 - o2[db][r] * i2; o1[db][r] = v; ss += v * v; }
        ss += shx(ss, le, 32);
        const float rr = rsqrtf(ss * (1.0f / 128.0f) + EPS) * post;
#pragma unroll
        for (int db = 0; db < 4; ++db)
#pragma unroll
            for (int g = 0; g < 4; ++g) {
                const int d = 32 * db + 8 * g + 4 * hie;
                const f32x4 gs = *(const f32x4*)(gsub + d);
                u32x2 w; w.x = cvt_pk_bf16(o1[db][4 * g] * rr * gs[0], o1[db][4 * g + 1] * rr * gs[1]); w.y = cvt_pk_bf16(o1[db][4 * g + 2] * rr * gs[2], o1[db][4 * g + 3] * rr * gs[3]);
                *(u32x2*)(Outw + (size_t)r32e * DM + d) = w;
            }
    }
}
constexpr int U_BS = 128, U_BP = 512, U_AP = 1024, U_AS = 256, U_B = U_BS + U_BP, U_ALL = U_B + U_AP + U_AS;
__device__ __forceinline__ void attn_phase(KArgP A, int l, LAS unsigned char* lds, int wave, int cidx) {
    unsigned char* ws = A->ws;
    unsigned* ctr = (unsigned*)(ws + WS_CTL) + cidx;
    const float* cst = (const float*)(ws + WS_CTL + 4096) + l * 8;
    const float shA = cst[0], shB = cst[1], lam = cst[2], post = cst[3];
    volatile LAS int* bw = (volatile LAS int*)(lds + ATT_BW);
    const bf16_t* QA = (const bf16_t*)(ws + WS_QA); const bf16_t* QB = (const bf16_t*)(ws + WS_QB);
    bf16_t* O = (bf16_t*)(ws + WS_O);
    const float* bias = A->in[16] + (size_t)l * 8 * 257;
    const float* gsub = A->in[21] + l * 128;
    for (;;) {
        int lane_l = lane_id_fresh(); asm volatile("" : "+v"(lane_l)); const int lane = lane_l;
        __syncthreads();
        if (wave == 0 && lane == 0) bw[0] = (int)atomicAdd(ctr, 1u);
        __syncthreads();
        const int uid = __builtin_amdgcn_readfirstlane(bw[0]);
        if (uid >= U_ALL) break;
        if (uid < U_B) {
            int b, h, T, tlim, row0, ldv; const bf16_t* K; const bf16_t* Vt;
            if (uid < U_BS) { b = uid >> 2; h = uid & 3; T = 33; tlim = wave < 2 ? 33 : 0; row0 = MP + b * 64 + 32 * (wave & 1); ldv = KSB_ROWS;
                K = (const bf16_t*)(ws + WS_KSB) + (size_t)(l * 32 + b) * KSB_ROWS * 512 + h * 128;
                Vt = (const bf16_t*)(ws + WS_VSB) + ((size_t)(l * 32 + b) * 512 + h * 128) * KSB_ROWS; }
            else { const int v = uid - U_BS, qb = 7 - (v >> 6), w = v & 63; b = w >> 2; h = w & 3; T = 4 * qb + 4; tlim = 4 * qb + (wave >> 1) + 1; row0 = b * 2048 + 256 * qb + 32 * wave; ldv = 2048;
                K = (const bf16_t*)(ws + WS_KBP) + (size_t)b * 2048 * 512 + h * 128;
                Vt = (const bf16_t*)(ws + WS_VBP) + ((size_t)b * 512 + h * 128) * 2048; }
            attn_b_block(QB + (size_t)row0 * 512 + h * 128, K, Vt, ldv, T, tlim, -shB, lam, post, gsub, O + (size_t)row0 * DM + 512 + h * 128, lds, wave, lane);
        } else {
            int b, h, T, t_lo, t_hi, t_self, row0, ldv; const bf16_t* K; const bf16_t* Vt;
            if (uid < U_B + U_AP) { const int v = uid - U_B, cq = 7 - (v >> 7), w = v & 127; b = w >> 3; h = w & 7;
                const int kc0 = cq >= 2 ? 4 * cq - 8 : 0, cw = 4 * cq + (wave >> 1);
                T = 4 * cq + 4 - kc0; t_self = cw - kc0; t_hi = t_self; t_lo = cw - 8 - kc0 > 0 ? cw - 8 - kc0 : 0; row0 = b * 2048 + 256 * cq + 32 * wave; ldv = 2048;
                K = (const bf16_t*)(ws + WS_KAP) + ((size_t)b * 2048 + 64 * kc0) * 512 + h * 64;
                Vt = (const bf16_t*)(ws + WS_VAP) + ((size_t)b * 512 + h * 64) * 2048 + 64 * kc0; }
            else { const int v = uid - U_B - U_AP; b = v >> 3; h = v & 7; T = 9; t_self = 8; t_lo = wave < 2 ? 0 : 1; t_hi = wave < 2 ? 8 : 0; row0 = MP + b * 64 + 32 * (wave & 1); ldv = KSA_ROWS;
                K = (const bf16_t*)(ws + WS_KSA) + (size_t)(l * 32 + b) * KSA_ROWS * 512 + h * 64;
                Vt = (const bf16_t*)(ws + WS_VSA) + ((size_t)(l * 32 + b) * 512 + h * 64) * KSA_ROWS; }
            LAS float* E = (LAS float*)(lds + ATT_WAVE + wave * 8192);
#pragma unroll
            for (int j = 0; j < 5; ++j) { const int i = lane + 64 * j; int rel = i - 64; rel = rel < -128 ? -128 : (rel > 128 ? 128 : rel); E[i] = LOG2E * bias[h * 257 + rel + 128] - shA; }
            attn_a_block(QA + (size_t)row0 * 512 + h * 64, K, Vt, ldv, T, t_lo, t_hi, t_self, 32 * (wave & 1), O + (size_t)row0 * DM + h * 64, lds, wave, lane);
        }
    }
}

__device__ __forceinline__ bool in_phase(int p) { KArgP k = (KArgP)__builtin_amdgcn_kernarg_segment_ptr(); asm volatile("" : "+s"(k)); return k->ph_lo <= p && p < k->ph_hi; }
__global__ void __launch_bounds__(512, 2) mega_fwd(Args KA) {
    extern __shared__ __attribute__((aligned(16))) unsigned char lds_raw[];
    LAS unsigned char* lds = (LAS unsigned char*)lds_raw;
    const int tid = threadIdx.x, wave = __builtin_amdgcn_readfirstlane(tid >> 6);
    const int G = gridDim.x, bx = blockIdx.x;
    const int vcu = (G % 8 == 0) ? (bx % 8) * (G / 8) + bx / 8 : bx;
    (void)KA;
    if (tid == 0) { ((volatile LAS unsigned*)(lds + ATT_BW + 64))[0] = 0u; ((volatile LAS unsigned*)(lds + ATT_BW + 64))[1] = 0u; ((volatile LAS unsigned*)(lds + ATT_BW + 64))[2] = (unsigned)bx; }
    __syncthreads();
#define FRESH_KAP(name) KArgP name = (KArgP)__builtin_amdgcn_kernarg_segment_ptr(); asm volatile("" : "+s"(name))
#define IN_PH(p) in_phase(p)
#define SEAM(p) do { FRESH_KAP(ks_); if (ks_->coop && (p) + 1 < ks_->ph_hi) { XcdBarrier xb_; xb_.bar = (unsigned*)(ks_->ws + WS_BAR); xb_.x = xb_xcc_id(); xb_.st = (volatile LAS unsigned*)(lds + ATT_BW + 64); xcd_barrier(xb_); } } while (0)
#define KARGS() KArgP kap = (KArgP)__builtin_amdgcn_kernarg_segment_ptr(); asm volatile("" : "+s"(kap)); unsigned char* ws = kap->ws; float* out = kap->out; \
    float* ssq = (float*)(ws + WS_SSQ); bf16_t* xb = (bf16_t*)(ws + WS_XB); bf16_t* ab = (bf16_t*)(ws + WS_A); unsigned char* wl = ws + WS_W + (size_t)l * W_LAYER; (void)ssq; (void)xb; (void)ab; (void)wl; (void)out; \
    const int cx = __builtin_amdgcn_readfirstlane((int)((volatile LAS unsigned*)(lds + ATT_BW + 64))[2])
    if (IN_PH(0)) {
        KArgP kap = (KArgP)__builtin_amdgcn_kernarg_segment_ptr(); asm volatile("" : "+s"(kap));
        prologue(kap, lds, vcu * 8 + wave, G * 8, wave);
#ifdef PROBE_PRO2
        prologue(kap, lds, vcu * 8 + wave, G * 8, wave);
#endif
        { FRESH_KAP(ks_); if (ks_->coop && 1 < ks_->ph_hi) { cg::this_grid().sync();
            if (tid == 0) { unsigned* bar_ = (unsigned*)(ks_->ws + WS_BAR); const unsigned x_ = xb_xcc_id(); const unsigned r_ = xb_add(&bar_[XB_XCNT(x_)], 1u);
                if (G == 256 && r_ < 32u && x_ < 8u) ((volatile LAS unsigned*)(lds + ATT_BW + 64))[2] = r_ * 8u + x_; }
            __syncthreads(); } }
    }
#pragma unroll 1
    for (int l = 0; l < 2; ++l) {
        const int p0 = 1 + 7 * l;
        if (IN_PH(p0 + 0)) {
            KARGS();
            pg8::Gemm g{xb, (const bf16_t*)(wl + W_GU1), MT, 2 * DFF, DM, DM, 0};
            pg8::StaticOrder S; S.init(MT, 2 * DFF, G, cx);
            EpiSwiGLU E{ab, ssq + (size_t)(3 * l) * MT};
            pg8::gemm_phase<EpiSwiGLU, pg8::StaticOrder, true, true>(lds, g, S, E, wave);
#ifdef PROBE_UP2
            pg8::gemm_phase<EpiSwiGLU, pg8::StaticOrder, true, true>(lds, g, S, E, wave);
#endif
            SEAM(p0 + 0);
        }
        if (IN_PH(p0 + 1)) {
            KARGS();
            pg8::Gemm g{ab, (const bf16_t*)(wl + W_D1), MT, DM, DFF, LDP, 1};
            pg8::TailSplitOrder S; S.init(MT, DM, G, cx, 0, DOWN_WGM);
            EpiResid E{l == 0 ? kap->in[0] : out, l == 0 ? kap->in[1] : out + (size_t)MP * DM, out, xb, ssq + (size_t)(3 * l + 1) * MT, 0.5f};
            pg8::gemm_phase<EpiResid, pg8::TailSplitOrder, true, true>(lds, g, S, E, wave);
            SEAM(p0 + 1);
        }
        if (IN_PH(p0 + 2)) {
            {
                KARGS();
                pg8::Gemm g{xb, (const bf16_t*)(wl + W_IN), MT, 2048, DM, DM, 0};
                pg8::TailSplitOrder S; S.init(MT, 2048, G, cx);
                EpiQK E{ssq + (size_t)(3 * l + 1) * MT, ws, out, kap, l};
                pg8::gemm_phase<EpiQK, pg8::TailSplitOrder, true, true>(lds, g, S, E, wave);
#ifdef PROBE_QK2
                pg8::gemm_phase<EpiQK, pg8::TailSplitOrder, true, true>(lds, g, S, E, wave);
#endif
            }
            {
                KARGS();
                pg8::Gemm g{(const bf16_t*)(wl + W_IN) + (size_t)2048 * DM, xb, 1024, MT, DM, DM, 0};
                pg8::TailSplitOrder S; S.init(1024, MT, G, cx);
                EpiVt E{ssq + (size_t)(3 * l + 1) * MT, ws, out, l};
                pg8::gemm_phase<EpiVt, pg8::TailSplitOrder, true, true>(lds, g, S, E, wave);
#ifdef PROBE_VT2
                pg8::gemm_phase<EpiVt, pg8::TailSplitOrder, true, true>(lds, g, S, E, wave);
#endif
            }
            SEAM(p0 + 2);
        }
        if (IN_PH(p0 + 3)) {
            KArgP kap = (KArgP)__builtin_amdgcn_kernarg_segment_ptr(); asm volatile("" : "+s"(kap));
            attn_phase(kap, l, lds, wave, l);
#ifdef PROBE_ATTN2
            attn_phase(kap, l, lds, wave, 2 + l);
#endif
            SEAM(p0 + 3);
        }
        if (IN_PH(p0 + 4)) {
            KARGS();
            pg8::Gemm g{(const bf16_t*)(ws + WS_O), (const bf16_t*)(wl + W_OUT), MT, DM, DM, DM, 0};
            pg8::TailSplitOrder S; S.init(MT, DM, G, cx);
            EpiResid E{out, out + (size_t)MP * DM, out, xb, ssq + (size_t)(3 * l + 2) * MT, 1.0f};
            pg8::gemm_phase<EpiResid, pg8::TailSplitOrder, true, true>(lds, g, S, E, wave);
            SEAM(p0 + 4);
        }
        if (IN_PH(p0 + 5)) {
            KARGS();
            pg8::Gemm g{xb, (const bf16_t*)(wl + W_GU2), MT, 2 * DFF, DM, DM, 0};
            pg8::StaticOrder S; S.init(MT, 2 * DFF, G, cx);
            EpiSwiGLU E{ab, ssq + (size_t)(3 * l + 2) * MT};
            pg8::gemm_phase<EpiSwiGLU, pg8::StaticOrder, true, true>(lds, g, S, E, wave);
            SEAM(p0 + 5);
        }
        if (IN_PH(p0 + 6)) {
            KARGS();
            pg8::Gemm g{ab, (const bf16_t*)(wl + W_D2), MT, DM, DFF, LDP, 1};
            pg8::TailSplitOrder S; S.init(MT, DM, G, cx, 0, DOWN_WGM);
            EpiResid E{out, out + (size_t)MP * DM, out, xb, ssq + (size_t)(3 * l + 3) * MT, 0.5f};
            pg8::gemm_phase<EpiResid, pg8::TailSplitOrder, true, true>(lds, g, S, E, wave);
            SEAM(p0 + 6);
        }
    }
}

#ifndef N_LAUNCH_MODE_GUARD_
#define N_LAUNCH_MODE_GUARD_
#endif
#ifndef N_LAUNCH_MODE
#define N_LAUNCH_MODE 0
#endif
extern "C" void kernel_launch(void* const* d_in, const int* in_sizes, int n_in, void* d_out, int out_size, void* d_ws, size_t ws_size, hipStream_t stream) {
    static int grid = 0;
    if (grid == 0) {
        if (n_in != 27 || ws_size < WS_END) { fprintf(stderr, "kernel_launch: unexpected inputs (n_in %d, ws %zu)\n", n_in, ws_size); grid = -1; return; }
        int dev = 0, cus = 0, per_cu = 0;
        hipGetDevice(&dev);
        hipDeviceGetAttribute(&cus, hipDeviceAttributeMultiprocessorCount, dev);
        hipFuncSetAttribute((const void*)mega_fwd, hipFuncAttributeMaxDynamicSharedMemorySize, LDS_BYTES);
        hipOccupancyMaxActiveBlocksPerMultiprocessor(&per_cu, (const void*)mega_fwd, 512, LDS_BYTES);
        (void)hipGetLastError();
        if (per_cu < 1) per_cu = 1;
        grid = cus;
        if (grid != 256) fprintf(stderr, "kernel_launch: note: %d CUs\n", grid);
    }
    if (grid < 0) return;
    Args a{};
    for (int i = 0; i < 27; ++i) a.in[i] = (const float*)d_in[i];
    a.out = (float*)d_out; a.ws = (unsigned char*)d_ws;
#if N_LAUNCH_MODE == 1
    for (int ph = 0; ph < NPHASE; ++ph) {
        a.ph_lo = ph; a.ph_hi = ph + 1; a.coop = 0;
        hipLaunchKernelGGL(mega_fwd, dim3(grid), dim3(512), LDS_BYTES, stream, a);
    }
#else
    a.ph_lo = 0; a.ph_hi = NPHASE; a.coop = 1;
    void* args[] = {&a};
    hipError_t e = hipLaunchCooperativeKernel((const void*)mega_fwd, dim3(grid), dim3(512), args, LDS_BYTES, stream);
    if (e != hipSuccess) fprintf(stderr, "cooperative launch failed: %s (grid %d)\n", hipGetErrorString(e), grid);
#endif
}
```

```cpp
#include <hip/hip_runtime.h>
#include <hip/hip_cooperative_groups.h>
#include <cstdio>
#include <cstdint>
#include <cstddef>
namespace cg = cooperative_groups;
__device__ __forceinline__ int lane_id_fresh() { int l; asm volatile("v_mbcnt_lo_u32_b32 %0, -1, 0\n\tv_mbcnt_hi_u32_b32 %0, -1, %0" : "=v"(l)); return l; }
#ifndef PG8_PFD
#define PG8_PFD 4
#endif
namespace pg8 {
#define PG8_LAS __attribute__((address_space(3)))
typedef unsigned short bf16_t;
typedef short bf16x8 __attribute__((ext_vector_type(8)));
typedef float f32x4 __attribute__((ext_vector_type(4)));
typedef unsigned u32x4 __attribute__((ext_vector_type(4)));
constexpr int BM = 256, BK = 64, HALF = 128, HTB = HALF * BK * 2  , STAGE_BYTES = 8 * HTB, NXCD = 8, WGM = 8;

__host__ __device__ __forceinline__ int lds_byte(int r, int c) { const int st = (r >> 4) * 2 + (c >> 5), rr = r & 15, cc = c & 31, ob = rr * 64 + cc * 2; return st * 1024 + (ob ^ (((ob >> 9) & 1) << 5)); }
__host__ __device__ __forceinline__ void stage_rc(int b, int& R, int& C) { const int st = b / 1024, sb = b % 1024, swz = sb ^ (((sb >> 9) & 1) << 5); R = (st >> 1) * 16 + swz / 64; C = (st & 1) * 32 + (swz % 64) / 2; }
__host__ __device__ __forceinline__ int perm32(int rho) { const int n = rho >> 4, i = rho & 15; return 8 * (i >> 2) + 4 * n + (i & 3); }

struct Unit { int pm, pn, hm; };
struct Gemm { const bf16_t* A; const bf16_t* Bt; int M, N, K, ld; int blocked; };

struct StaticOrder {
    int nM, nN, nwg, G, c, rev, wgm;
    __host__ __device__ void init(int M, int N, int G_, int c_, int rev_ = 0, int wgm_ = WGM) { nM = M / BM; nN = N / BM; nwg = nM * nN; G = G_; c = c_; rev = rev_; wgm = wgm_; }
    __host__ __device__ __forceinline__ void tile(int wgid, Unit& u) const {
        { const int q = nwg / NXCD, r = nwg % NXCD, xcd = wgid % NXCD, off = wgid / NXCD; wgid = (xcd < r ? xcd * (q + 1) : r * (q + 1) + (xcd - r) * q) + off; }
        const int nig = wgm * nN, gid = wgid / nig, fm = gid * wgm, gsz = (nM - fm) < wgm ? (nM - fm) : wgm;
        u.pm = fm + ((wgid % nig) % gsz); u.pn = (wgid % nig) / gsz; u.hm = 3;
        if (rev) u.pm = nM - 1 - u.pm;
    }
    __host__ __device__ bool next(int i, Unit& u) const {
        const long L = (long)i * G + c; if (L >= nwg) return false;
        tile((int)L, u); return true;
    }
    __device__ __forceinline__ void a_ready(const Unit&) const {}
    __device__ __forceinline__ void done(const Unit&) const {}
};
struct TailSplitOrder : StaticOrder {
    __host__ __device__ bool next(int i, Unit& u) const {
        const int nfull = (nwg / G) * G, L = i * G + c;
        if (L < nfull) { tile(L, u); return true; }
        const int idx = L - nfull;
        if (idx >= 2 * (nwg - nfull)) return false;
        tile(nfull + (idx >> 1), u); u.hm = 1 << (idx & 1); return true;
    }
};

__device__ __forceinline__ unsigned cvt_pk_bf16(float lo, float hi) { unsigned r; asm volatile("v_cvt_pk_bf16_f32 %0, %1, %2" : "=v"(r) : "v"(lo), "v"(hi)); return r; }
typedef float f32x2 __attribute__((ext_vector_type(2)));
template <class Epi, class Sched, bool ALIGN_EPI = false, bool SP2 = false>
__device__ __forceinline__ void gemm_phase(PG8_LAS unsigned char* lds, const Gemm g, const Sched& S, const Epi& E, int wave_in) {
    int tid_l = wave_in * 64 + lane_id_fresh(); asm volatile("" : "+v"(tid_l));
    const int tid = tid_l, wid = __builtin_amdgcn_readfirstlane(tid >> 6), lane = tid & 63, wr = wid >> 2, wc = wid & 3, fr = lane & 15, fq = lane >> 4;
    const int nt = g.K / BK, K = g.blocked ? BK : g.ld;
    unsigned voffA[2], voffB[2];
#pragma unroll
    for (int i = 0; i < 2; ++i) { int R, C; stage_rc(tid * 16 + i * 8192, R, C); const int Rb = Epi::PERM ? ((R & ~31) + perm32(R & 31)) : R;
        voffA[i] = (unsigned)(R * K + C) * 2u; voffB[i] = (unsigned)(Rb * K + C) * 2u; }
    const size_t kstep = g.blocked ? (size_t)(BM * BK * 2) : (size_t)(BK * 2);
    const size_t hstep = (size_t)HALF * K * 2;
    const size_t tstep = g.blocked ? (size_t)nt * (BM * BK * 2) : 2 * hstep;
    const unsigned ldsw = (unsigned)wid * 1024u;
    const int aoff = lds_byte(wr * 64 + fr, fq * 8), boff = lds_byte(wc * 32 + fr, fq * 8);
#define PG8_SA(b, h) (((b) * 2 + (h)) * HTB)
#define PG8_SB(b, h) ((4 + (b) * 2 + (h)) * HTB)
#define PG8_STAGE(bufoff, gbase, voff) do { _Pragma("unroll") for (int _i = 0; _i < 2; ++_i) \
        __builtin_amdgcn_global_load_lds((const unsigned*)((const char*)(gbase) + (voff)[_i]), (PG8_LAS unsigned*)(lds + (bufoff) + ldsw + _i * 8192), 16, 0, 0); } while (0)
#define PG8_LDA(dst, b, h) do { _Pragma("unroll") for (int m = 0; m < 4; ++m) _Pragma("unroll") for (int k = 0; k < 2; ++k) dst[m][k] = *(const PG8_LAS bf16x8*)(lds + PG8_SA(b, h) + aoff + m * 2048 + k * 1024); } while (0)
#define PG8_LDB(dst, b, h) do { _Pragma("unroll") for (int n = 0; n < 2; ++n) _Pragma("unroll") for (int k = 0; k < 2; ++k) dst[n][k] = *(const PG8_LAS bf16x8*)(lds + PG8_SB(b, h) + boff + n * 2048 + k * 1024); } while (0)
#define PG8_MMA(ai, bj, At, Bt) do { __builtin_amdgcn_s_setprio(1); _Pragma("unroll") for (int m = 0; m < 4; ++m) _Pragma("unroll") for (int n = 0; n < 2; ++n) _Pragma("unroll") for (int k = 0; k < 2; ++k) \
        acc[ai][bj][m][n] = __builtin_amdgcn_mfma_f32_16x16x32_bf16(Bt[n][k], At[m][k], acc[ai][bj][m][n], 0, 0, 0); __builtin_amdgcn_s_setprio(0); } while (0)
#define PG8_WAIT_V(n) asm volatile("s_waitcnt vmcnt(" #n ")" ::: "memory")
#define PG8_WAIT_L(n) asm volatile("s_waitcnt lgkmcnt(" #n ")" ::: "memory")
#define PG8_BAR __builtin_amdgcn_s_barrier()
#define PG8_SCHED __builtin_amdgcn_sched_barrier(0)
    Unit cur, nxt; int ui = 0;
    if (!S.next(0, cur)) return;
    f32x4 acc[2][2][4][2];
#pragma unroll
    for (int a = 0; a < 2; ++a)
#pragma unroll
        for (int b = 0; b < 2; ++b)
#pragma unroll
            for (int m = 0; m < 4; ++m)
#pragma unroll
                for (int n = 0; n < 2; ++n) acc[a][b][m][n] = (f32x4){0.f, 0.f, 0.f, 0.f};
    bf16x8 At[4][2], B0[2][2], B1[2][2];
    const char* cA = (const char*)g.A + (size_t)cur.pm * tstep; const char* cB = (const char*)g.Bt + (size_t)cur.pn * tstep;
    S.a_ready(cur);
    if constexpr (SP2) {
        PG8_STAGE(PG8_SB(0, 0), cB, voffB); PG8_STAGE(PG8_SB(0, 1), cB + hstep, voffB); PG8_STAGE(PG8_SA(0, 0), cA, voffA); PG8_STAGE(PG8_SA(0, 1), cA + hstep, voffA);
        if (wr == 1) PG8_BAR;
        PG8_WAIT_V(2); PG8_BAR;
        PG8_STAGE(PG8_SB(1, 0), cB + kstep, voffB); PG8_STAGE(PG8_SA(1, 0), cA + kstep, voffA); PG8_STAGE(PG8_SB(1, 1), cB + hstep + kstep, voffB);
        PG8_WAIT_V(6); PG8_BAR;
    } else {
        PG8_STAGE(PG8_SB(0, 0), cB, voffB); PG8_STAGE(PG8_SA(0, 0), cA, voffA); PG8_STAGE(PG8_SB(0, 1), cB + hstep, voffB); PG8_STAGE(PG8_SA(0, 1), cA + hstep, voffA);
        if (wr == 1) PG8_BAR;
        PG8_WAIT_V(4); PG8_BAR;
        PG8_STAGE(PG8_SB(1, 0), cB + kstep, voffB); PG8_STAGE(PG8_SA(1, 0), cA + kstep, voffA); PG8_STAGE(PG8_SB(1, 1), cB + hstep + kstep, voffB);
        PG8_WAIT_V(6); PG8_BAR;
    }
    for (;;) {
        const bool has_next = S.next(ui + 1, nxt);
        const char* nA = has_next ? (const char*)g.A + (size_t)nxt.pm * tstep : cA; const char* nB = has_next ? (const char*)g.Bt + (size_t)nxt.pn * tstep : cB;
        for (int t = 0; t < nt; t += 2) {
            const bool last = (t == nt - 2);
            const char* a1 = cA + (size_t)(t + 1) * kstep;
            const char* a2 = last ? nA : cA + (size_t)(t + 2) * kstep; const char* b2 = last ? nB : cB + (size_t)(t + 2) * kstep;
            const char* a3 = a2 + kstep; const char* b3 = b2 + kstep;
            if (last && has_next) S.a_ready(nxt);
            if constexpr (SP2) {
            PG8_LDB(B0, 0, 0); PG8_LDB(B1, 0, 1); PG8_SCHED; PG8_LDA(At, 0, 0); PG8_STAGE(PG8_SA(1, 1), a1 + hstep, voffA);
            PG8_WAIT_V(8); PG8_WAIT_L(0); PG8_BAR; if (cur.hm & 1) { PG8_MMA(0, 0, At, B0); PG8_MMA(0, 1, At, B1); } PG8_BAR; PG8_SCHED;
            PG8_LDA(At, 0, 1); PG8_STAGE(PG8_SB(0, 0), b2, voffB); PG8_STAGE(PG8_SB(0, 1), b2 + hstep, voffB); PG8_STAGE(PG8_SA(0, 0), a2, voffA);
            PG8_WAIT_V(8); PG8_WAIT_L(0); PG8_BAR; if (cur.hm & 2) { PG8_MMA(1, 0, At, B0); PG8_MMA(1, 1, At, B1); } PG8_BAR; PG8_SCHED;
            PG8_LDB(B0, 1, 0); PG8_LDB(B1, 1, 1); PG8_SCHED; PG8_LDA(At, 1, 0); PG8_STAGE(PG8_SA(0, 1), a2 + hstep, voffA);
            PG8_WAIT_V(8); PG8_WAIT_L(0); PG8_BAR; if (cur.hm & 1) { PG8_MMA(0, 0, At, B0); PG8_MMA(0, 1, At, B1); } PG8_BAR; PG8_SCHED;
            PG8_LDA(At, 1, 1); PG8_STAGE(PG8_SB(1, 0), b3, voffB); PG8_STAGE(PG8_SB(1, 1), b3 + hstep, voffB); PG8_STAGE(PG8_SA(1, 0), a3, voffA);
            PG8_WAIT_V(8); PG8_WAIT_L(0); PG8_BAR; if (cur.hm & 2) { PG8_MMA(1, 0, At, B0); PG8_MMA(1, 1, At, B1); } PG8_BAR; PG8_SCHED;
            } else {
            PG8_LDB(B0, 0, 0); PG8_SCHED; PG8_LDA(At, 0, 0); PG8_STAGE(PG8_SA(1, 1), a1 + hstep, voffA);
            PG8_WAIT_L(8); PG8_BAR; PG8_WAIT_L(0); PG8_MMA(0, 0, At, B0); PG8_BAR; PG8_SCHED;
            PG8_LDB(B1, 0, 1); PG8_STAGE(PG8_SB(0, 0), b2, voffB);
            PG8_BAR; PG8_WAIT_L(0); PG8_MMA(0, 1, At, B1); PG8_BAR;
            PG8_LDA(At, 0, 1); PG8_STAGE(PG8_SA(0, 0), a2, voffA);
            PG8_BAR; PG8_WAIT_L(0); PG8_MMA(1, 0, At, B0); PG8_BAR; PG8_SCHED;
            PG8_STAGE(PG8_SB(0, 1), b2 + hstep, voffB);
            PG8_WAIT_V(6); PG8_BAR; PG8_MMA(1, 1, At, B1); PG8_BAR;
            PG8_LDB(B0, 1, 0); PG8_SCHED; PG8_LDA(At, 1, 0); PG8_STAGE(PG8_SA(0, 1), a2 + hstep, voffA);
            PG8_WAIT_L(8); PG8_BAR; PG8_WAIT_L(0); PG8_MMA(0, 0, At, B0); PG8_BAR; PG8_SCHED;
            PG8_LDB(B1, 1, 1); PG8_STAGE(PG8_SB(1, 0), b3, voffB);
            PG8_BAR; PG8_WAIT_L(0); PG8_MMA(0, 1, At, B1); PG8_BAR;
            PG8_LDA(At, 1, 1); PG8_STAGE(PG8_SA(1, 0), a3, voffA);
            PG8_BAR; PG8_WAIT_L(0); PG8_MMA(1, 0, At, B0); PG8_BAR; PG8_SCHED;
            PG8_STAGE(PG8_SB(1, 1), b3 + hstep, voffB);
            PG8_WAIT_V(6); PG8_BAR; PG8_MMA(1, 1, At, B1); PG8_BAR;
            }
        }
        if constexpr (ALIGN_EPI) { if (wr == 0) PG8_BAR; }
        if constexpr (!Epi::AFTER_DRAIN) { E(acc, cur, wr, wc, fr, fq); S.done(cur); }
        if (!has_next) break;
#pragma unroll
        for (int a = 0; a < 2; ++a)
#pragma unroll
            for (int b = 0; b < 2; ++b)
#pragma unroll
                for (int m = 0; m < 4; ++m)
#pragma unroll
                    for (int n = 0; n < 2; ++n) acc[a][b][m][n] = (f32x4){0.f, 0.f, 0.f, 0.f};
        cur = nxt; cA = nA; cB = nB; ++ui;
        if constexpr (ALIGN_EPI) { if (wr == 1) PG8_BAR; }
    }
    PG8_WAIT_V(0);
    if constexpr (!ALIGN_EPI) { if (wr == 0) PG8_BAR; }
    PG8_BAR;
    if constexpr (Epi::AFTER_DRAIN) { E.fused(acc, cur, wr, wc, fr, fq, lds, wid, lane); S.done(cur); }
#undef PG8_SA
#undef PG8_SB
#undef PG8_STAGE
#undef PG8_LDA
#undef PG8_LDB
#undef PG8_MMA
#undef PG8_WAIT_V
#undef PG8_WAIT_L
#undef PG8_BAR
#undef PG8_SCHED
}
}
using pg8::bf16_t; using pg8::bf16x8; using pg8::f32x4; using pg8::u32x4; using pg8::Unit; using pg8::cvt_pk_bf16;
typedef float f32x16 __attribute__((ext_vector_type(16)));
typedef unsigned u32x2 __attribute__((ext_vector_type(2)));
#define LAS __attribute__((address_space(3)))

constexpr int DM = 1024, SEQ = 2048, DSEQ = 64;
constexpr int MP = 16 * 2048, MS = 32 * 64, MT = MP + MS;
constexpr int DFF = 2816, LDP = 2880;
constexpr int KSA_ROWS = 576, KSB_ROWS = 2112;
constexpr float EPS = 1e-6f, LOG2E = 1.4426950408889634f, QSCALE = 0.125f * 1.4426950408889634f;
constexpr int NPHASE = 15;
#ifndef DOWN_WGM
#define DOWN_WGM 8
#endif
constexpr size_t MiB = 1u << 20;
constexpr size_t WS_CTL = 0, WS_BAR = 65536, WS_SSQ = 1 * MiB, WS_ROPE = 2 * MiB, WS_W = 4 * MiB;
constexpr size_t W_GU1 = 0, W_D1 = 11 * MiB, W_IN = 17 * MiB, W_OUT = 23 * MiB, W_GU2 = 25 * MiB, W_D2 = 36 * MiB, W_LAYER = 42 * MiB;
constexpr size_t WS_XB = 88 * MiB, WS_A = 156 * MiB, WS_QA = WS_A, WS_QB = WS_A + 34 * MiB, WS_O = WS_A + 68 * MiB;
constexpr size_t WS_KAP = 352 * MiB, WS_KBP = 384 * MiB, WS_VAP = 416 * MiB, WS_VBP = 448 * MiB;
constexpr size_t WS_KSA = 480 * MiB, WS_VSA = 516 * MiB, WS_KSB = 552 * MiB, WS_VSB = 684 * MiB, WS_END = 816 * MiB;
static_assert(W_D2 + (size_t)1024 * LDP * 2 <= W_LAYER && WS_W + 2 * W_LAYER <= WS_XB && WS_A + (size_t)MT * LDP * 2 <= WS_KAP, "d_ws map");
constexpr size_t OUT_YP = 0, OUT_YS = 33554432, OUT_PAK = 35651584, OUT_PAV = 44040192, OUT_PBK = 52428800, OUT_PBV = 85983232,
                 OUT_SAK = 119537664, OUT_SAV = 121634816, OUT_SBK = 123731968, OUT_SBV = 125829120;
constexpr int LDS_BYTES = 147456;

struct Args { const float* in[27]; float* out; unsigned char* ws; int ph_lo, ph_hi, coop, pad; };
typedef const __attribute__((address_space(4))) Args* KArgP;

__device__ const double ROPE_INV[32] = {1.0, 0.7498942093324559, 0.5623413251903491, 0.4216965034285822, 0.31622776601683794, 0.23713737056616552, 0.1778279410038923, 0.1333521432163324, 0.1, 0.07498942093324558, 0.05623413251903491, 0.042169650342858224, 0.03162277660168379, 0.023713737056616554, 0.01778279410038923, 0.01333521432163324, 0.01, 0.007498942093324558, 0.005623413251903491, 0.004216965034285823, 0.0031622776601683794, 0.0023713737056616554, 0.0017782794100389228, 0.001333521432163324, 0.001, 0.0007498942093324559, 0.0005623413251903491, 0.00042169650342858224, 0.00031622776601683794, 0.00023713737056616554, 0.00017782794100389227, 0.0001333521432163324};

__device__ __forceinline__ float shx(float v, int lane, int m) { return __builtin_bit_cast(float, __builtin_amdgcn_ds_bpermute((lane ^ m) << 2, __builtin_bit_cast(int, v))); }
__device__ __forceinline__ float wave_sum(float v, int lane) {
#pragma unroll
    for (int o = 1; o < 64; o <<= 1) v += shx(v, lane, o);
    return v;
}
__device__ __forceinline__ float wave_max(float v, int lane) {
#pragma unroll
    for (int o = 1; o < 64; o <<= 1) v = fmaxf(v, shx(v, lane, o));
    return v;
}
__device__ __forceinline__ float fast_rcp(float x) { return __builtin_amdgcn_rcpf(x); }
__device__ __forceinline__ float fast_exp2(float x) { return __builtin_amdgcn_exp2f(x); }

struct EpiSwiGLU {
    static constexpr bool PERM = true, AFTER_DRAIN = false;
    bf16_t* O; const float* ssq;
    __device__ __forceinline__ void operator()(const f32x4 (&acc)[2][2][4][2], const Unit& u, int wr, int wc, int fr, int fq) const {
        const int row0 = u.pm * 256 + wr * 64 + fr, col0 = u.pn * 128 + wc * 32 + 8 * fq;
        float sq[2][4];
#pragma unroll
        for (int ai = 0; ai < 2; ++ai)
#pragma unroll
            for (int m = 0; m < 4; ++m) sq[ai][m] = ssq[row0 + ai * 128 + m * 16];
#pragma unroll
        for (int ai = 0; ai < 2; ++ai)
#pragma unroll
            for (int m = 0; m < 4; ++m) {
                if (!((u.hm >> ai) & 1)) continue;
                const int row = row0 + ai * 128 + m * 16;
                const float rstd = rsqrtf(sq[ai][m] * (1.0f / DM) + EPS);
                float o[8];
#pragma unroll
                for (int n = 0; n < 2; ++n)
#pragma unroll
                    for (int i = 0; i < 4; ++i) {
                        const float g = acc[ai][0][m][n][i] * rstd, up = acc[ai][1][m][n][i] * rstd;
                        const float sg = g * fast_rcp(1.0f + fast_exp2(-g * LOG2E));
                        o[n * 4 + i] = sg * up;
                    }
                u32x4 w; w.x = cvt_pk_bf16(o[0], o[1]); w.y = cvt_pk_bf16(o[2], o[3]); w.z = cvt_pk_bf16(o[4], o[5]); w.w = cvt_pk_bf16(o[6], o[7]);
                *(u32x4*)(O + (((size_t)(row >> 8) * (DFF / 64) + (col0 >> 6)) * 256 + (row & 255)) * 64 + (col0 & 63)) = w;
            }
    }
};
struct EpiResid {
    static constexpr bool PERM = false, AFTER_DRAIN = false;
    const float* xin_p; const float* xin_s; float* xout; bf16_t* xb; float* ssq; float scale;
    __device__ __forceinline__ void operator()(const f32x4 (&acc)[2][2][4][2], const Unit& u, int wr, int wc, int fr, int fq) const {
        const int col0 = u.pn * 256 + wc * 32 + 4 * fq;
#pragma unroll
        for (int ai = 0; ai < 2; ++ai) {
            if (!((u.hm >> ai) & 1)) continue;
            const int rowb = u.pm * 256 + ai * 128 + wr * 64 + fr;
            const float* xi = (rowb < MP) ? xin_p + (size_t)rowb * DM : xin_s + (size_t)(rowb - MP) * DM;
            f32x4 pre[4][2][2];
#pragma unroll
            for (int m = 0; m < 4; ++m)
#pragma unroll
                for (int bj = 0; bj < 2; ++bj)
#pragma unroll
                    for (int n = 0; n < 2; ++n) pre[m][bj][n] = *(const f32x4*)(xi + (size_t)m * 16 * DM + col0 + bj * 128 + n * 16);
#pragma unroll
            for (int m = 0; m < 4; ++m) {
                const int row = rowb + m * 16;
                float sq = 0.f;
#pragma unroll
                for (int bj = 0; bj < 2; ++bj)
#pragma unroll
                    for (int n = 0; n < 2; ++n) {
                        const int c = col0 + bj * 128 + n * 16;
                        const f32x4 v = pre[m][bj][n] + acc[ai][bj][m][n] * scale;
                        *(f32x4*)(xout + (size_t)row * DM + c) = v;
                        u32x2 w; w.x = cvt_pk_bf16(v[0], v[1]); w.y = cvt_pk_bf16(v[2], v[3]);
                        *(u32x2*)(xb + (size_t)row * DM + c) = w;
                        sq += (v[0] * v[0] + v[1] * v[1]) + (v[2] * v[2] + v[3] * v[3]);
                    }
                sq += shx(sq, fr + 16 * fq, 16); sq += shx(sq, fr + 16 * fq, 32);
                if (fq == 0) atomicAdd(ssq + row, sq);
            }
        }
    }
};
struct EpiQK {
    static constexpr bool PERM = true, AFTER_DRAIN = false;
    const float* ssq; unsigned char* ws; float* out; KArgP kap; int l;
    __device__ __forceinline__ void operator()(const f32x4 (&acc)[2][2][4][2], const Unit& u, int wr, int wc, int fr, int fq) const {
        const int sec = u.pn >> 1, hd = 4 * (u.pn & 1) + wc;
        const float* gp = kap->in[12 + sec] + l * 64;
        const float* rope = (const float*)(ws + WS_ROPE);
        bf16_t* QA = (bf16_t*)(ws + WS_QA); bf16_t* QB = (bf16_t*)(ws + WS_QB); bf16_t* KAP = (bf16_t*)(ws + WS_KAP); bf16_t* KBP = (bf16_t*)(ws + WS_KBP);
        bf16_t* KSA = (bf16_t*)(ws + WS_KSA) + (size_t)l * 32 * KSA_ROWS * 512; bf16_t* KSB = (bf16_t*)(ws + WS_KSB) + (size_t)l * 32 * KSB_ROWS * 512;
        float* oPAK = out + OUT_PAK + (size_t)l * 16 * 512 * 512; float* oPBK = out + OUT_PBK + (size_t)l * MP * 512;
        float* oSAK = out + OUT_SAK + (size_t)l * MS * 512; float* oSBK = out + OUT_SBK + (size_t)l * MS * 512;
        f32x4 gl[2], gh[2];
#pragma unroll
        for (int n = 0; n < 2; ++n) { gl[n] = *(const f32x4*)(gp + 8 * fq + 4 * n); gh[n] = *(const f32x4*)(gp + 32 + 8 * fq + 4 * n); }
        const int cbase = hd * 64 + 8 * fq;
        float sqr[2][4];
#pragma unroll
        for (int ai = 0; ai < 2; ++ai)
#pragma unroll
            for (int m = 0; m < 4; ++m) sqr[ai][m] = ssq[u.pm * 256 + ai * 128 + wr * 64 + m * 16 + fr];
#pragma unroll
        for (int ai = 0; ai < 2; ++ai)
#pragma unroll
            for (int m = 0; m < 4; ++m) {
                if (!((u.hm >> ai) & 1)) continue;
                const int row = u.pm * 256 + ai * 128 + wr * 64 + m * 16 + fr;
                const float rstd = rsqrtf(sqr[ai][m] * (1.0f / DM) + EPS);
                f32x4 y[2][2]; float ss = 0.f;
#pragma unroll
                for (int bj = 0; bj < 2; ++bj)
#pragma unroll
                    for (int n = 0; n < 2; ++n) { const f32x4 v = acc[ai][bj][m][n] * rstd; y[bj][n] = v; ss += (v[0] * v[0] + v[1] * v[1]) + (v[2] * v[2] + v[3] * v[3]); }
                ss += shx(ss, fr + 16 * fq, 16); ss += shx(ss, fr + 16 * fq, 32);
                const float rr = rsqrtf(ss * (1.0f / 64.0f) + EPS);
#pragma unroll
                for (int n = 0; n < 2; ++n) { y[0][n] = y[0][n] * rr * gl[n]; y[1][n] = y[1][n] * rr * gh[n]; }
                const bool prompt = row < MP;
                const int sp = row & 2047, bp = row >> 11, ts = (row - MP) & 63, bs = (row - MP) >> 6;
                if (sec >= 2) {
                    const int pos = prompt ? sp : 2048 + ts;
                    const float* cs = rope + (size_t)pos * 64 + 8 * fq;
#pragma unroll
                    for (int n = 0; n < 2; ++n) {
                        const f32x4 c = *(const f32x4*)(cs + 4 * n), s = *(const f32x4*)(cs + 32 + 4 * n);
                        const f32x4 x1 = y[0][n], x2 = y[1][n];
                        y[0][n] = x1 * c - x2 * s; y[1][n] = x2 * c + x1 * s;
                    }
                }
                if (sec == 0 || sec == 2) {
                    bf16_t* dst = (sec == 0 ? QA : QB) + (size_t)row * 512 + cbase;
#pragma unroll
                    for (int bj = 0; bj < 2; ++bj) {
                        const f32x4 a = y[bj][0] * QSCALE, b = y[bj][1] * QSCALE;
                        u32x4 w; w.x = cvt_pk_bf16(a[0], a[1]); w.y = cvt_pk_bf16(a[2], a[3]); w.z = cvt_pk_bf16(b[0], b[1]); w.w = cvt_pk_bf16(b[2], b[3]);
                        *(u32x4*)(dst + 32 * bj) = w;
                    }
                } else {
                    bf16_t* dst; float* fo = nullptr;
                    if (sec == 1) {
                        if (prompt) { dst = KAP + (size_t)row * 512; if (sp >= 1536) fo = oPAK + (size_t)(bp * 512 + sp - 1536) * 512; }
                        else { dst = KSA + (size_t)(bs * KSA_ROWS + 512 + ts) * 512; fo = oSAK + (size_t)(row - MP) * 512; }
                    } else {
                        if (prompt) { dst = KBP + (size_t)row * 512; fo = oPBK + (size_t)row * 512; }
                        else { dst = KSB + (size_t)(bs * KSB_ROWS + 2048 + ts) * 512; fo = oSBK + (size_t)(row - MP) * 512; }
                    }
#pragma unroll
                    for (int bj = 0; bj < 2; ++bj) {
                        const f32x4 a = y[bj][0], b = y[bj][1];
                        u32x4 w; w.x = cvt_pk_bf16(a[0], a[1]); w.y = cvt_pk_bf16(a[2], a[3]); w.z = cvt_pk_bf16(b[0], b[1]); w.w = cvt_pk_bf16(b[2], b[3]);
                        *(u32x4*)(dst + cbase + 32 * bj) = w;
                        if (fo) { *(f32x4*)(fo + cbase + 32 * bj) = a; *(f32x4*)(fo + cbase + 32 * bj + 4) = b; }
                    }
                }
            }
    }
};
struct EpiVt {
    static constexpr bool PERM = true, AFTER_DRAIN = false;
    const float* ssq; unsigned char* ws; float* out; int l;
    __device__ __forceinline__ void operator()(const f32x4 (&acc)[2][2][4][2], const Unit& u, int wr, int wc, int fr, int fq) const {
        bf16_t* VAP = (bf16_t*)(ws + WS_VAP); bf16_t* VBP = (bf16_t*)(ws + WS_VBP);
        bf16_t* VSA = (bf16_t*)(ws + WS_VSA) + (size_t)l * 32 * 512 * KSA_ROWS; bf16_t* VSB = (bf16_t*)(ws + WS_VSB) + (size_t)l * 32 * 512 * KSB_ROWS;
        float* oPAV = out + OUT_PAV + (size_t)l * 16 * 512 * 512; float* oPBV = out + OUT_PBV + (size_t)l * MP * 512;
        float* oSAV = out + OUT_SAV + (size_t)l * MS * 512; float* oSBV = out + OUT_SBV + (size_t)l * MS * 512;
        const int grp = u.pm >> 1;
        const bool prompt = u.pn < (MP / 256);
        f32x4 rs[2][2];
#pragma unroll
        for (int bj = 0; bj < 2; ++bj)
#pragma unroll
            for (int n = 0; n < 2; ++n) {
                const f32x4 q = *(const f32x4*)(ssq + u.pn * 256 + bj * 128 + wc * 32 + 8 * fq + 4 * n);
                f32x4 r; r[0] = rsqrtf(q[0] * (1.0f / DM) + EPS); r[1] = rsqrtf(q[1] * (1.0f / DM) + EPS); r[2] = rsqrtf(q[2] * (1.0f / DM) + EPS); r[3] = rsqrtf(q[3] * (1.0f / DM) + EPS);
                rs[bj][n] = r;
            }
#pragma unroll
        for (int bj = 0; bj < 2; ++bj) {
            const int tok = u.pn * 256 + bj * 128 + wc * 32 + 8 * fq;
            const int bp = tok >> 11, sp = tok & 2047, tt = tok - MP, bs = tt >> 6, ts = tt & 63;
            bf16_t* vdst; size_t vld; float* fo = nullptr;
            if (prompt) { vdst = (grp == 0 ? VAP : VBP) + (size_t)bp * 512 * 2048 + sp; vld = 2048;
                if (grp == 0) { if (sp >= 1536) fo = oPAV + (size_t)(bp * 512 + sp - 1536) * 512; } else fo = oPBV + (size_t)tok * 512; }
            else { if (grp == 0) { vdst = VSA + (size_t)bs * 512 * KSA_ROWS + 512 + ts; vld = KSA_ROWS; fo = oSAV + (size_t)tt * 512; }
                   else { vdst = VSB + (size_t)bs * 512 * KSB_ROWS + 2048 + ts; vld = KSB_ROWS; fo = oSBV + (size_t)tt * 512; } }
#pragma unroll
            for (int ai = 0; ai < 2; ++ai)
#pragma unroll
                for (int m = 0; m < 4; ++m) {
                    if (!((u.hm >> ai) & 1)) continue;
                    const int hrow = (ai * 128 + wr * 64 + m * 16 + fr) + (u.pm & 1) * 256;
                    const f32x4 a = acc[ai][bj][m][0] * rs[bj][0], b = acc[ai][bj][m][1] * rs[bj][1];
                    u32x4 w; w.x = cvt_pk_bf16(a[0], a[1]); w.y = cvt_pk_bf16(a[2], a[3]); w.z = cvt_pk_bf16(b[0], b[1]); w.w = cvt_pk_bf16(b[2], b[3]);
                    *(u32x4*)(vdst + (size_t)hrow * vld) = w;
                    if (fo) {
#pragma unroll
                        for (int i = 0; i < 4; ++i) { fo[(size_t)i * 512 + hrow] = a[i]; fo[(size_t)(4 + i) * 512 + hrow] = b[i]; }
                    }
                }
        }
    }
};
#define XB_TMO      128
#define XB_XCNT(j)  (256  + 64 * (j))
#define XB_XSUB(j)  (1280 + 64 * (j))
#define XB_XGEN(j)  (2304 + 64 * (j))
#define XB_TOP      3328
#define XB_TOPGEN   3392
#define XCD_BAR_WORDS 3456
#define XB_SPIN_CAP (1u << 18)

__device__ __forceinline__ unsigned xb_ld(unsigned* p)              { return __hip_atomic_load(p, __ATOMIC_RELAXED, __HIP_MEMORY_SCOPE_AGENT); }
__device__ __forceinline__ unsigned xb_add(unsigned* p, unsigned v) { return __hip_atomic_fetch_add(p, v, __ATOMIC_RELAXED, __HIP_MEMORY_SCOPE_AGENT); }
__device__ __forceinline__ unsigned xb_xcc_id() { return (unsigned)__builtin_amdgcn_s_getreg((3 << 11) | 20) & 0xFu; }
#define XB_SPIN(cond, bar) do { unsigned _sp = 0; while (cond) { __builtin_amdgcn_s_sleep(1); \
    if ((++_sp & 255u) == 0u) { if (xb_ld(&(bar)[XB_TMO])) break; if (_sp > XB_SPIN_CAP) { atomicAdd(&(bar)[XB_TMO], 1u); break; } } } } while (0)

struct XcdBarrier {
    unsigned* bar; unsigned x;
    volatile LAS unsigned* st;
};

__device__ __forceinline__ XcdBarrier xcd_barrier_post(unsigned* bar, volatile LAS unsigned* st) {
    XcdBarrier b; b.bar = bar; b.x = xb_xcc_id(); b.st = st;
    if (threadIdx.x == 0) (void)xb_add(&bar[XB_XCNT(b.x)], 1u);
    return b;
}
__device__ __forceinline__ void xcd_barrier_complete(unsigned* bar, unsigned x, unsigned& nloc, unsigned& nx) {
    const unsigned G = gridDim.x * gridDim.y * gridDim.z;
    unsigned sum, cnt, mine, sp = 0u;
    for (;;) {
        sum = 0u; cnt = 0u; mine = 0u;
#pragma unroll
        for (unsigned j = 0; j < 16; ++j) { const unsigned c = xb_ld(&bar[XB_XCNT(j)]); sum += c; cnt += (c > 0u) ? 1u : 0u; mine = (j == x) ? c : mine; }
        if (sum == G) break;
        __builtin_amdgcn_s_sleep(1);
        if ((++sp & 255u) == 0u) { if (xb_ld(&bar[XB_TMO])) break; if (sp > XB_SPIN_CAP) { atomicAdd(&bar[XB_TMO], 1u); break; } }
    }
    nloc = mine > 0u ? mine : 1u; nx = cnt > 0u ? cnt : 1u;
}

__device__ __forceinline__ void xcd_barrier(const XcdBarrier& b) {
    asm volatile("s_waitcnt vmcnt(0)" ::: "memory");
    __syncthreads();
    if (threadIdx.x == 0) {
        unsigned* bar = b.bar;
        __builtin_amdgcn_s_waitcnt(0);
        unsigned nloc = b.st[0], nx = b.st[1];
        if (nloc == 0u) { xcd_barrier_complete(bar, b.x, nloc, nx); b.st[0] = nloc; b.st[1] = nx; }
        const unsigned old = xb_add(&bar[XB_XSUB(b.x)], 1u);
        const unsigned gen = old / nloc;
        if (old + 1u == (gen + 1u) * nloc) {
            __builtin_amdgcn_fence(__ATOMIC_RELEASE, "agent");
            asm volatile("s_waitcnt vmcnt(0)" ::: "memory");
            const unsigned og = xb_add(&bar[XB_TOP], 1u);
            const unsigned tg = og / nx;
            if (og + 1u == (tg + 1u) * nx) xb_add(&bar[XB_TOPGEN], 1u);
            else XB_SPIN(xb_ld(&bar[XB_TOPGEN]) == tg, bar);
            __builtin_amdgcn_fence(__ATOMIC_ACQUIRE, "agent");
            xb_add(&bar[XB_XGEN(b.x)], 1u);
            asm volatile("s_waitcnt vmcnt(0)" ::: "memory");
        } else {
            XB_SPIN(xb_ld(&bar[XB_XGEN(b.x)]) == gen, bar);
            __builtin_amdgcn_fence(__ATOMIC_ACQUIRE, "agent");
            asm volatile("s_waitcnt vmcnt(0)" ::: "memory");
        }
    }
    __syncthreads();
}
__device__ __forceinline__ int map_row(int kind, int n) {
    if (kind == 0) return n;
    if (kind == 1) return 256 * (n >> 7) + (n & 127);
    if (kind == 2) return 256 * (n >> 7) + 128 + (n & 127);
    const int sec = n >> 9, w = n & 511;
    if (sec == 2) return 2048 + w;
    if (sec == 5) return 2560 + w;
    const int qsec = sec == 0 ? 0 : sec == 1 ? 1 : sec == 3 ? 2 : 3;
    const int c = qsec * 512 + w, pn = c >> 8, ww = c & 255, hw = ww >> 6, d = ww & 63;
    return 256 * pn + 128 * (d >> 5) + 32 * hw + (d & 31);
}
__device__ __forceinline__ void transpose_item(const float* src, int ld_src, int k0, int n0, const float* gain, bf16_t* dst, size_t ld_dst, int kind, LAS float* scr, int lane) {
#pragma unroll 8
    for (int i = 0; i < 32; ++i) {
        const int kk = 2 * i + (lane >> 5);
        float v = src[(size_t)(k0 + kk) * ld_src + n0 + (lane & 31)];
        if (gain) v *= gain[k0 + kk];
        scr[kk * 33 + (lane & 31)] = v;
    }
    asm volatile("s_waitcnt lgkmcnt(0)" ::: "memory");
    const int c = lane & 7;
#pragma unroll
    for (int j = 0; j < 4; ++j) {
        const int n = (lane >> 3) + 8 * j; const LAS float* s = scr + (8 * c) * 33 + n;
        u32x4 o; o.x = cvt_pk_bf16(s[0 * 33], s[1 * 33]); o.y = cvt_pk_bf16(s[2 * 33], s[3 * 33]); o.z = cvt_pk_bf16(s[4 * 33], s[5 * 33]); o.w = cvt_pk_bf16(s[6 * 33], s[7 * 33]);
        if (kind == 4) { const int row = n0 + n; *(u32x4*)(dst + (((size_t)(row >> 8) * (DFF / 64) + (k0 >> 6)) * 256 + (row & 255)) * 64 + 8 * c) = o; }
        else *(u32x4*)(dst + (size_t)map_row(kind, n0 + n) * ld_dst + k0 + 8 * c) = o;
    }
    asm volatile("s_waitcnt lgkmcnt(0)" ::: "memory");
}
__device__ __forceinline__ void do_job(const float* src, int R, int C, const float* gain, bf16_t* dst, size_t ld_dst, int kind, int item, LAS float* scr, int lane) {
    const int nblk = C >> 5, kb = item / nblk, nb = item - kb * nblk;
    (void)R;
    transpose_item(src, C, 64 * kb, 32 * nb, gain, dst, ld_dst, kind, scr, lane);
}

__device__ __forceinline__ void convert_caches(KArgP A, LAS unsigned char* lds, int l, int gw, int NGW, int wave) {
    int lane_l = lane_id_fresh(); asm volatile("" : "+v"(lane_l)); const int lane = lane_l;
    unsigned char* ws = A->ws;
    LAS float* scr = (LAS float*)(lds + wave * 16384);
    constexpr int I_CAV = 32 * 128;
    for (int it = gw; it < I_CAV; it += NGW) {
        {
            const int lb = l * 32 + (it >> 7), item = it & 127;
            do_job(A->in[3] + (size_t)lb * 512 * 512, 512, 512, nullptr, (bf16_t*)(ws + WS_VSA) + (size_t)lb * 512 * KSA_ROWS, KSA_ROWS, 0, item, scr, lane);
        }
    }
    for (int r = gw; r < 32 * 512; r += NGW) {
        const float* s; bf16_t* d;
        if (r < 32 * 512) { const int lb = l * 32 + (r >> 9), key = r & 511; s = A->in[2] + ((size_t)lb * 512 + key) * 512; d = (bf16_t*)(ws + WS_KSA) + (size_t)(lb * KSA_ROWS + key) * 512; }
        else { const int q = r - 32 * 512, lb = l * 32 + (q >> 11), key = q & 2047; s = A->in[4] + ((size_t)lb * 2048 + key) * 512; d = (bf16_t*)(ws + WS_KSB) + (size_t)(lb * KSB_ROWS + key) * 512; }
        const f32x4 a = *(const f32x4*)(s + 8 * lane), b = *(const f32x4*)(s + 8 * lane + 4);
        u32x4 w; w.x = cvt_pk_bf16(a[0], a[1]); w.y = cvt_pk_bf16(a[2], a[3]); w.z = cvt_pk_bf16(b[0], b[1]); w.w = cvt_pk_bf16(b[2], b[3]);
        *(u32x4*)(d + 8 * lane) = w;
    }
}

__device__ __forceinline__ void prologue(KArgP A, LAS unsigned char* lds, int gw, int NGW, int wave) {
    int lane_l = lane_id_fresh(); asm volatile("" : "+v"(lane_l)); const int lane = lane_l;
    unsigned char* ws = A->ws;
    LAS float* scr = (LAS float*)(lds + wave * 16384);
    constexpr int I_GU = 16 * 88, I_D = 44 * 32, I_IN = 16 * 96, I_O = 16 * 32;
    constexpr int I_LAYER = 4 * I_GU + 2 * I_D + I_IN + I_O;
    constexpr int I_W = 2 * I_LAYER;
    for (int it = gw; it < I_W; it += NGW) {
        {
            const int l = it / I_LAYER; int r = it - l * I_LAYER;
            unsigned char* wl = ws + WS_W + (size_t)l * W_LAYER;
            const float* gf1 = A->in[6] + l * DM; const float* gmx = A->in[10] + l * DM; const float* gf2 = A->in[23] + l * DM;
            if (r < I_GU) { do_job(A->in[7] + (size_t)l * DM * DFF, DM, DFF, gf1, (bf16_t*)(wl + W_GU1), DM, 1, r, scr, lane); continue; } r -= I_GU;
            if (r < I_GU) { do_job(A->in[8] + (size_t)l * DM * DFF, DM, DFF, gf1, (bf16_t*)(wl + W_GU1), DM, 2, r, scr, lane); continue; } r -= I_GU;
            if (r < I_D)  { do_job(A->in[9] + (size_t)l * DM * DFF, DFF, DM, nullptr, (bf16_t*)(wl + W_D1), LDP, 4, r, scr, lane); continue; } r -= I_D;
            if (r < I_IN) { do_job(A->in[11] + (size_t)l * DM * 3072, DM, 3072, gmx, (bf16_t*)(wl + W_IN), DM, 3, r, scr, lane); continue; } r -= I_IN;
            if (r < I_O)  { do_job(A->in[22] + (size_t)l * DM * DM, DM, DM, nullptr, (bf16_t*)(wl + W_OUT), DM, 0, r, scr, lane); continue; } r -= I_O;
            if (r < I_GU) { do_job(A->in[24] + (size_t)l * DM * DFF, DM, DFF, gf2, (bf16_t*)(wl + W_GU2), DM, 1, r, scr, lane); continue; } r -= I_GU;
            if (r < I_GU) { do_job(A->in[25] + (size_t)l * DM * DFF, DM, DFF, gf2, (bf16_t*)(wl + W_GU2), DM, 2, r, scr, lane); continue; } r -= I_GU;
            do_job(A->in[26] + (size_t)l * DM * DFF, DFF, DM, nullptr, (bf16_t*)(wl + W_D2), LDP, 4, r, scr, lane);
        }
    }
    convert_caches(A, lds, 0, gw, NGW, wave);
    convert_caches(A, lds, 1, gw, NGW, wave);
    float* ssq = (float*)(ws + WS_SSQ);
    bf16_t* xb = (bf16_t*)(ws + WS_XB);
    for (int r = gw; r < MT; r += NGW) {
        const float* xr = (r < MP) ? A->in[0] + (size_t)r * DM : A->in[1] + (size_t)(r - MP) * DM;
        float s = 0.f;
#pragma unroll
        for (int j = 0; j < 4; ++j) {
            const f32x4 v = *(const f32x4*)(xr + 256 * j + 4 * lane);
            s += (v[0] * v[0] + v[1] * v[1]) + (v[2] * v[2] + v[3] * v[3]);
            u32x2 w; w.x = cvt_pk_bf16(v[0], v[1]); w.y = cvt_pk_bf16(v[2], v[3]);
            *(u32x2*)(xb + (size_t)r * DM + 256 * j + 4 * lane) = w;
        }
        s = wave_sum(s, lane);
        if (lane == 0) ssq[r] = s;
    }
    for (int i = gw * 64 + lane; i < 6 * MT; i += NGW * 64) ssq[MT + i] = 0.f;
    float* rope = (float*)(ws + WS_ROPE);
    for (int i = gw * 64 + lane; i < 2112 * 32; i += NGW * 64) {
        const int pos = i >> 5, j = i & 31;
        const double a = (double)((float)pos * (float)ROPE_INV[j]);
        const double kq = __builtin_rint(a * 0.63661977236758134308);
        const double rr = (a - kq * 1.5707963267948966192) - kq * 6.123233995736766e-17;
        const double r2 = rr * rr;
        const double sn = rr * (1.0 + r2 * (-1.0 / 6 + r2 * (1.0 / 120 + r2 * (-1.0 / 5040 + r2 * (1.0 / 362880 + r2 * (-1.0 / 39916800 + r2 * (1.0 / 6227020800.0)))))));
        const double cn = 1.0 + r2 * (-0.5 + r2 * (1.0 / 24 + r2 * (-1.0 / 720 + r2 * (1.0 / 40320 + r2 * (-1.0 / 3628800 + r2 * (1.0 / 479001600 + r2 * (-1.0 / 87178291200.0)))))));
        const int q = ((int)kq) & 3;
        const double c = q == 0 ? cn : q == 1 ? -sn : q == 2 ? -cn : sn;
        const double s = q == 0 ? sn : q == 1 ? cn : q == 2 ? -sn : -cn;
        rope[(size_t)pos * 64 + j] = (float)c; rope[(size_t)pos * 64 + 32 + j] = (float)s;
    }
    if (gw == 0) {
        unsigned* ctl = (unsigned*)(ws + WS_CTL);
        float* cst = (float*)(ws + WS_CTL + 4096);
        if (lane < 16) ctl[lane] = 0u;
        for (int i = lane; i < XCD_BAR_WORDS; i += 64) ((unsigned*)(ws + WS_BAR))[i] = 0u;
        for (int l = 0; l < 2; ++l) {
            const float mqa = wave_max(fabsf(A->in[12][l * 64 + lane]), lane), mka = wave_max(fabsf(A->in[13][l * 64 + lane]), lane);
            const float mqb = wave_max(fabsf(A->in[14][l * 64 + lane]), lane), mkb = wave_max(fabsf(A->in[15][l * 64 + lane]), lane);
            float mb = 0.f;
            for (int i = lane; i < 8 * 257; i += 64) mb = fmaxf(mb, fabsf(A->in[16][l * 8 * 257 + i]));
            mb = wave_max(mb, lane);
            const float d1 = wave_sum(A->in[17][l * 64 + lane] * A->in[18][l * 64 + lane], lane), d2 = wave_sum(A->in[19][l * 64 + lane] * A->in[20][l * 64 + lane], lane);
            const float lam_init = l == 0 ? 0.2f : 0.35550906759096934f;
            if (lane == 0) {
                cst[l * 8 + 0] = LOG2E * (8.0f * mqa * mka + mb);
                cst[l * 8 + 1] = LOG2E * (8.0f * mqb * mkb);
                cst[l * 8 + 2] = expf(d1) - expf(d2) + lam_init;
                cst[l * 8 + 3] = 1.0f - lam_init;
            }
        }
    }
}

__device__ __forceinline__ int swap23(int r) { return (r & 19) | ((r & 4) << 1) | ((r & 8) >> 1); }
__device__ __forceinline__ f32x16 mfma32(bf16x8 a, bf16x8 b, f32x16 c) { return __builtin_amdgcn_mfma_f32_32x32x16_bf16(a, b, c, 0, 0, 0); }
__device__ __forceinline__ bf16x8 pack8(const f32x16& p, int s) {
    u32x4 w; w.x = cvt_pk_bf16(p[8 * s + 0], p[8 * s + 1]); w.y = cvt_pk_bf16(p[8 * s + 2], p[8 * s + 3]); w.z = cvt_pk_bf16(p[8 * s + 4], p[8 * s + 5]); w.w = cvt_pk_bf16(p[8 * s + 6], p[8 * s + 7]);
    return __builtin_bit_cast(bf16x8, w);
}
constexpr int ATT_BUF = 32768, ATT_WAVE = 65536, ATT_BW = 131072 + 64;

__device__ __forceinline__ void attn_a_block(const bf16_t* Qw, const bf16_t* Kb, const bf16_t* Vtb, int ldv, int T, int t_lo, int t_hi, int t_self, int qoff,
                                             bf16_t* Outw, LAS unsigned char* lds, int wave, int lane_in) {
    int lane = lane_in; asm volatile("" : "+v"(lane));
    const int r32 = lane & 31, hi = lane >> 5;
    const bool active = t_lo <= t_hi;
    const LAS float* E = (const LAS float*)(lds + ATT_WAVE + wave * 8192);
    bf16x8 qf[4];
#pragma unroll
    for (int d0 = 0; d0 < 4; ++d0) qf[d0] = active ? *(const bf16x8*)(Qw + (size_t)r32 * 512 + 16 * d0 + 8 * hi) : (bf16x8){0, 0, 0, 0, 0, 0, 0, 0};
    f32x16 o0, o1;
#pragma unroll
    for (int r = 0; r < 16; ++r) { o0[r] = 0.f; o1[r] = 0.f; }
    float l = 0.f;
    const float cfar = E[192];
    const int key_l = 8 * wave + (lane & 7), c8 = lane >> 3;
    const bf16_t* kg = Kb + (size_t)key_l * 512 + 8 * c8;
    const bf16_t* vg = Vtb + (size_t)key_l * ldv + 8 * c8;
    const int koff = ((key_l >> 5) * 4 + (c8 >> 1)) * 1024 + (swap23(key_l & 31) + 32 * (c8 & 1)) * 16;
    const int voff = 8192 + (((c8 >> 2) * 2 + (key_l >> 5)) * 2 + ((c8 >> 1) & 1)) * 1024 + ((key_l & 31) + 32 * (c8 & 1)) * 16;
    constexpr int ABUF = 16384;
    u32x4 skA = *(const u32x4*)kg, svA = *(const u32x4*)vg, skB = skA, svB = svA;
    if (T > 1) { skB = *(const u32x4*)(kg + (size_t)64 * 512); svB = *(const u32x4*)(vg + 64); }
    *(LAS u32x4*)(lds + koff) = skA; *(LAS u32x4*)(lds + voff) = svA;
    __syncthreads();
    int cb = 0;
#define A_STEP(t, LK, LV, WK, WV) do { \
        if ((t) + 2 < T) { LK = *(const u32x4*)(kg + (size_t)((t) + 2) * 64 * 512); LV = *(const u32x4*)(vg + ((t) + 2) * 64); } \
        if ((t) >= t_lo && (t) <= t_hi) { \
            const LAS bf16x8* KF = (const LAS bf16x8*)(lds + cb * ABUF); \
            const LAS bf16x8* VF = KF + 512; \
            _Pragma("unroll") for (int j = 0; j < 2; ++j) { \
                f32x16 sa; \
                const int relbase = 64 * (t_self - (t)) - 32 * j + qoff; \
                if (relbase - 31 >= 128) { _Pragma("unroll") for (int r = 0; r < 16; ++r) sa[r] = cfar; } \
                else { const int bi = relbase + 64 + r32 - 8 * hi - 23; _Pragma("unroll") for (int r = 0; r < 16; ++r) sa[r] = E[bi + 23 - (r & 7) - 16 * (r >> 3)]; } \
                _Pragma("unroll") for (int d0 = 0; d0 < 4; ++d0) sa = mfma32(KF[(j * 4 + d0) * 64 + lane], qf[d0], sa); \
                float ps = 0.f; \
                _Pragma("unroll") for (int r = 0; r < 16; ++r) { sa[r] = fast_exp2(sa[r]); ps += sa[r]; } \
                l += ps; \
                const bf16x8 p0 = pack8(sa, 0), p1 = pack8(sa, 1); \
                o0 = mfma32(VF[((j * 2 + 0) * 2 + 0) * 64 + lane], p0, o0); o0 = mfma32(VF[((j * 2 + 0) * 2 + 1) * 64 + lane], p1, o0); \
                o1 = mfma32(VF[((j * 2 + 1) * 2 + 0) * 64 + lane], p0, o1); o1 = mfma32(VF[((j * 2 + 1) * 2 + 1) * 64 + lane], p1, o1); \
            } \
        } \
        const int nb = cb == 2 ? 0 : cb + 1; \
        if ((t) + 1 < T) { *(LAS u32x4*)(lds + nb * ABUF + koff) = WK; *(LAS u32x4*)(lds + nb * ABUF + voff) = WV; } \
        cb = nb; \
        __syncthreads(); \
    } while (0)
    for (int t = 0; t < T; t += 2) {
        A_STEP(t, skA, svA, skB, svB);
        if (t + 1 < T) A_STEP(t + 1, skB, svB, skA, svA);
    }
#undef A_STEP
    if (active) {
        const int le = lane_id_fresh(), r32e = le & 31, hie = le >> 5;
        l += shx(l, le, 32);
        const float inv = 1.0f / l;
#pragma unroll
        for (int g = 0; g < 4; ++g) {
            u32x2 w0, w1;
            w0.x = cvt_pk_bf16(o0[4 * g] * inv, o0[4 * g + 1] * inv); w0.y = cvt_pk_bf16(o0[4 * g + 2] * inv, o0[4 * g + 3] * inv);
            w1.x = cvt_pk_bf16(o1[4 * g] * inv, o1[4 * g + 1] * inv); w1.y = cvt_pk_bf16(o1[4 * g + 2] * inv, o1[4 * g + 3] * inv);
            *(u32x2*)(Outw + (size_t)r32e * DM + 8 * g + 4 * hie) = w0;
            *(u32x2*)(Outw + (size_t)r32e * DM + 32 + 8 * g + 4 * hie) = w1;
        }
    }
}
__device__ __forceinline__ void attn_b_block(const bf16_t* Qw, const bf16_t* Kb, const bf16_t* Vtb, int ldv, int T, int tlim, float nshift, float lam, float post, const float* gsub,
                                             bf16_t* Outw, LAS unsigned char* lds, int wave, int lane_in) {
    int lane = lane_in; asm volatile("" : "+v"(lane));
    const int r32 = lane & 31, hi = lane >> 5;
    LAS bf16x8* Qs = (LAS bf16x8*)(lds + ATT_WAVE + wave * 8192);
    if (tlim > 0) {
#pragma unroll
        for (int m = 0; m < 2; ++m)
#pragma unroll
            for (int d0 = 0; d0 < 4; ++d0) Qs[(m * 4 + d0) * 64 + lane] = *(const bf16x8*)(Qw + (size_t)r32 * 512 + 64 * m + 16 * d0 + 8 * hi);
    }
    f32x16 o1[4], o2[4];
#pragma unroll
    for (int db = 0; db < 4; ++db)
#pragma unroll
        for (int r = 0; r < 16; ++r) { o1[db][r] = 0.f; o2[db][r] = 0.f; }
    float l1 = 0.f, l2 = 0.f;
    const int key_l = 8 * wave + (lane & 7), c8 = lane >> 3;
    const bf16_t* kg = Kb + (size_t)key_l * 512 + 8 * c8;
    const int koff = ((key_l >> 5) * 8 + (c8 >> 1)) * 1024 + (swap23(key_l & 31) + 32 * (c8 & 1)) * 16;
    const int d_l = 16 * wave + (lane & 7);
    const bf16_t* vg = Vtb + (size_t)d_l * ldv + 8 * c8;
    const int voff = 16384 + (((c8 >> 2) * 4 + (d_l >> 5)) * 2 + ((c8 >> 1) & 1)) * 1024 + ((d_l & 31) + 32 * (c8 & 1)) * 16;
    u32x4 sk0 = *(const u32x4*)kg, sk1 = *(const u32x4*)(kg + 64), sv0 = *(const u32x4*)vg, sv1 = *(const u32x4*)(vg + (size_t)8 * ldv);
    *(LAS u32x4*)(lds + koff) = sk0; *(LAS u32x4*)(lds + koff + 4096) = sk1; *(LAS u32x4*)(lds + voff) = sv0; *(LAS u32x4*)(lds + voff + 128) = sv1;
    __syncthreads();
    for (int t = 0; t < T; ++t) {
        const bool more = t + 1 < T;
        if (more) {
            const bf16_t* kn = kg + (size_t)(t + 1) * 64 * 512; const bf16_t* vn = vg + (t + 1) * 64;
            sk0 = *(const u32x4*)kn; sk1 = *(const u32x4*)(kn + 64); sv0 = *(const u32x4*)vn; sv1 = *(const u32x4*)(vn + (size_t)8 * ldv);
        }
        if (t < tlim) {
            const LAS bf16x8* KF = (const LAS bf16x8*)(lds + (t & 1) * ATT_BUF);
            const LAS bf16x8* VF = KF + 1024;
#pragma unroll
            for (int j = 0; j < 2; ++j) {
                bf16x8 pa[2], pb[2];
                {
                    f32x16 sa;
#pragma unroll
                    for (int r = 0; r < 16; ++r) sa[r] = nshift;
#pragma unroll
                    for (int d0 = 0; d0 < 4; ++d0) sa = mfma32(KF[((j * 2 + 0) * 4 + d0) * 64 + lane], Qs[d0 * 64 + lane], sa);
                    float ps = 0.f;
#pragma unroll
                    for (int r = 0; r < 16; ++r) { sa[r] = fast_exp2(sa[r]); ps += sa[r]; }
                    l1 += ps; pa[0] = pack8(sa, 0); pa[1] = pack8(sa, 1);
                }
                {
                    f32x16 sa;
#pragma unroll
                    for (int r = 0; r < 16; ++r) sa[r] = nshift;
#pragma unroll
                    for (int d0 = 0; d0 < 4; ++d0) sa = mfma32(KF[((j * 2 + 1) * 4 + d0) * 64 + lane], Qs[(4 + d0) * 64 + lane], sa);
                    float ps = 0.f;
#pragma unroll
                    for (int r = 0; r < 16; ++r) { sa[r] = fast_exp2(sa[r]); ps += sa[r]; }
                    l2 += ps; pb[0] = pack8(sa, 0); pb[1] = pack8(sa, 1);
                }
#pragma unroll
                for (int db = 0; db < 4; ++db)
#pragma unroll
                    for (int s = 0; s < 2; ++s) {
                        const bf16x8 vf = VF[((j * 4 + db) * 2 + s) * 64 + lane];
                        o1[db] = mfma32(vf, pa[s], o1[db]); o2[db] = mfma32(vf, pb[s], o2[db]);
                    }
            }
        }
        if (more) {
            LAS unsigned char* nb = lds + ((t + 1) & 1) * ATT_BUF;
            *(LAS u32x4*)(nb + koff) = sk0; *(LAS u32x4*)(nb + koff + 4096) = sk1; *(LAS u32x4*)(nb + voff) = sv0; *(LAS u32x4*)(nb + voff + 128) = sv1;
        }
        __syncthreads();
    }
    if (tlim > 0) {
        const int le = lane_id_fresh(), r32e = le & 31, hie = le >> 5;
        l1 += shx(l1, le, 32); l2 += shx(l2, le, 32);
        const float i1 = 1.0f / l1, i2 = lam / l2;
        float ss = 0.f;
#pragma unroll
        for (int db = 0; db < 4; ++db)
#pragma unroll
            for (int r = 0; r < 16; ++r) { const float v = o1[db][r] * i1 - o2[db][r] * i2; o1[db][r] = v; ss += v * v; }
        ss += shx(ss, le, 32);
        const float rr = rsqrtf(ss * (1.0f / 128.0f) + EPS) * post;
#pragma unroll
        for (int db = 0; db < 4; ++db)
#pragma unroll
            for (int g = 0; g < 4; ++g) {
                const int d = 32 * db + 8 * g + 4 * hie;
                const f32x4 gs = *(const f32x4*)(gsub + d);
                u32x2 w; w.x = cvt_pk_bf16(o1[db][4 * g] * rr * gs[0], o1[db][4 * g + 1] * rr * gs[1]); w.y = cvt_pk_bf16(o1[db][4 * g + 2] * rr * gs[2], o1[db][4 * g + 3] * rr * gs[3]);
                *(u32x2*)(Outw + (size_t)r32e * DM + d) = w;
            }
    }
}
__device__ __forceinline__ void attn_bs_block(KArgP A, int l, int b, int h, float nshift, float lam, float post, const float* gsub, LAS unsigned char* lds, int wave, int lane_in) {
    int lane = lane_in; asm volatile("" : "+v"(lane));
    unsigned char* ws = A->ws;
    const int lb = l * 32 + b;
    constexpr int T = 33;
    const float* ck = A->in[4] + (size_t)lb * 2048 * 512 + h * 128;
    const float* cv = A->in[5] + (size_t)lb * 2048 * 512 + h * 128;
    const bf16_t* nk = (const bf16_t*)(ws + WS_KSB) + ((size_t)lb * KSB_ROWS + 2048) * 512 + h * 128;
    const bf16_t* nv = (const bf16_t*)(ws + WS_VSB) + ((size_t)lb * 512 + h * 128) * KSB_ROWS + 2048;
    const int li = (wave - 2) * 64 + lane;
#define BS_FILL(t) do { \
        LAS unsigned char* fb = lds + ((t) & 1) * ATT_BUF; \
        if ((t) < 32) { \
            _Pragma("unroll") for (int i = 0; i < 3; ++i) { const int ci = li + 384 * i; \
                if (ci < 1024) { const int key = ci >> 4, c16 = ci & 15, c8 = c16 & 7; \
                    const float* src = ck + (size_t)(64 * (t) + key) * 512 + 8 * c16; \
                    const f32x4 a = *(const f32x4*)src, c = *(const f32x4*)(src + 4); \
                    u32x4 w; w.x = cvt_pk_bf16(a[0], a[1]); w.y = cvt_pk_bf16(a[2], a[3]); w.z = cvt_pk_bf16(c[0], c[1]); w.w = cvt_pk_bf16(c[2], c[3]); \
                    *(LAS u32x4*)(fb + ((key >> 5) * 8 + (c16 >> 3) * 4 + (c8 >> 1)) * 1024 + (swap23(key & 31) + 32 * (c8 & 1)) * 16) = w; } } \
            if (li < 256) { const int g = li >> 5, d4 = li & 31; \
                f32x4 r[8]; \
                _Pragma("unroll") for (int kk = 0; kk < 8; ++kk) r[kk] = *(const f32x4*)(cv + (size_t)(64 * (t) + 8 * g + kk) * 512 + 4 * d4); \
                _Pragma("unroll") for (int i = 0; i < 4; ++i) { const int d = 4 * d4 + i; \
                    u32x4 w; w.x = cvt_pk_bf16(r[0][i], r[1][i]); w.y = cvt_pk_bf16(r[2][i], r[3][i]); w.z = cvt_pk_bf16(r[4][i], r[5][i]); w.w = cvt_pk_bf16(r[6][i], r[7][i]); \
                    *(LAS u32x4*)(fb + 16384 + (((g >> 2) * 4 + (d >> 5)) * 2 + ((g >> 1) & 1)) * 1024 + ((d & 31) + 32 * (g & 1)) * 16) = w; } } \
        } else { \
            _Pragma("unroll") for (int i = 0; i < 3; ++i) { const int ci = li + 384 * i; \
                if (ci < 1024) { const int key = ci >> 4, c16 = ci & 15, c8 = c16 & 7; \
                    const u32x4 w = *(const u32x4*)(nk + (size_t)key * 512 + 8 * c16); \
                    *(LAS u32x4*)(fb + ((key >> 5) * 8 + (c16 >> 3) * 4 + (c8 >> 1)) * 1024 + (swap23(key & 31) + 32 * (c8 & 1)) * 16) = w; \
                    const int d = ci >> 3, g = ci & 7; \
                    const u32x4 v = *(const u32x4*)(nv + (size_t)d * KSB_ROWS + 8 * g); \
                    *(LAS u32x4*)(fb + 16384 + (((g >> 2) * 4 + (d >> 5)) * 2 + ((g >> 1) & 1)) * 1024 + ((d & 31) + 32 * (g & 1)) * 16) = v; } } \
        } \
    } while (0)
    if (wave >= 2) {
        BS_FILL(0);
        __syncthreads();
        for (int t = 0; t < T; ++t) {
            if (t + 1 < T) BS_FILL(t + 1);
            __syncthreads();
        }
    } else {
        const int r32 = lane & 31, hi = lane >> 5;
        const int row0 = MP + b * 64 + 32 * wave;
        const bf16_t* Qw = (const bf16_t*)(ws + WS_QB) + (size_t)row0 * 512 + h * 128;
        LAS bf16x8* Qs = (LAS bf16x8*)(lds + ATT_WAVE + wave * 8192);
#pragma unroll
        for (int m = 0; m < 2; ++m)
#pragma unroll
            for (int d0 = 0; d0 < 4; ++d0) Qs[(m * 4 + d0) * 64 + lane] = *(const bf16x8*)(Qw + (size_t)r32 * 512 + 64 * m + 16 * d0 + 8 * hi);
        f32x16 o1[4], o2[4];
#pragma unroll
        for (int db = 0; db < 4; ++db)
#pragma unroll
            for (int r = 0; r < 16; ++r) { o1[db][r] = 0.f; o2[db][r] = 0.f; }
        float l1 = 0.f, l2 = 0.f;
        __syncthreads();
        for (int t = 0; t < T; ++t) {
            const LAS bf16x8* KF = (const LAS bf16x8*)(lds + (t & 1) * ATT_BUF);
            const LAS bf16x8* VF = KF + 1024;
#pragma unroll
            for (int j = 0; j < 2; ++j) {
                bf16x8 pa[2], pb[2];
                {
                    f32x16 sa;
#pragma unroll
                    for (int r = 0; r < 16; ++r) sa[r] = nshift;
#pragma unroll
                    for (int d0 = 0; d0 < 4; ++d0) sa = mfma32(KF[((j * 2 + 0) * 4 + d0) * 64 + lane], Qs[d0 * 64 + lane], sa);
                    float ps = 0.f;
#pragma unroll
                    for (int r = 0; r < 16; ++r) { sa[r] = fast_exp2(sa[r]); ps += sa[r]; }
                    l1 += ps; pa[0] = pack8(sa, 0); pa[1] = pack8(sa, 1);
                }
                {
                    f32x16 sa;
#pragma unroll
                    for (int r = 0; r < 16; ++r) sa[r] = nshift;
#pragma unroll
                    for (int d0 = 0; d0 < 4; ++d0) sa = mfma32(KF[((j * 2 + 1) * 4 + d0) * 64 + lane], Qs[(4 + d0) * 64 + lane], sa);
                    float ps = 0.f;
#pragma unroll
                    for (int r = 0; r < 16; ++r) { sa[r] = fast_exp2(sa[r]); ps += sa[r]; }
                    l2 += ps; pb[0] = pack8(sa, 0); pb[1] = pack8(sa, 1);
                }
#pragma unroll
                for (int db = 0; db < 4; ++db)
#pragma unroll
                    for (int s = 0; s < 2; ++s) {
                        const bf16x8 vf = VF[((j * 4 + db) * 2 + s) * 64 + lane];
                        o1[db] = mfma32(vf, pa[s], o1[db]); o2[db] = mfma32(vf, pb[s], o2[db]);
                    }
            }
            __syncthreads();
        }
        const int le = lane_id_fresh(), r32e = le & 31, hie = le >> 5;
        l1 += shx(l1, le, 32); l2 += shx(l2, le, 32);
        const float i1 = 1.0f / l1, i2 = lam / l2;
        float ss = 0.f;
#pragma unroll
        for (int db = 0; db < 4; ++db)
#pragma unroll
            for (int r = 0; r < 16; ++r) { const float v = o1[db][r] * i1 - o2[db][r] * i2; o1[db][r] = v; ss += v * v; }
        ss += shx(ss, le, 32);
        const float rr = rsqrtf(ss * (1.0f / 128.0f) + EPS) * post;
        bf16_t* Outw = (bf16_t*)(ws + WS_O) + (size_t)row0 * DM + 512 + h * 128;
#pragma unroll
        for (int db = 0; db < 4; ++db)
#pragma unroll
            for (int g = 0; g < 4; ++g) {
                const int d = 32 * db + 8 * g + 4 * hie;
                const f32x4 gs = *(const f32x4*)(gsub + d);
                u32x2 w; w.x = cvt_pk_bf16(o1[db][4 * g] * rr * gs[0], o1[db][4 * g + 1] * rr * gs[1]); w.y = cvt_pk_bf16(o1[db][4 * g + 2] * rr * gs[2], o1[db][4 * g + 3] * rr * gs[3]);
                *(u32x2*)(Outw + (size_t)r32e * DM + d) = w;
            }
    }
#undef BS_FILL
}
constexpr int U_BS = 128, U_BP = 512, U_AP = 1024, U_AS = 256, U_B = U_BS + U_BP, U_ALL = U_B + U_AP + U_AS;
__device__ __forceinline__ void attn_phase(KArgP A, int l, LAS unsigned char* lds, int wave, int cidx) {
    unsigned char* ws = A->ws;
    unsigned* ctr = (unsigned*)(ws + WS_CTL) + cidx;
    const float* cst = (const float*)(ws + WS_CTL + 4096) + l * 8;
#define SGPR_F(x) __builtin_bit_cast(float, __builtin_amdgcn_readfirstlane(__builtin_bit_cast(int, (x))))
    const float shA = SGPR_F(cst[0]), shB = SGPR_F(cst[1]), lam = SGPR_F(cst[2]), post = SGPR_F(cst[3]);
#undef SGPR_F
    volatile LAS int* bw = (volatile LAS int*)(lds + ATT_BW);
    const bf16_t* QA = (const bf16_t*)(ws + WS_QA); const bf16_t* QB = (const bf16_t*)(ws + WS_QB);
    bf16_t* O = (bf16_t*)(ws + WS_O);
    const float* bias = A->in[16] + (size_t)l * 8 * 257;
    const float* gsub = A->in[21] + l * 128;
    for (;;) {
        int lane_l = lane_id_fresh(); asm volatile("" : "+v"(lane_l)); const int lane = lane_l;
        __syncthreads();
        if (wave == 0 && lane == 0) bw[0] = (int)atomicAdd(ctr, 1u);
        __syncthreads();
        const int uid = __builtin_amdgcn_readfirstlane(bw[0]);
        if (uid >= U_ALL) break;
        if (uid < U_BS) {
            attn_bs_block(A, l, uid >> 2, uid & 3, -shB, lam, post, gsub, lds, wave, lane);
        } else if (uid < U_B) {
            int b, h, T, tlim, row0, ldv; const bf16_t* K; const bf16_t* Vt;
            if (uid < U_BS) { b = uid >> 2; h = uid & 3; T = 33; tlim = wave < 2 ? 33 : 0; row0 = MP + b * 64 + 32 * (wave & 1); ldv = KSB_ROWS;
                K = (const bf16_t*)(ws + WS_KSB) + (size_t)(l * 32 + b) * KSB_ROWS * 512 + h * 128;
                Vt = (const bf16_t*)(ws + WS_VSB) + ((size_t)(l * 32 + b) * 512 + h * 128) * KSB_ROWS; }
            else { const int v = uid - U_BS, qb = 7 - (v >> 6), w = v & 63; b = w >> 2; h = w & 3; T = 4 * qb + 4; tlim = 4 * qb + (wave >> 1) + 1; row0 = b * 2048 + 256 * qb + 32 * wave; ldv = 2048;
                K = (const bf16_t*)(ws + WS_KBP) + (size_t)b * 2048 * 512 + h * 128;
                Vt = (const bf16_t*)(ws + WS_VBP) + ((size_t)b * 512 + h * 128) * 2048; }
            attn_b_block(QB + (size_t)row0 * 512 + h * 128, K, Vt, ldv, T, tlim, -shB, lam, post, gsub, O + (size_t)row0 * DM + 512 + h * 128, lds, wave, lane);
        } else {
            int b, h, T, t_lo, t_hi, t_self, row0, ldv; const bf16_t* K; const bf16_t* Vt;
            if (uid < U_B + U_AP) { const int v = uid - U_B, cq = 7 - (v >> 7), w = v & 127; b = w >> 3; h = w & 7;
                const int kc0 = cq >= 2 ? 4 * cq - 8 : 0, cw = 4 * cq + (wave >> 1);
                T = 4 * cq + 4 - kc0; t_self = cw - kc0; t_hi = t_self; t_lo = cw - 8 - kc0 > 0 ? cw - 8 - kc0 : 0; row0 = b * 2048 + 256 * cq + 32 * wave; ldv = 2048;
                K = (const bf16_t*)(ws + WS_KAP) + ((size_t)b * 2048 + 64 * kc0) * 512 + h * 64;
                Vt = (const bf16_t*)(ws + WS_VAP) + ((size_t)b * 512 + h * 64) * 2048 + 64 * kc0; }
            else { const int v = uid - U_B - U_AP; b = v >> 3; h = v & 7; T = 9; t_self = 8; t_lo = wave < 2 ? 0 : 1; t_hi = wave < 2 ? 8 : 0; row0 = MP + b * 64 + 32 * (wave & 1); ldv = KSA_ROWS;
                K = (const bf16_t*)(ws + WS_KSA) + (size_t)(l * 32 + b) * KSA_ROWS * 512 + h * 64;
                Vt = (const bf16_t*)(ws + WS_VSA) + ((size_t)(l * 32 + b) * 512 + h * 64) * KSA_ROWS; }
            LAS float* E = (LAS float*)(lds + ATT_WAVE + wave * 8192);
#pragma unroll
            for (int j = 0; j < 5; ++j) { const int i = lane + 64 * j; int rel = i - 64; rel = rel < -128 ? -128 : (rel > 128 ? 128 : rel); E[i] = LOG2E * bias[h * 257 + rel + 128] - shA; }
            attn_a_block(QA + (size_t)row0 * 512 + h * 64, K, Vt, ldv, T, t_lo, t_hi, t_self, 32 * (wave & 1), O + (size_t)row0 * DM + h * 64, lds, wave, lane);
        }
    }
}

__device__ __forceinline__ bool in_phase(int p) { KArgP k = (KArgP)__builtin_amdgcn_kernarg_segment_ptr(); asm volatile("" : "+s"(k)); return k->ph_lo <= p && p < k->ph_hi; }
__global__ void __launch_bounds__(512, 2) mega_fwd(Args KA) {
    extern __shared__ __attribute__((aligned(16))) unsigned char lds_raw[];
    LAS unsigned char* lds = (LAS unsigned char*)lds_raw;
    const int tid = threadIdx.x, wave = __builtin_amdgcn_readfirstlane(tid >> 6);
    const int G = gridDim.x, bx = blockIdx.x;
    const int vcu = (G % 8 == 0) ? (bx % 8) * (G / 8) + bx / 8 : bx;
    (void)KA;
    if (tid == 0) { ((volatile LAS unsigned*)(lds + ATT_BW + 64))[0] = 0u; ((volatile LAS unsigned*)(lds + ATT_BW + 64))[1] = 0u; ((volatile LAS unsigned*)(lds + ATT_BW + 64))[2] = (unsigned)bx; }
    __syncthreads();
#define FRESH_KAP(name) KArgP name = (KArgP)__builtin_amdgcn_kernarg_segment_ptr(); asm volatile("" : "+s"(name))
#define IN_PH(p) in_phase(p)
#define SEAM(p) do { FRESH_KAP(ks_); if (ks_->coop && (p) + 1 < ks_->ph_hi) { XcdBarrier xb_; xb_.bar = (unsigned*)(ks_->ws + WS_BAR); xb_.x = xb_xcc_id(); xb_.st = (volatile LAS unsigned*)(lds + ATT_BW + 64); xcd_barrier(xb_); } } while (0)
#define KARGS() KArgP kap = (KArgP)__builtin_amdgcn_kernarg_segment_ptr(); asm volatile("" : "+s"(kap)); unsigned char* ws = kap->ws; float* out = kap->out; \
    float* ssq = (float*)(ws + WS_SSQ); bf16_t* xb = (bf16_t*)(ws + WS_XB); bf16_t* ab = (bf16_t*)(ws + WS_A); unsigned char* wl = ws + WS_W + (size_t)l * W_LAYER; (void)ssq; (void)xb; (void)ab; (void)wl; (void)out; \
    const int cx = __builtin_amdgcn_readfirstlane((int)((volatile LAS unsigned*)(lds + ATT_BW + 64))[2])
    if (IN_PH(0)) {
        KArgP kap = (KArgP)__builtin_amdgcn_kernarg_segment_ptr(); asm volatile("" : "+s"(kap));
        prologue(kap, lds, vcu * 8 + wave, G * 8, wave);
#ifdef PROBE_PRO2
        prologue(kap, lds, vcu * 8 + wave, G * 8, wave);
#endif
        { FRESH_KAP(ks_); if (ks_->coop && 1 < ks_->ph_hi) { cg::this_grid().sync();
            if (tid == 0) { unsigned* bar_ = (unsigned*)(ks_->ws + WS_BAR); const unsigned x_ = xb_xcc_id(); const unsigned r_ = xb_add(&bar_[XB_XCNT(x_)], 1u);
                if (G == 256 && r_ < 32u && x_ < 8u) ((volatile LAS unsigned*)(lds + ATT_BW + 64))[2] = r_ * 8u + x_; }
            __syncthreads(); } }
    }
#pragma unroll 1
    for (int l = 0; l < 2; ++l) {
        const int p0 = 1 + 7 * l;
        if (IN_PH(p0 + 0)) {
            KARGS();
            pg8::Gemm g{xb, (const bf16_t*)(wl + W_GU1), MT, 2 * DFF, DM, DM, 0};
            pg8::StaticOrder S; S.init(MT, 2 * DFF, G, cx);
            EpiSwiGLU E{ab, ssq + (size_t)(3 * l) * MT};
            pg8::gemm_phase<EpiSwiGLU, pg8::StaticOrder, true, true>(lds, g, S, E, wave);
#ifdef PROBE_UP2
            pg8::gemm_phase<EpiSwiGLU, pg8::StaticOrder, true, true>(lds, g, S, E, wave);
#endif
            SEAM(p0 + 0);
        }
        if (IN_PH(p0 + 1)) {
            KARGS();
            pg8::Gemm g{ab, (const bf16_t*)(wl + W_D1), MT, DM, DFF, LDP, 1};
            pg8::TailSplitOrder S; S.init(MT, DM, G, cx, 0, DOWN_WGM);
            EpiResid E{l == 0 ? kap->in[0] : out, l == 0 ? kap->in[1] : out + (size_t)MP * DM, out, xb, ssq + (size_t)(3 * l + 1) * MT, 0.5f};
            pg8::gemm_phase<EpiResid, pg8::TailSplitOrder, true, true>(lds, g, S, E, wave);
            SEAM(p0 + 1);
        }
        if (IN_PH(p0 + 2)) {
            {
                KARGS();
                pg8::Gemm g{xb, (const bf16_t*)(wl + W_IN), MT, 2048, DM, DM, 0};
                pg8::TailSplitOrder S; S.init(MT, 2048, G, cx);
                EpiQK E{ssq + (size_t)(3 * l + 1) * MT, ws, out, kap, l};
                pg8::gemm_phase<EpiQK, pg8::TailSplitOrder, true, true>(lds, g, S, E, wave);
#ifdef PROBE_QK2
                pg8::gemm_phase<EpiQK, pg8::TailSplitOrder, true, true>(lds, g, S, E, wave);
#endif
            }
            {
                KARGS();
                pg8::Gemm g{(const bf16_t*)(wl + W_IN) + (size_t)2048 * DM, xb, 1024, MT, DM, DM, 0};
                pg8::TailSplitOrder S; S.init(1024, MT, G, cx);
                EpiVt E{ssq + (size_t)(3 * l + 1) * MT, ws, out, l};
                pg8::gemm_phase<EpiVt, pg8::TailSplitOrder, true, true>(lds, g, S, E, wave);
#ifdef PROBE_VT2
                pg8::gemm_phase<EpiVt, pg8::TailSplitOrder, true, true>(lds, g, S, E, wave);
#endif
            }
            SEAM(p0 + 2);
        }
        if (IN_PH(p0 + 3)) {
            KArgP kap = (KArgP)__builtin_amdgcn_kernarg_segment_ptr(); asm volatile("" : "+s"(kap));
            attn_phase(kap, l, lds, wave, l);
#ifdef PROBE_ATTN2
            attn_phase(kap, l, lds, wave, 2 + l);
#endif
            SEAM(p0 + 3);
        }
        if (IN_PH(p0 + 4)) {
            KARGS();
            pg8::Gemm g{(const bf16_t*)(ws + WS_O), (const bf16_t*)(wl + W_OUT), MT, DM, DM, DM, 0};
            pg8::TailSplitOrder S; S.init(MT, DM, G, cx);
            EpiResid E{out, out + (size_t)MP * DM, out, xb, ssq + (size_t)(3 * l + 2) * MT, 1.0f};
            pg8::gemm_phase<EpiResid, pg8::TailSplitOrder, true, true>(lds, g, S, E, wave);
            SEAM(p0 + 4);
        }
        if (IN_PH(p0 + 5)) {
            KARGS();
            pg8::Gemm g{xb, (const bf16_t*)(wl + W_GU2), MT, 2 * DFF, DM, DM, 0};
            pg8::StaticOrder S; S.init(MT, 2 * DFF, G, cx);
            EpiSwiGLU E{ab, ssq + (size_t)(3 * l + 2) * MT};
            pg8::gemm_phase<EpiSwiGLU, pg8::StaticOrder, true, true>(lds, g, S, E, wave);
            SEAM(p0 + 5);
        }
        if (IN_PH(p0 + 6)) {
            KARGS();
            pg8::Gemm g{ab, (const bf16_t*)(wl + W_D2), MT, DM, DFF, LDP, 1};
            pg8::TailSplitOrder S; S.init(MT, DM, G, cx, 0, DOWN_WGM);
            EpiResid E{out, out + (size_t)MP * DM, out, xb, ssq + (size_t)(3 * l + 3) * MT, 0.5f};
            pg8::gemm_phase<EpiResid, pg8::TailSplitOrder, true, true>(lds, g, S, E, wave);
            SEAM(p0 + 6);
        }
    }
}

#ifndef N_LAUNCH_MODE_GUARD_
#define N_LAUNCH_MODE_GUARD_
#endif
#ifndef N_LAUNCH_MODE
#define N_LAUNCH_MODE 0
#endif
extern "C" void kernel_launch(void* const* d_in, const int* in_sizes, int n_in, void* d_out, int out_size, void* d_ws, size_t ws_size, hipStream_t stream) {
    static int grid = 0;
    if (grid == 0) {
        if (n_in != 27 || ws_size < WS_END) { fprintf(stderr, "kernel_launch: unexpected inputs (n_in %d, ws %zu)\n", n_in, ws_size); grid = -1; return; }
        int dev = 0, cus = 0, per_cu = 0;
        hipGetDevice(&dev);
        hipDeviceGetAttribute(&cus, hipDeviceAttributeMultiprocessorCount, dev);
        hipFuncSetAttribute((const void*)mega_fwd, hipFuncAttributeMaxDynamicSharedMemorySize, LDS_BYTES);
        hipOccupancyMaxActiveBlocksPerMultiprocessor(&per_cu, (const void*)mega_fwd, 512, LDS_BYTES);
        (void)hipGetLastError();
        if (per_cu < 1) per_cu = 1;
        grid = cus;
        if (grid != 256) fprintf(stderr, "kernel_launch: note: %d CUs\n", grid);
    }
    if (grid < 0) return;
    Args a{};
    for (int i = 0; i < 27; ++i) a.in[i] = (const float*)d_in[i];
    a.out = (float*)d_out; a.ws = (unsigned char*)d_ws;
#if N_LAUNCH_MODE == 1
    for (int ph = 0; ph < NPHASE; ++ph) {
        a.ph_lo = ph; a.ph_hi = ph + 1; a.coop = 0;
        hipLaunchKernelGGL(mega_fwd, dim3(grid), dim3(512), LDS_BYTES, stream, a);
    }
#else
    a.ph_lo = 0; a.ph_hi = NPHASE; a.coop = 1;
    void* args[] = {&a};
    hipError_t e = hipLaunchCooperativeKernel((const void*)mega_fwd, dim3(grid), dim3(512), args, LDS_BYTES, stream);
    if (e != hipSuccess) fprintf(stderr, "cooperative launch failed: %s (grid %d)\n", hipGetErrorString(e), grid);
#endif
}
```

```cpp
#include <hip/hip_runtime.h>
#include <hip/hip_cooperative_groups.h>
#include <cstdio>
#include <cstdint>
#include <cstddef>
namespace cg = cooperative_groups;
__device__ __forceinline__ int lane_id_fresh() { int l; asm volatile("v_mbcnt_lo_u32_b32 %0, -1, 0\n\tv_mbcnt_hi_u32_b32 %0, -1, %0" : "=v"(l)); return l; }
#ifndef PG8_PFD
#define PG8_PFD 4
#endif
namespace pg8 {
#define PG8_LAS __attribute__((address_space(3)))
typedef unsigned short bf16_t;
typedef short bf16x8 __attribute__((ext_vector_type(8)));
typedef float f32x4 __attribute__((ext_vector_type(4)));
typedef unsigned u32x4 __attribute__((ext_vector_type(4)));
constexpr int BM = 256, BK = 64, HALF = 128, HTB = HALF * BK * 2  , STAGE_BYTES = 8 * HTB, NXCD = 8, WGM = 8;

__host__ __device__ __forceinline__ int lds_byte(int r, int c) { const int st = (r >> 4) * 2 + (c >> 5), rr = r & 15, cc = c & 31, ob = rr * 64 + cc * 2; return st * 1024 + (ob ^ (((ob >> 9) & 1) << 5)); }
__host__ __device__ __forceinline__ void stage_rc(int b, int& R, int& C) { const int st = b / 1024, sb = b % 1024, swz = sb ^ (((sb >> 9) & 1) << 5); R = (st >> 1) * 16 + swz / 64; C = (st & 1) * 32 + (swz % 64) / 2; }
__host__ __device__ __forceinline__ int perm32(int rho) { const int n = rho >> 4, i = rho & 15; return 8 * (i >> 2) + 4 * n + (i & 3); }

struct Unit { int pm, pn, hm; };
struct Gemm { const bf16_t* A; const bf16_t* Bt; int M, N, K, ld; int blocked; };

struct StaticOrder {
    int nM, nN, nwg, G, c, rev, wgm;
    __host__ __device__ void init(int M, int N, int G_, int c_, int rev_ = 0, int wgm_ = WGM) { nM = M / BM; nN = N / BM; nwg = nM * nN; G = G_; c = c_; rev = rev_; wgm = wgm_; }
    __host__ __device__ __forceinline__ void tile(int wgid, Unit& u) const {
        { const int q = nwg / NXCD, r = nwg % NXCD, xcd = wgid % NXCD, off = wgid / NXCD; wgid = (xcd < r ? xcd * (q + 1) : r * (q + 1) + (xcd - r) * q) + off; }
        const int nig = wgm * nN, gid = wgid / nig, fm = gid * wgm, gsz = (nM - fm) < wgm ? (nM - fm) : wgm;
        u.pm = fm + ((wgid % nig) % gsz); u.pn = (wgid % nig) / gsz; u.hm = 3;
        if (rev) u.pm = nM - 1 - u.pm;
    }
    __host__ __device__ bool next(int i, Unit& u) const {
        const long L = (long)i * G + c; if (L >= nwg) return false;
        tile((int)L, u); return true;
    }
    __device__ __forceinline__ void a_ready(const Unit&) const {}
    __device__ __forceinline__ void done(const Unit&) const {}
};
struct TailSplitOrder : StaticOrder {
    __host__ __device__ bool next(int i, Unit& u) const {
        const int nfull = (nwg / G) * G, L = i * G + c;
        if (L < nfull) { tile(L, u); return true; }
        const int idx = L - nfull;
        if (idx >= 2 * (nwg - nfull)) return false;
        tile(nfull + (idx >> 1), u); u.hm = 1 << (idx & 1); return true;
    }
};

__device__ __forceinline__ unsigned cvt_pk_bf16(float lo, float hi) { unsigned r; asm volatile("v_cvt_pk_bf16_f32 %0, %1, %2" : "=v"(r) : "v"(lo), "v"(hi)); return r; }
typedef float f32x2 __attribute__((ext_vector_type(2)));
template <class Epi, class Sched, bool ALIGN_EPI = false, bool SP2 = false>
__device__ __forceinline__ void gemm_phase(PG8_LAS unsigned char* lds, const Gemm g, const Sched& S, const Epi& E, int wave_in) {
    int tid_l = wave_in * 64 + lane_id_fresh(); asm volatile("" : "+v"(tid_l));
    const int tid = tid_l, wid = __builtin_amdgcn_readfirstlane(tid >> 6), lane = tid & 63, wr = wid >> 2, wc = wid & 3, fr = lane & 15, fq = lane >> 4;
    const int nt = g.K / BK, K = g.blocked ? BK : g.ld;
    unsigned voffA[2], voffB[2];
#pragma unroll
    for (int i = 0; i < 2; ++i) { int R, C; stage_rc(tid * 16 + i * 8192, R, C); const int Rb = Epi::PERM ? ((R & ~31) + perm32(R & 31)) : R;
        voffA[i] = (unsigned)(R * K + C) * 2u; voffB[i] = (unsigned)(Rb * K + C) * 2u;
        if (g.blocked == 2) { voffA[i] = (unsigned)(tid * 16 + i * 8192); voffB[i] = voffA[i]; } }
    const size_t kstep = g.blocked ? (size_t)(BM * BK * 2) : (size_t)(BK * 2);
    const size_t hstep = (size_t)HALF * K * 2;
    const size_t tstep = g.blocked ? (size_t)nt * (BM * BK * 2) : 2 * hstep;
    const unsigned ldsw = (unsigned)wid * 1024u;
    const int aoff = lds_byte(wr * 64 + fr, fq * 8), boff = lds_byte(wc * 32 + fr, fq * 8);
#define PG8_SA(b, h) (((b) * 2 + (h)) * HTB)
#define PG8_SB(b, h) ((4 + (b) * 2 + (h)) * HTB)
#define PG8_STAGE(bufoff, gbase, voff) do { _Pragma("unroll") for (int _i = 0; _i < 2; ++_i) \
        __builtin_amdgcn_global_load_lds((const unsigned*)((const char*)(gbase) + (voff)[_i]), (PG8_LAS unsigned*)(lds + (bufoff) + ldsw + _i * 8192), 16, 0, 0); } while (0)
#define PG8_LDA(dst, b, h) do { _Pragma("unroll") for (int m = 0; m < 4; ++m) _Pragma("unroll") for (int k = 0; k < 2; ++k) dst[m][k] = *(const PG8_LAS bf16x8*)(lds + PG8_SA(b, h) + aoff + m * 2048 + k * 1024); } while (0)
#define PG8_LDB(dst, b, h) do { _Pragma("unroll") for (int n = 0; n < 2; ++n) _Pragma("unroll") for (int k = 0; k < 2; ++k) dst[n][k] = *(const PG8_LAS bf16x8*)(lds + PG8_SB(b, h) + boff + n * 2048 + k * 1024); } while (0)
#define PG8_MMA(ai, bj, At, Bt) do { __builtin_amdgcn_s_setprio(1); _Pragma("unroll") for (int m = 0; m < 4; ++m) _Pragma("unroll") for (int n = 0; n < 2; ++n) _Pragma("unroll") for (int k = 0; k < 2; ++k) \
        acc[ai][bj][m][n] = __builtin_amdgcn_mfma_f32_16x16x32_bf16(Bt[n][k], At[m][k], acc[ai][bj][m][n], 0, 0, 0); __builtin_amdgcn_s_setprio(0); } while (0)
#define PG8_WAIT_V(n) asm volatile("s_waitcnt vmcnt(" #n ")" ::: "memory")
#define PG8_WAIT_L(n) asm volatile("s_waitcnt lgkmcnt(" #n ")" ::: "memory")
#define PG8_BAR __builtin_amdgcn_s_barrier()
#define PG8_SCHED __builtin_amdgcn_sched_barrier(0)
    Unit cur, nxt; int ui = 0;
    if (!S.next(0, cur)) return;
    f32x4 acc[2][2][4][2];
#pragma unroll
    for (int a = 0; a < 2; ++a)
#pragma unroll
        for (int b = 0; b < 2; ++b)
#pragma unroll
            for (int m = 0; m < 4; ++m)
#pragma unroll
                for (int n = 0; n < 2; ++n) acc[a][b][m][n] = (f32x4){0.f, 0.f, 0.f, 0.f};
    bf16x8 At[4][2], B0[2][2], B1[2][2];
    const char* cA = (const char*)g.A + (size_t)cur.pm * tstep; const char* cB = (const char*)g.Bt + (size_t)cur.pn * tstep;
    S.a_ready(cur);
    if constexpr (SP2) {
        PG8_STAGE(PG8_SB(0, 0), cB, voffB); PG8_STAGE(PG8_SB(0, 1), cB + hstep, voffB); PG8_STAGE(PG8_SA(0, 0), cA, voffA); PG8_STAGE(PG8_SA(0, 1), cA + hstep, voffA);
        if (wr == 1) PG8_BAR;
        PG8_WAIT_V(2); PG8_BAR;
        PG8_STAGE(PG8_SB(1, 0), cB + kstep, voffB); PG8_STAGE(PG8_SA(1, 0), cA + kstep, voffA); PG8_STAGE(PG8_SB(1, 1), cB + hstep + kstep, voffB);
        PG8_WAIT_V(6); PG8_BAR;
    } else {
        PG8_STAGE(PG8_SB(0, 0), cB, voffB); PG8_STAGE(PG8_SA(0, 0), cA, voffA); PG8_STAGE(PG8_SB(0, 1), cB + hstep, voffB); PG8_STAGE(PG8_SA(0, 1), cA + hstep, voffA);
        if (wr == 1) PG8_BAR;
        PG8_WAIT_V(4); PG8_BAR;
        PG8_STAGE(PG8_SB(1, 0), cB + kstep, voffB); PG8_STAGE(PG8_SA(1, 0), cA + kstep, voffA); PG8_STAGE(PG8_SB(1, 1), cB + hstep + kstep, voffB);
        PG8_WAIT_V(6); PG8_BAR;
    }
    for (;;) {
        const bool has_next = S.next(ui + 1, nxt);
        const char* nA = has_next ? (const char*)g.A + (size_t)nxt.pm * tstep : cA; const char* nB = has_next ? (const char*)g.Bt + (size_t)nxt.pn * tstep : cB;
        for (int t = 0; t < nt; t += 2) {
            const bool last = (t == nt - 2);
            const char* a1 = cA + (size_t)(t + 1) * kstep;
            const char* a2 = last ? nA : cA + (size_t)(t + 2) * kstep; const char* b2 = last ? nB : cB + (size_t)(t + 2) * kstep;
            const char* a3 = a2 + kstep; const char* b3 = b2 + kstep;
            if (last && has_next) S.a_ready(nxt);
            if constexpr (SP2) {
            PG8_LDB(B0, 0, 0); PG8_LDB(B1, 0, 1); PG8_SCHED; PG8_LDA(At, 0, 0); PG8_STAGE(PG8_SA(1, 1), a1 + hstep, voffA);
            PG8_WAIT_V(8); PG8_WAIT_L(0); PG8_BAR; if (cur.hm & 1) { PG8_MMA(0, 0, At, B0); PG8_MMA(0, 1, At, B1); } PG8_BAR; PG8_SCHED;
            PG8_LDA(At, 0, 1); PG8_STAGE(PG8_SB(0, 0), b2, voffB); PG8_STAGE(PG8_SB(0, 1), b2 + hstep, voffB); PG8_STAGE(PG8_SA(0, 0), a2, voffA);
            PG8_WAIT_V(8); PG8_WAIT_L(0); PG8_BAR; if (cur.hm & 2) { PG8_MMA(1, 0, At, B0); PG8_MMA(1, 1, At, B1); } PG8_BAR; PG8_SCHED;
            PG8_LDB(B0, 1, 0); PG8_LDB(B1, 1, 1); PG8_SCHED; PG8_LDA(At, 1, 0); PG8_STAGE(PG8_SA(0, 1), a2 + hstep, voffA);
            PG8_WAIT_V(8); PG8_WAIT_L(0); PG8_BAR; if (cur.hm & 1) { PG8_MMA(0, 0, At, B0); PG8_MMA(0, 1, At, B1); } PG8_BAR; PG8_SCHED;
            PG8_LDA(At, 1, 1); PG8_STAGE(PG8_SB(1, 0), b3, voffB); PG8_STAGE(PG8_SB(1, 1), b3 + hstep, voffB); PG8_STAGE(PG8_SA(1, 0), a3, voffA);
            PG8_WAIT_V(8); PG8_WAIT_L(0); PG8_BAR; if (cur.hm & 2) { PG8_MMA(1, 0, At, B0); PG8_MMA(1, 1, At, B1); } PG8_BAR; PG8_SCHED;
            } else {
            PG8_LDB(B0, 0, 0); PG8_SCHED; PG8_LDA(At, 0, 0); PG8_STAGE(PG8_SA(1, 1), a1 + hstep, voffA);
            PG8_WAIT_L(8); PG8_BAR; PG8_WAIT_L(0); PG8_MMA(0, 0, At, B0); PG8_BAR; PG8_SCHED;
            PG8_LDB(B1, 0, 1); PG8_STAGE(PG8_SB(0, 0), b2, voffB);
            PG8_BAR; PG8_WAIT_L(0); PG8_MMA(0, 1, At, B1); PG8_BAR;
            PG8_LDA(At, 0, 1); PG8_STAGE(PG8_SA(0, 0), a2, voffA);
            PG8_BAR; PG8_WAIT_L(0); PG8_MMA(1, 0, At, B0); PG8_BAR; PG8_SCHED;
            PG8_STAGE(PG8_SB(0, 1), b2 + hstep, voffB);
            PG8_WAIT_V(6); PG8_BAR; PG8_MMA(1, 1, At, B1); PG8_BAR;
            PG8_LDB(B0, 1, 0); PG8_SCHED; PG8_LDA(At, 1, 0); PG8_STAGE(PG8_SA(0, 1), a2 + hstep, voffA);
            PG8_WAIT_L(8); PG8_BAR; PG8_WAIT_L(0); PG8_MMA(0, 0, At, B0); PG8_BAR; PG8_SCHED;
            PG8_LDB(B1, 1, 1); PG8_STAGE(PG8_SB(1, 0), b3, voffB);
            PG8_BAR; PG8_WAIT_L(0); PG8_MMA(0, 1, At, B1); PG8_BAR;
            PG8_LDA(At, 1, 1); PG8_STAGE(PG8_SA(1, 0), a3, voffA);
            PG8_BAR; PG8_WAIT_L(0); PG8_MMA(1, 0, At, B0); PG8_BAR; PG8_SCHED;
            PG8_STAGE(PG8_SB(1, 1), b3 + hstep, voffB);
            PG8_WAIT_V(6); PG8_BAR; PG8_MMA(1, 1, At, B1); PG8_BAR;
            }
        }
        if constexpr (ALIGN_EPI) { if (wr == 0) PG8_BAR; }
        if constexpr (!Epi::AFTER_DRAIN) { E(acc, cur, wr, wc, fr, fq); S.done(cur); }
        if (!has_next) break;
#pragma unroll
        for (int a = 0; a < 2; ++a)
#pragma unroll
            for (int b = 0; b < 2; ++b)
#pragma unroll
                for (int m = 0; m < 4; ++m)
#pragma unroll
                    for (int n = 0; n < 2; ++n) acc[a][b][m][n] = (f32x4){0.f, 0.f, 0.f, 0.f};
        cur = nxt; cA = nA; cB = nB; ++ui;
        if constexpr (ALIGN_EPI) { if (wr == 1) PG8_BAR; }
    }
    PG8_WAIT_V(0);
    if constexpr (!ALIGN_EPI) { if (wr == 0) PG8_BAR; }
    PG8_BAR;
    if constexpr (Epi::AFTER_DRAIN) { E.fused(acc, cur, wr, wc, fr, fq, lds, wid, lane); S.done(cur); }
#undef PG8_SA
#undef PG8_SB
#undef PG8_STAGE
#undef PG8_LDA
#undef PG8_LDB
#undef PG8_MMA
#undef PG8_WAIT_V
#undef PG8_WAIT_L
#undef PG8_BAR
#undef PG8_SCHED
}
}
using pg8::bf16_t; using pg8::bf16x8; using pg8::f32x4; using pg8::u32x4; using pg8::Unit; using pg8::cvt_pk_bf16;
typedef float f32x16 __attribute__((ext_vector_type(16)));
typedef unsigned u32x2 __attribute__((ext_vector_type(2)));
#define LAS __attribute__((address_space(3)))

constexpr int DM = 1024, SEQ = 2048, DSEQ = 64;
constexpr int MP = 16 * 2048, MS = 32 * 64, MT = MP + MS;
constexpr int DFF = 2816, LDP = 2880;
constexpr int KSA_ROWS = 576, KSB_ROWS = 2112;
constexpr float EPS = 1e-6f, LOG2E = 1.4426950408889634f, QSCALE = 0.125f * 1.4426950408889634f;
constexpr int NPHASE = 15;
#ifndef DOWN_WGM
#define DOWN_WGM 8
#endif
constexpr size_t MiB = 1u << 20;
constexpr size_t WS_CTL = 0, WS_BAR = 65536, WS_SSQ = 1 * MiB, WS_ROPE = 2 * MiB, WS_W = 4 * MiB;
constexpr size_t W_GU1 = 0, W_D1 = 11 * MiB, W_IN = 17 * MiB, W_OUT = 23 * MiB, W_GU2 = 25 * MiB, W_D2 = 36 * MiB, W_LAYER = 42 * MiB;
constexpr size_t WS_XB = 88 * MiB, WS_A = 156 * MiB, WS_QA = WS_A, WS_QB = WS_A + 34 * MiB, WS_O = WS_A + 68 * MiB;
constexpr size_t WS_KAP = 352 * MiB, WS_KBP = 384 * MiB, WS_VAP = 416 * MiB, WS_VBP = 448 * MiB;
constexpr size_t WS_KSA = 480 * MiB, WS_VSA = 516 * MiB, WS_KSB = 552 * MiB, WS_VSB = 684 * MiB, WS_END = 816 * MiB;
static_assert(W_D2 + (size_t)1024 * LDP * 2 <= W_LAYER && WS_W + 2 * W_LAYER <= WS_XB && WS_A + (size_t)MT * LDP * 2 <= WS_KAP, "d_ws map");
constexpr size_t OUT_YP = 0, OUT_YS = 33554432, OUT_PAK = 35651584, OUT_PAV = 44040192, OUT_PBK = 52428800, OUT_PBV = 85983232,
                 OUT_SAK = 119537664, OUT_SAV = 121634816, OUT_SBK = 123731968, OUT_SBV = 125829120;
constexpr int LDS_BYTES = 147456;

struct Args { const float* in[27]; float* out; unsigned char* ws; int ph_lo, ph_hi, coop, pad; };
typedef const __attribute__((address_space(4))) Args* KArgP;

__device__ const double ROPE_INV[32] = {1.0, 0.7498942093324559, 0.5623413251903491, 0.4216965034285822, 0.31622776601683794, 0.23713737056616552, 0.1778279410038923, 0.1333521432163324, 0.1, 0.07498942093324558, 0.05623413251903491, 0.042169650342858224, 0.03162277660168379, 0.023713737056616554, 0.01778279410038923, 0.01333521432163324, 0.01, 0.007498942093324558, 0.005623413251903491, 0.004216965034285823, 0.0031622776601683794, 0.0023713737056616554, 0.0017782794100389228, 0.001333521432163324, 0.001, 0.0007498942093324559, 0.0005623413251903491, 0.00042169650342858224, 0.00031622776601683794, 0.00023713737056616554, 0.00017782794100389227, 0.0001333521432163324};

__device__ __forceinline__ float shx(float v, int lane, int m) { return __builtin_bit_cast(float, __builtin_amdgcn_ds_bpermute((lane ^ m) << 2, __builtin_bit_cast(int, v))); }
__device__ __forceinline__ float wave_sum(float v, int lane) {
#pragma unroll
    for (int o = 1; o < 64; o <<= 1) v += shx(v, lane, o);
    return v;
}
__device__ __forceinline__ float wave_max(float v, int lane) {
#pragma unroll
    for (int o = 1; o < 64; o <<= 1) v = fmaxf(v, shx(v, lane, o));
    return v;
}
__device__ __forceinline__ float fast_rcp(float x) { return __builtin_amdgcn_rcpf(x); }
__device__ __forceinline__ float fast_exp2(float x) { return __builtin_amdgcn_exp2f(x); }

struct EpiSwiGLU {
    static constexpr bool PERM = true, AFTER_DRAIN = false;
    bf16_t* O; const float* ssq;
    __device__ __forceinline__ void operator()(const f32x4 (&acc)[2][2][4][2], const Unit& u, int wr, int wc, int fr, int fq) const {
        const int row0 = u.pm * 256 + wr * 64 + fr, col0 = u.pn * 128 + wc * 32 + 8 * fq;
        float sq[2][4];
#pragma unroll
        for (int ai = 0; ai < 2; ++ai)
#pragma unroll
            for (int m = 0; m < 4; ++m) sq[ai][m] = ssq[row0 + ai * 128 + m * 16];
#pragma unroll
        for (int ai = 0; ai < 2; ++ai)
#pragma unroll
            for (int m = 0; m < 4; ++m) {
                if (!((u.hm >> ai) & 1)) continue;
                const int row = row0 + ai * 128 + m * 16;
                const float rstd = rsqrtf(sq[ai][m] * (1.0f / DM) + EPS);
                float o[8];
#pragma unroll
                for (int n = 0; n < 2; ++n)
#pragma unroll
                    for (int i = 0; i < 4; ++i) {
                        const float g = acc[ai][0][m][n][i] * rstd, up = acc[ai][1][m][n][i] * rstd;
                        const float sg = g * fast_rcp(1.0f + fast_exp2(-g * LOG2E));
                        o[n * 4 + i] = sg * up;
                    }
                u32x4 w; w.x = cvt_pk_bf16(o[0], o[1]); w.y = cvt_pk_bf16(o[2], o[3]); w.z = cvt_pk_bf16(o[4], o[5]); w.w = cvt_pk_bf16(o[6], o[7]);
                *(u32x4*)((char*)O + (((size_t)(row >> 8) * (DFF / 64) + (col0 >> 6)) * 2 + ((row >> 7) & 1)) * 16384 + pg8::lds_byte(row & 127, col0 & 63)) = w;
            }
    }
};
struct EpiResid {
    static constexpr bool PERM = false, AFTER_DRAIN = false;
    const float* xin_p; const float* xin_s; float* xout; bf16_t* xb; float* ssq; float scale;
    __device__ __forceinline__ void operator()(const f32x4 (&acc)[2][2][4][2], const Unit& u, int wr, int wc, int fr, int fq) const {
        const int col0 = u.pn * 256 + wc * 32 + 4 * fq;
#pragma unroll
        for (int ai = 0; ai < 2; ++ai) {
            if (!((u.hm >> ai) & 1)) continue;
            const int rowb = u.pm * 256 + ai * 128 + wr * 64 + fr;
            const float* xi = (rowb < MP) ? xin_p + (size_t)rowb * DM : xin_s + (size_t)(rowb - MP) * DM;
            f32x4 pre[4][2][2];
#pragma unroll
            for (int m = 0; m < 4; ++m)
#pragma unroll
                for (int bj = 0; bj < 2; ++bj)
#pragma unroll
                    for (int n = 0; n < 2; ++n) pre[m][bj][n] = *(const f32x4*)(xi + (size_t)m * 16 * DM + col0 + bj * 128 + n * 16);
#pragma unroll
            for (int m = 0; m < 4; ++m) {
                const int row = rowb + m * 16;
                float sq = 0.f;
#pragma unroll
                for (int bj = 0; bj < 2; ++bj)
#pragma unroll
                    for (int n = 0; n < 2; ++n) {
                        const int c = col0 + bj * 128 + n * 16;
                        const f32x4 v = pre[m][bj][n] + acc[ai][bj][m][n] * scale;
                        *(f32x4*)(xout + (size_t)row * DM + c) = v;
                        u32x2 w; w.x = cvt_pk_bf16(v[0], v[1]); w.y = cvt_pk_bf16(v[2], v[3]);
                        *(u32x2*)(xb + (size_t)row * DM + c) = w;
                        sq += (v[0] * v[0] + v[1] * v[1]) + (v[2] * v[2] + v[3] * v[3]);
                    }
                sq += shx(sq, fr + 16 * fq, 16); sq += shx(sq, fr + 16 * fq, 32);
                if (fq == 0) atomicAdd(ssq + row, sq);
            }
        }
    }
};
struct EpiQK {
    static constexpr bool PERM = true, AFTER_DRAIN = false;
    const float* ssq; unsigned char* ws; float* out; KArgP kap; int l;
    __device__ __forceinline__ void operator()(const f32x4 (&acc)[2][2][4][2], const Unit& u, int wr, int wc, int fr, int fq) const {
        const int sec = u.pn >> 1, hd = 4 * (u.pn & 1) + wc;
        const float* gp = kap->in[12 + sec] + l * 64;
        const float* rope = (const float*)(ws + WS_ROPE);
        bf16_t* QA = (bf16_t*)(ws + WS_QA); bf16_t* QB = (bf16_t*)(ws + WS_QB); bf16_t* KAP = (bf16_t*)(ws + WS_KAP); bf16_t* KBP = (bf16_t*)(ws + WS_KBP);
        bf16_t* KSA = (bf16_t*)(ws + WS_KSA) + (size_t)l * 32 * KSA_ROWS * 512; bf16_t* KSB = (bf16_t*)(ws + WS_KSB) + (size_t)l * 32 * KSB_ROWS * 512;
        float* oPAK = out + OUT_PAK + (size_t)l * 16 * 512 * 512; float* oPBK = out + OUT_PBK + (size_t)l * MP * 512;
        float* oSAK = out + OUT_SAK + (size_t)l * MS * 512; float* oSBK = out + OUT_SBK + (size_t)l * MS * 512;
        f32x4 gl[2], gh[2];
#pragma unroll
        for (int n = 0; n < 2; ++n) { gl[n] = *(const f32x4*)(gp + 8 * fq + 4 * n); gh[n] = *(const f32x4*)(gp + 32 + 8 * fq + 4 * n); }
        const int cbase = hd * 64 + 8 * fq;
        float sqr[2][4];
#pragma unroll
        for (int ai = 0; ai < 2; ++ai)
#pragma unroll
            for (int m = 0; m < 4; ++m) sqr[ai][m] = ssq[u.pm * 256 + ai * 128 + wr * 64 + m * 16 + fr];
#pragma unroll
        for (int ai = 0; ai < 2; ++ai)
#pragma unroll
            for (int m = 0; m < 4; ++m) {
                if (!((u.hm >> ai) & 1)) continue;
                const int row = u.pm * 256 + ai * 128 + wr * 64 + m * 16 + fr;
                const float rstd = rsqrtf(sqr[ai][m] * (1.0f / DM) + EPS);
                f32x4 y[2][2]; float ss = 0.f;
#pragma unroll
                for (int bj = 0; bj < 2; ++bj)
#pragma unroll
                    for (int n = 0; n < 2; ++n) { const f32x4 v = acc[ai][bj][m][n] * rstd; y[bj][n] = v; ss += (v[0] * v[0] + v[1] * v[1]) + (v[2] * v[2] + v[3] * v[3]); }
                ss += shx(ss, fr + 16 * fq, 16); ss += shx(ss, fr + 16 * fq, 32);
                const float rr = rsqrtf(ss * (1.0f / 64.0f) + EPS);
#pragma unroll
                for (int n = 0; n < 2; ++n) { y[0][n] = y[0][n] * rr * gl[n]; y[1][n] = y[1][n] * rr * gh[n]; }
                const bool prompt = row < MP;
                const int sp = row & 2047, bp = row >> 11, ts = (row - MP) & 63, bs = (row - MP) >> 6;
                if (sec >= 2) {
                    const int pos = prompt ? sp : 2048 + ts;
                    const float* cs = rope + (size_t)pos * 64 + 8 * fq;
#pragma unroll
                    for (int n = 0; n < 2; ++n) {
                        const f32x4 c = *(const f32x4*)(cs + 4 * n), s = *(const f32x4*)(cs + 32 + 4 * n);
                        const f32x4 x1 = y[0][n], x2 = y[1][n];
                        y[0][n] = x1 * c - x2 * s; y[1][n] = x2 * c + x1 * s;
                    }
                }
                if (sec == 0 || sec == 2) {
                    bf16_t* dst = (sec == 0 ? QA : QB) + (size_t)row * 512 + cbase;
#pragma unroll
                    for (int bj = 0; bj < 2; ++bj) {
                        const f32x4 a = y[bj][0] * QSCALE, b = y[bj][1] * QSCALE;
                        u32x4 w; w.x = cvt_pk_bf16(a[0], a[1]); w.y = cvt_pk_bf16(a[2], a[3]); w.z = cvt_pk_bf16(b[0], b[1]); w.w = cvt_pk_bf16(b[2], b[3]);
                        *(u32x4*)(dst + 32 * bj) = w;
                    }
                } else {
                    bf16_t* dst; float* fo = nullptr;
                    if (sec == 1) {
                        if (prompt) { dst = KAP + (size_t)row * 512; if (sp >= 1536) fo = oPAK + (size_t)(bp * 512 + sp - 1536) * 512; }
                        else { dst = KSA + (size_t)(bs * KSA_ROWS + 512 + ts) * 512; fo = oSAK + (size_t)(row - MP) * 512; }
                    } else {
                        if (prompt) { dst = KBP + (size_t)row * 512; fo = oPBK + (size_t)row * 512; }
                        else { dst = KSB + (size_t)(bs * KSB_ROWS + 2048 + ts) * 512; fo = oSBK + (size_t)(row - MP) * 512; }
                    }
#pragma unroll
                    for (int bj = 0; bj < 2; ++bj) {
                        const f32x4 a = y[bj][0], b = y[bj][1];
                        u32x4 w; w.x = cvt_pk_bf16(a[0], a[1]); w.y = cvt_pk_bf16(a[2], a[3]); w.z = cvt_pk_bf16(b[0], b[1]); w.w = cvt_pk_bf16(b[2], b[3]);
                        *(u32x4*)(dst + cbase + 32 * bj) = w;
                        if (fo) { *(f32x4*)(fo + cbase + 32 * bj) = a; *(f32x4*)(fo + cbase + 32 * bj + 4) = b; }
                    }
                }
            }
    }
};
struct EpiVt {
    static constexpr bool PERM = true, AFTER_DRAIN = false;
    const float* ssq; unsigned char* ws; float* out; int l;
    __device__ __forceinline__ void operator()(const f32x4 (&acc)[2][2][4][2], const Unit& u, int wr, int wc, int fr, int fq) const {
        bf16_t* VAP = (bf16_t*)(ws + WS_VAP); bf16_t* VBP = (bf16_t*)(ws + WS_VBP);
        bf16_t* VSA = (bf16_t*)(ws + WS_VSA) + (size_t)l * 32 * 512 * KSA_ROWS; bf16_t* VSB = (bf16_t*)(ws + WS_VSB) + (size_t)l * 32 * 512 * KSB_ROWS;
        float* oPAV = out + OUT_PAV + (size_t)l * 16 * 512 * 512; float* oPBV = out + OUT_PBV + (size_t)l * MP * 512;
        float* oSAV = out + OUT_SAV + (size_t)l * MS * 512; float* oSBV = out + OUT_SBV + (size_t)l * MS * 512;
        const int grp = u.pm >> 1;
        const bool prompt = u.pn < (MP / 256);
        f32x4 rs[2][2];
#pragma unroll
        for (int bj = 0; bj < 2; ++bj)
#pragma unroll
            for (int n = 0; n < 2; ++n) {
                const f32x4 q = *(const f32x4*)(ssq + u.pn * 256 + bj * 128 + wc * 32 + 8 * fq + 4 * n);
                f32x4 r; r[0] = rsqrtf(q[0] * (1.0f / DM) + EPS); r[1] = rsqrtf(q[1] * (1.0f / DM) + EPS); r[2] = rsqrtf(q[2] * (1.0f / DM) + EPS); r[3] = rsqrtf(q[3] * (1.0f / DM) + EPS);
                rs[bj][n] = r;
            }
#pragma unroll
        for (int bj = 0; bj < 2; ++bj) {
            const int tok = u.pn * 256 + bj * 128 + wc * 32 + 8 * fq;
            const int bp = tok >> 11, sp = tok & 2047, tt = tok - MP, bs = tt >> 6, ts = tt & 63;
            bf16_t* vdst; size_t vld; float* fo = nullptr;
            if (prompt) { vdst = (grp == 0 ? VAP : VBP) + (size_t)bp * 512 * 2048 + sp; vld = 2048;
                if (grp == 0) { if (sp >= 1536) fo = oPAV + (size_t)(bp * 512 + sp - 1536) * 512; } else fo = oPBV + (size_t)tok * 512; }
            else { if (grp == 0) { vdst = VSA + (size_t)bs * 512 * KSA_ROWS + 512 + ts; vld = KSA_ROWS; fo = oSAV + (size_t)tt * 512; }
                   else { vdst = VSB + (size_t)bs * 512 * KSB_ROWS + 2048 + ts; vld = KSB_ROWS; fo = oSBV + (size_t)tt * 512; } }
#pragma unroll
            for (int ai = 0; ai < 2; ++ai)
#pragma unroll
                for (int m = 0; m < 4; ++m) {
                    if (!((u.hm >> ai) & 1)) continue;
                    const int hrow = (ai * 128 + wr * 64 + m * 16 + fr) + (u.pm & 1) * 256;
                    const f32x4 a = acc[ai][bj][m][0] * rs[bj][0], b = acc[ai][bj][m][1] * rs[bj][1];
                    u32x4 w; w.x = cvt_pk_bf16(a[0], a[1]); w.y = cvt_pk_bf16(a[2], a[3]); w.z = cvt_pk_bf16(b[0], b[1]); w.w = cvt_pk_bf16(b[2], b[3]);
                    *(u32x4*)(vdst + (size_t)hrow * vld) = w;
                    if (fo) {
#pragma unroll
                        for (int i = 0; i < 4; ++i) { fo[(size_t)i * 512 + hrow] = a[i]; fo[(size_t)(4 + i) * 512 + hrow] = b[i]; }
                    }
                }
        }
    }
};
#define XB_TMO      128
#define XB_XCNT(j)  (256  + 64 * (j))
#define XB_XSUB(j)  (1280 + 64 * (j))
#define XB_XGEN(j)  (2304 + 64 * (j))
#define XB_TOP      3328
#define XB_TOPGEN   3392
#define XCD_BAR_WORDS 3456
#define XB_SPIN_CAP (1u << 18)

__device__ __forceinline__ unsigned xb_ld(unsigned* p)              { return __hip_atomic_load(p, __ATOMIC_RELAXED, __HIP_MEMORY_SCOPE_AGENT); }
__device__ __forceinline__ unsigned xb_add(unsigned* p, unsigned v) { return __hip_atomic_fetch_add(p, v, __ATOMIC_RELAXED, __HIP_MEMORY_SCOPE_AGENT); }
__device__ __forceinline__ unsigned xb_xcc_id() { return (unsigned)__builtin_amdgcn_s_getreg((3 << 11) | 20) & 0xFu; }
#define XB_SPIN(cond, bar) do { unsigned _sp = 0; while (cond) { __builtin_amdgcn_s_sleep(1); \
    if ((++_sp & 255u) == 0u) { if (xb_ld(&(bar)[XB_TMO])) break; if (_sp > XB_SPIN_CAP) { atomicAdd(&(bar)[XB_TMO], 1u); break; } } } } while (0)

struct XcdBarrier {
    unsigned* bar; unsigned x;
    volatile LAS unsigned* st;
};

__device__ __forceinline__ XcdBarrier xcd_barrier_post(unsigned* bar, volatile LAS unsigned* st) {
    XcdBarrier b; b.bar = bar; b.x = xb_xcc_id(); b.st = st;
    if (threadIdx.x == 0) (void)xb_add(&bar[XB_XCNT(b.x)], 1u);
    return b;
}
__device__ __forceinline__ void xcd_barrier_complete(unsigned* bar, unsigned x, unsigned& nloc, unsigned& nx) {
    const unsigned G = gridDim.x * gridDim.y * gridDim.z;
    unsigned sum, cnt, mine, sp = 0u;
    for (;;) {
        sum = 0u; cnt = 0u; mine = 0u;
#pragma unroll
        for (unsigned j = 0; j < 16; ++j) { const unsigned c = xb_ld(&bar[XB_XCNT(j)]); sum += c; cnt += (c > 0u) ? 1u : 0u; mine = (j == x) ? c : mine; }
        if (sum == G) break;
        __builtin_amdgcn_s_sleep(1);
        if ((++sp & 255u) == 0u) { if (xb_ld(&bar[XB_TMO])) break; if (sp > XB_SPIN_CAP) { atomicAdd(&bar[XB_TMO], 1u); break; } }
    }
    nloc = mine > 0u ? mine : 1u; nx = cnt > 0u ? cnt : 1u;
}

__device__ __forceinline__ void xcd_barrier(const XcdBarrier& b) {
    asm volatile("s_waitcnt vmcnt(0)" ::: "memory");
    __syncthreads();
    if (threadIdx.x == 0) {
        unsigned* bar = b.bar;
        __builtin_amdgcn_s_waitcnt(0);
        unsigned nloc = b.st[0], nx = b.st[1];
        if (nloc == 0u) { xcd_barrier_complete(bar, b.x, nloc, nx); b.st[0] = nloc; b.st[1] = nx; }
        const unsigned old = xb_add(&bar[XB_XSUB(b.x)], 1u);
        const unsigned gen = old / nloc;
        if (old + 1u == (gen + 1u) * nloc) {
            __builtin_amdgcn_fence(__ATOMIC_RELEASE, "agent");
            asm volatile("s_waitcnt vmcnt(0)" ::: "memory");
            const unsigned og = xb_add(&bar[XB_TOP], 1u);
            const unsigned tg = og / nx;
            if (og + 1u == (tg + 1u) * nx) xb_add(&bar[XB_TOPGEN], 1u);
            else XB_SPIN(xb_ld(&bar[XB_TOPGEN]) == tg, bar);
            __builtin_amdgcn_fence(__ATOMIC_ACQUIRE, "agent");
            xb_add(&bar[XB_XGEN(b.x)], 1u);
            asm volatile("s_waitcnt vmcnt(0)" ::: "memory");
        } else {
            XB_SPIN(xb_ld(&bar[XB_XGEN(b.x)]) == gen, bar);
            __builtin_amdgcn_fence(__ATOMIC_ACQUIRE, "agent");
            asm volatile("s_waitcnt vmcnt(0)" ::: "memory");
        }
    }
    __syncthreads();
}
__device__ __forceinline__ int map_row(int kind, int n) {
    if (kind == 0) return n;
    if (kind == 1) return 256 * (n >> 7) + (n & 127);
    if (kind == 2) return 256 * (n >> 7) + 128 + (n & 127);
    const int sec = n >> 9, w = n & 511;
    if (sec == 2) return 2048 + w;
    if (sec == 5) return 2560 + w;
    const int qsec = sec == 0 ? 0 : sec == 1 ? 1 : sec == 3 ? 2 : 3;
    const int c = qsec * 512 + w, pn = c >> 8, ww = c & 255, hw = ww >> 6, d = ww & 63;
    return 256 * pn + 128 * (d >> 5) + 32 * hw + (d & 31);
}
__device__ __forceinline__ void transpose_item(const float* src, int ld_src, int k0, int n0, const float* gain, bf16_t* dst, size_t ld_dst, int kind, LAS float* scr, int lane) {
#pragma unroll 8
    for (int i = 0; i < 32; ++i) {
        const int kk = 2 * i + (lane >> 5);
        float v = src[(size_t)(k0 + kk) * ld_src + n0 + (lane & 31)];
        if (gain) v *= gain[k0 + kk];
        scr[kk * 33 + (lane & 31)] = v;
    }
    asm volatile("s_waitcnt lgkmcnt(0)" ::: "memory");
    const int c = lane & 7;
#pragma unroll
    for (int j = 0; j < 4; ++j) {
        const int n = (lane >> 3) + 8 * j; const LAS float* s = scr + (8 * c) * 33 + n;
        u32x4 o; o.x = cvt_pk_bf16(s[0 * 33], s[1 * 33]); o.y = cvt_pk_bf16(s[2 * 33], s[3 * 33]); o.z = cvt_pk_bf16(s[4 * 33], s[5 * 33]); o.w = cvt_pk_bf16(s[6 * 33], s[7 * 33]);
        if (kind == 4) { const int row = n0 + n; *(u32x4*)((char*)dst + (((size_t)(row >> 8) * (DFF / 64) + (k0 >> 6)) * 2 + ((row >> 7) & 1)) * 16384 + pg8::lds_byte(row & 127, 8 * c)) = o; }
        else *(u32x4*)(dst + (size_t)map_row(kind, n0 + n) * ld_dst + k0 + 8 * c) = o;
    }
    asm volatile("s_waitcnt lgkmcnt(0)" ::: "memory");
}
__device__ __forceinline__ void do_job(const float* src, int R, int C, const float* gain, bf16_t* dst, size_t ld_dst, int kind, int item, LAS float* scr, int lane) {
    const int nblk = C >> 5, kb = item / nblk, nb = item - kb * nblk;
    (void)R;
    transpose_item(src, C, 64 * kb, 32 * nb, gain, dst, ld_dst, kind, scr, lane);
}

__device__ __forceinline__ void convert_caches(KArgP A, LAS unsigned char* lds, int l, int gw, int NGW, int wave) {
    int lane_l = lane_id_fresh(); asm volatile("" : "+v"(lane_l)); const int lane = lane_l;
    unsigned char* ws = A->ws;
    LAS float* scr = (LAS float*)(lds + wave * 16384);
    constexpr int I_CAV = 32 * 128;
    for (int it = gw; it < I_CAV; it += NGW) {
        {
            const int lb = l * 32 + (it >> 7), item = it & 127;
            do_job(A->in[3] + (size_t)lb * 512 * 512, 512, 512, nullptr, (bf16_t*)(ws + WS_VSA) + (size_t)lb * 512 * KSA_ROWS, KSA_ROWS, 0, item, scr, lane);
        }
    }
    for (int r = gw; r < 32 * 512; r += NGW) {
        const float* s; bf16_t* d;
        if (r < 32 * 512) { const int lb = l * 32 + (r >> 9), key = r & 511; s = A->in[2] + ((size_t)lb * 512 + key) * 512; d = (bf16_t*)(ws + WS_KSA) + (size_t)(lb * KSA_ROWS + key) * 512; }
        else { const int q = r - 32 * 512, lb = l * 32 + (q >> 11), key = q & 2047; s = A->in[4] + ((size_t)lb * 2048 + key) * 512; d = (bf16_t*)(ws + WS_KSB) + (size_t)(lb * KSB_ROWS + key) * 512; }
        const f32x4 a = *(const f32x4*)(s + 8 * lane), b = *(const f32x4*)(s + 8 * lane + 4);
        u32x4 w; w.x = cvt_pk_bf16(a[0], a[1]); w.y = cvt_pk_bf16(a[2], a[3]); w.z = cvt_pk_bf16(b[0], b[1]); w.w = cvt_pk_bf16(b[2], b[3]);
        *(u32x4*)(d + 8 * lane) = w;
    }
}

__device__ __forceinline__ void prologue(KArgP A, LAS unsigned char* lds, int gw, int NGW, int wave) {
    int lane_l = lane_id_fresh(); asm volatile("" : "+v"(lane_l)); const int lane = lane_l;
    unsigned char* ws = A->ws;
    LAS float* scr = (LAS float*)(lds + wave * 16384);
    constexpr int I_GU = 16 * 88, I_D = 44 * 32, I_IN = 16 * 96, I_O = 16 * 32;
    constexpr int I_LAYER = 4 * I_GU + 2 * I_D + I_IN + I_O;
    constexpr int I_W = 2 * I_LAYER;
    for (int it = gw; it < I_W; it += NGW) {
        {
            const int l = it / I_LAYER; int r = it - l * I_LAYER;
            unsigned char* wl = ws + WS_W + (size_t)l * W_LAYER;
            const float* gf1 = A->in[6] + l * DM; const float* gmx = A->in[10] + l * DM; const float* gf2 = A->in[23] + l * DM;
            if (r < I_GU) { do_job(A->in[7] + (size_t)l * DM * DFF, DM, DFF, gf1, (bf16_t*)(wl + W_GU1), DM, 1, r, scr, lane); continue; } r -= I_GU;
            if (r < I_GU) { do_job(A->in[8] + (size_t)l * DM * DFF, DM, DFF, gf1, (bf16_t*)(wl + W_GU1), DM, 2, r, scr, lane); continue; } r -= I_GU;
            if (r < I_D)  { do_job(A->in[9] + (size_t)l * DM * DFF, DFF, DM, nullptr, (bf16_t*)(wl + W_D1), LDP, 4, r, scr, lane); continue; } r -= I_D;
            if (r < I_IN) { do_job(A->in[11] + (size_t)l * DM * 3072, DM, 3072, gmx, (bf16_t*)(wl + W_IN), DM, 3, r, scr, lane); continue; } r -= I_IN;
            if (r < I_O)  { do_job(A->in[22] + (size_t)l * DM * DM, DM, DM, nullptr, (bf16_t*)(wl + W_OUT), DM, 0, r, scr, lane); continue; } r -= I_O;
            if (r < I_GU) { do_job(A->in[24] + (size_t)l * DM * DFF, DM, DFF, gf2, (bf16_t*)(wl + W_GU2), DM, 1, r, scr, lane); continue; } r -= I_GU;
            if (r < I_GU) { do_job(A->in[25] + (size_t)l * DM * DFF, DM, DFF, gf2, (bf16_t*)(wl + W_GU2), DM, 2, r, scr, lane); continue; } r -= I_GU;
            do_job(A->in[26] + (size_t)l * DM * DFF, DFF, DM, nullptr, (bf16_t*)(wl + W_D2), LDP, 4, r, scr, lane);
        }
    }
    convert_caches(A, lds, 0, gw, NGW, wave);
    convert_caches(A, lds, 1, gw, NGW, wave);
    float* ssq = (float*)(ws + WS_SSQ);
    bf16_t* xb = (bf16_t*)(ws + WS_XB);
    for (int r = gw; r < MT; r += NGW) {
        const float* xr = (r < MP) ? A->in[0] + (size_t)r * DM : A->in[1] + (size_t)(r - MP) * DM;
        float s = 0.f;
#pragma unroll
        for (int j = 0; j < 4; ++j) {
            const f32x4 v = *(const f32x4*)(xr + 256 * j + 4 * lane);
            s += (v[0] * v[0] + v[1] * v[1]) + (v[2] * v[2] + v[3] * v[3]);
            u32x2 w; w.x = cvt_pk_bf16(v[0], v[1]); w.y = cvt_pk_bf16(v[2], v[3]);
            *(u32x2*)(xb + (size_t)r * DM + 256 * j + 4 * lane) = w;
        }
        s = wave_sum(s, lane);
        if (lane == 0) ssq[r] = s;
    }
    for (int i = gw * 64 + lane; i < 6 * MT; i += NGW * 64) ssq[MT + i] = 0.f;
    float* rope = (float*)(ws + WS_ROPE);
    for (int i = gw * 64 + lane; i < 2112 * 32; i += NGW * 64) {
        const int pos = i >> 5, j = i & 31;
        const double a = (double)((float)pos * (float)ROPE_INV[j]);
        const double kq = __builtin_rint(a * 0.63661977236758134308);
        const double rr = (a - kq * 1.5707963267948966192) - kq * 6.123233995736766e-17;
        const double r2 = rr * rr;
        const double sn = rr * (1.0 + r2 * (-1.0 / 6 + r2 * (1.0 / 120 + r2 * (-1.0 / 5040 + r2 * (1.0 / 362880 + r2 * (-1.0 / 39916800 + r2 * (1.0 / 6227020800.0)))))));
        const double cn = 1.0 + r2 * (-0.5 + r2 * (1.0 / 24 + r2 * (-1.0 / 720 + r2 * (1.0 / 40320 + r2 * (-1.0 / 3628800 + r2 * (1.0 / 479001600 + r2 * (-1.0 / 87178291200.0)))))));
        const int q = ((int)kq) & 3;
        const double c = q == 0 ? cn : q == 1 ? -sn : q == 2 ? -cn : sn;
        const double s = q == 0 ? sn : q == 1 ? cn : q == 2 ? -sn : -cn;
        rope[(size_t)pos * 64 + j] = (float)c; rope[(size_t)pos * 64 + 32 + j] = (float)s;
    }
    if (gw == 0) {
        unsigned* ctl = (unsigned*)(ws + WS_CTL);
        float* cst = (float*)(ws + WS_CTL + 4096);
        if (lane < 16) ctl[lane] = 0u;
        for (int i = lane; i < XCD_BAR_WORDS; i += 64) ((unsigned*)(ws + WS_BAR))[i] = 0u;
        for (int l = 0; l < 2; ++l) {
            const float mqa = wave_max(fabsf(A->in[12][l * 64 + lane]), lane), mka = wave_max(fabsf(A->in[13][l * 64 + lane]), lane);
            const float mqb = wave_max(fabsf(A->in[14][l * 64 + lane]), lane), mkb = wave_max(fabsf(A->in[15][l * 64 + lane]), lane);
            float mb = 0.f;
            for (int i = lane; i < 8 * 257; i += 64) mb = fmaxf(mb, fabsf(A->in[16][l * 8 * 257 + i]));
            mb = wave_max(mb, lane);
            const float d1 = wave_sum(A->in[17][l * 64 + lane] * A->in[18][l * 64 + lane], lane), d2 = wave_sum(A->in[19][l * 64 + lane] * A->in[20][l * 64 + lane], lane);
            const float lam_init = l == 0 ? 0.2f : 0.35550906759096934f;
            if (lane == 0) {
                cst[l * 8 + 0] = LOG2E * (8.0f * mqa * mka + mb);
                cst[l * 8 + 1] = LOG2E * (8.0f * mqb * mkb);
                cst[l * 8 + 2] = expf(d1) - expf(d2) + lam_init;
                cst[l * 8 + 3] = 1.0f - lam_init;
            }
        }
    }
}

__device__ __forceinline__ int swap23(int r) { return (r & 19) | ((r & 4) << 1) | ((r & 8) >> 1); }
__device__ __forceinline__ f32x16 mfma32(bf16x8 a, bf16x8 b, f32x16 c) { return __builtin_amdgcn_mfma_f32_32x32x16_bf16(a, b, c, 0, 0, 0); }
__device__ __forceinline__ bf16x8 pack8(const f32x16& p, int s) {
    u32x4 w; w.x = cvt_pk_bf16(p[8 * s + 0], p[8 * s + 1]); w.y = cvt_pk_bf16(p[8 * s + 2], p[8 * s + 3]); w.z = cvt_pk_bf16(p[8 * s + 4], p[8 * s + 5]); w.w = cvt_pk_bf16(p[8 * s + 6], p[8 * s + 7]);
    return __builtin_bit_cast(bf16x8, w);
}
constexpr int ATT_BUF = 32768, ATT_WAVE = 65536, ATT_BW = 131072 + 64;

__device__ __forceinline__ void attn_a_block(const bf16_t* Qw, const bf16_t* Kb, const bf16_t* Vtb, int ldv, int T, int t_lo, int t_hi, int t_self, int qoff,
                                             bf16_t* Outw, LAS unsigned char* lds, int wave, int lane_in) {
    int lane = lane_in; asm volatile("" : "+v"(lane));
    const int r32 = lane & 31, hi = lane >> 5;
    const bool active = t_lo <= t_hi;
    const LAS float* E = (const LAS float*)(lds + ATT_WAVE + wave * 8192);
    bf16x8 qf[4];
#pragma unroll
    for (int d0 = 0; d0 < 4; ++d0) qf[d0] = active ? *(const bf16x8*)(Qw + (size_t)r32 * 512 + 16 * d0 + 8 * hi) : (bf16x8){0, 0, 0, 0, 0, 0, 0, 0};
    f32x16 o0, o1;
#pragma unroll
    for (int r = 0; r < 16; ++r) { o0[r] = 0.f; o1[r] = 0.f; }
    float l = 0.f;
    const float cfar = E[192];
    const int key_l = 8 * wave + (lane & 7), c8 = lane >> 3;
    const bf16_t* kg = Kb + (size_t)key_l * 512 + 8 * c8;
    const bf16_t* vg = Vtb + (size_t)key_l * ldv + 8 * c8;
    const int koff = ((key_l >> 5) * 4 + (c8 >> 1)) * 1024 + (swap23(key_l & 31) + 32 * (c8 & 1)) * 16;
    const int voff = 8192 + (((c8 >> 2) * 2 + (key_l >> 5)) * 2 + ((c8 >> 1) & 1)) * 1024 + ((key_l & 31) + 32 * (c8 & 1)) * 16;
    constexpr int ABUF = 16384;
    u32x4 skA = *(const u32x4*)kg, svA = *(const u32x4*)vg, skB = skA, svB = svA;
    if (T > 1) { skB = *(const u32x4*)(kg + (size_t)64 * 512); svB = *(const u32x4*)(vg + 64); }
    *(LAS u32x4*)(lds + koff) = skA; *(LAS u32x4*)(lds + voff) = svA;
    __syncthreads();
    int cb = 0;
#define A_STEP(t, LK, LV, WK, WV) do { \
        if ((t) + 2 < T) { LK = *(const u32x4*)(kg + (size_t)((t) + 2) * 64 * 512); LV = *(const u32x4*)(vg + ((t) + 2) * 64); } \
        if ((t) >= t_lo && (t) <= t_hi) { \
            const LAS bf16x8* KF = (const LAS bf16x8*)(lds + cb * ABUF); \
            const LAS bf16x8* VF = KF + 512; \
            _Pragma("unroll") for (int j = 0; j < 2; ++j) { \
                f32x16 sa; \
                const int relbase = 64 * (t_self - (t)) - 32 * j + qoff; \
                if (relbase - 31 >= 128) { _Pragma("unroll") for (int r = 0; r < 16; ++r) sa[r] = cfar; } \
                else { const int bi = relbase + 64 + r32 - 8 * hi - 23; _Pragma("unroll") for (int r = 0; r < 16; ++r) sa[r] = E[bi + 23 - (r & 7) - 16 * (r >> 3)]; } \
                _Pragma("unroll") for (int d0 = 0; d0 < 4; ++d0) sa = mfma32(KF[(j * 4 + d0) * 64 + lane], qf[d0], sa); \
                float ps = 0.f; \
                _Pragma("unroll") for (int r = 0; r < 16; ++r) { sa[r] = fast_exp2(sa[r]); ps += sa[r]; } \
                l += ps; \
                const bf16x8 p0 = pack8(sa, 0), p1 = pack8(sa, 1); \
                o0 = mfma32(VF[((j * 2 + 0) * 2 + 0) * 64 + lane], p0, o0); o0 = mfma32(VF[((j * 2 + 0) * 2 + 1) * 64 + lane], p1, o0); \
                o1 = mfma32(VF[((j * 2 + 1) * 2 + 0) * 64 + lane], p0, o1); o1 = mfma32(VF[((j * 2 + 1) * 2 + 1) * 64 + lane], p1, o1); \
            } \
        } \
        const int nb = cb == 2 ? 0 : cb + 1; \
        if ((t) + 1 < T) { *(LAS u32x4*)(lds + nb * ABUF + koff) = WK; *(LAS u32x4*)(lds + nb * ABUF + voff) = WV; } \
        cb = nb; \
        __syncthreads(); \
    } while (0)
    for (int t = 0; t < T; t += 2) {
        A_STEP(t, skA, svA, skB, svB);
        if (t + 1 < T) A_STEP(t + 1, skB, svB, skA, svA);
    }
#undef A_STEP
    if (active) {
        const int le = lane_id_fresh(), r32e = le & 31, hie = le >> 5;
        l += shx(l, le, 32);
        const float inv = 1.0f / l;
#pragma unroll
        for (int g = 0; g < 4; ++g) {
            u32x2 w0, w1;
            w0.x = cvt_pk_bf16(o0[4 * g] * inv, o0[4 * g + 1] * inv); w0.y = cvt_pk_bf16(o0[4 * g + 2] * inv, o0[4 * g + 3] * inv);
            w1.x = cvt_pk_bf16(o1[4 * g] * inv, o1[4 * g + 1] * inv); w1.y = cvt_pk_bf16(o1[4 * g + 2] * inv, o1[4 * g + 3] * inv);
            *(u32x2*)(Outw + (size_t)r32e * DM + 8 * g + 4 * hie) = w0;
            *(u32x2*)(Outw + (size_t)r32e * DM + 32 + 8 * g + 4 * hie) = w1;
        }
    }
}
__device__ __forceinline__ void attn_b_block(const bf16_t* Qw, const bf16_t* Kb, const bf16_t* Vtb, int ldv, int T, int tlim, float nshift, float lam, float post, const float* gsub,
                                             bf16_t* Outw, LAS unsigned char* lds, int wave, int lane_in) {
    int lane = lane_in; asm volatile("" : "+v"(lane));
    const int r32 = lane & 31, hi = lane >> 5;
    LAS bf16x8* Qs = (LAS bf16x8*)(lds + ATT_WAVE + wave * 8192);
    if (tlim > 0) {
#pragma unroll
        for (int m = 0; m < 2; ++m)
#pragma unroll
            for (int d0 = 0; d0 < 4; ++d0) Qs[(m * 4 + d0) * 64 + lane] = *(const bf16x8*)(Qw + (size_t)r32 * 512 + 64 * m + 16 * d0 + 8 * hi);
    }
    f32x16 o1[4], o2[4];
#pragma unroll
    for (int db = 0; db < 4; ++db)
#pragma unroll
        for (int r = 0; r < 16; ++r) { o1[db][r] = 0.f; o2[db][r] = 0.f; }
    float l1 = 0.f, l2 = 0.f;
    const int key_l = 8 * wave + (lane & 7), c8 = lane >> 3;
    const bf16_t* kg = Kb + (size_t)key_l * 512 + 8 * c8;
    const int koff = ((key_l >> 5) * 8 + (c8 >> 1)) * 1024 + (swap23(key_l & 31) + 32 * (c8 & 1)) * 16;
    const int d_l = 16 * wave + (lane & 7);
    const bf16_t* vg = Vtb + (size_t)d_l * ldv + 8 * c8;
    const int voff = 16384 + (((c8 >> 2) * 4 + (d_l >> 5)) * 2 + ((c8 >> 1) & 1)) * 1024 + ((d_l & 31) + 32 * (c8 & 1)) * 16;
    u32x4 sk0 = *(const u32x4*)kg, sk1 = *(const u32x4*)(kg + 64), sv0 = *(const u32x4*)vg, sv1 = *(const u32x4*)(vg + (size_t)8 * ldv);
    *(LAS u32x4*)(lds + koff) = sk0; *(LAS u32x4*)(lds + koff + 4096) = sk1; *(LAS u32x4*)(lds + voff) = sv0; *(LAS u32x4*)(lds + voff + 128) = sv1;
    __syncthreads();
    for (int t = 0; t < T; ++t) {
        const bool more = t + 1 < T;
        if (more) {
            const bf16_t* kn = kg + (size_t)(t + 1) * 64 * 512; const bf16_t* vn = vg + (t + 1) * 64;
            sk0 = *(const u32x4*)kn; sk1 = *(const u32x4*)(kn + 64); sv0 = *(const u32x4*)vn; sv1 = *(const u32x4*)(vn + (size_t)8 * ldv);
        }
        if (t < tlim) {
            const LAS bf16x8* KF = (const LAS bf16x8*)(lds + (t & 1) * ATT_BUF);
            const LAS bf16x8* VF = KF + 1024;
#pragma unroll
            for (int j = 0; j < 2; ++j) {
                bf16x8 pa[2], pb[2];
                {
                    f32x16 sa;
#pragma unroll
                    for (int r = 0; r < 16; ++r) sa[r] = nshift;
#pragma unroll
                    for (int d0 = 0; d0 < 4; ++d0) sa = mfma32(KF[((j * 2 + 0) * 4 + d0) * 64 + lane], Qs[d0 * 64 + lane], sa);
                    float ps = 0.f;
#pragma unroll
                    for (int r = 0; r < 16; ++r) { sa[r] = fast_exp2(sa[r]); ps += sa[r]; }
                    l1 += ps; pa[0] = pack8(sa, 0); pa[1] = pack8(sa, 1);
                }
                {
                    f32x16 sa;
#pragma unroll
                    for (int r = 0; r < 16; ++r) sa[r] = nshift;
#pragma unroll
                    for (int d0 = 0; d0 < 4; ++d0) sa = mfma32(KF[((j * 2 + 1) * 4 + d0) * 64 + lane], Qs[(4 + d0) * 64 + lane], sa);
                    float ps = 0.f;
#pragma unroll
                    for (int r = 0; r < 16; ++r) { sa[r] = fast_exp2(sa[r]); ps += sa[r]; }
                    l2 += ps; pb[0] = pack8(sa, 0); pb[1] = pack8(sa, 1);
                }
#pragma unroll
                for (int db = 0; db < 4; ++db)
#pragma unroll
                    for (int s = 0; s < 2; ++s) {
                        const bf16x8 vf = VF[((j * 4 + db) * 2 + s) * 64 + lane];
                        o1[db] = mfma32(vf, pa[s], o1[db]); o2[db] = mfma32(vf, pb[s], o2[db]);
                    }
            }
        }
        if (more) {
            LAS unsigned char* nb = lds + ((t + 1) & 1) * ATT_BUF;
            *(LAS u32x4*)(nb + koff) = sk0; *(LAS u32x4*)(nb + koff + 4096) = sk1; *(LAS u32x4*)(nb + voff) = sv0; *(LAS u32x4*)(nb + voff + 128) = sv1;
        }
        __syncthreads();
    }
    if (tlim > 0) {
        const int le = lane_id_fresh(), r32e = le & 31, hie = le >> 5;
        l1 += shx(l1, le, 32); l2 += shx(l2, le, 32);
        const float i1 = 1.0f / l1, i2 = lam / l2;
        float ss = 0.f;
#pragma unroll
        for (int db = 0; db < 4; ++db)
#pragma unroll
            for (int r = 0; r < 16; ++r) { const float v = o1[db][r] * i1 - o2[db][r] * i2; o1[db][r] = v; ss += v * v; }
        ss += shx(ss, le, 32);
        const float rr = rsqrtf(ss * (1.0f / 128.0f) + EPS) * post;
#pragma unroll
        for (int db = 0; db < 4; ++db)
#pragma unroll
            for (int g = 0; g < 4; ++g) {
                const int d = 32 * db + 8 * g + 4 * hie;
                const f32x4 gs = *(const f32x4*)(gsub + d);
                u32x2 w; w.x = cvt_pk_bf16(o1[db][4 * g] * rr * gs[0], o1[db][4 * g + 1] * rr * gs[1]); w.y = cvt_pk_bf16(o1[db][4 * g + 2] * rr * gs[2], o1[db][4 * g + 3] * rr * gs[3]);
                *(u32x2*)(Outw + (size_t)r32e * DM + d) = w;
            }
    }
}
__device__ __forceinline__ void attn_bs_block(KArgP A, int l, int b, int h, float nshift, float lam, float post, const float* gsub, LAS unsigned char* lds, int wave, int lane_in) {
    int lane = lane_in; asm volatile("" : "+v"(lane));
    unsigned char* ws = A->ws;
    const int lb = l * 32 + b;
    constexpr int T = 33;
    const float* ck = A->in[4] + (size_t)lb * 2048 * 512 + h * 128;
    const float* cv = A->in[5] + (size_t)lb * 2048 * 512 + h * 128;
    const bf16_t* nk = (const bf16_t*)(ws + WS_KSB) + ((size_t)lb * KSB_ROWS + 2048) * 512 + h * 128;
    const bf16_t* nv = (const bf16_t*)(ws + WS_VSB) + ((size_t)lb * 512 + h * 128) * KSB_ROWS + 2048;
    const int li = (wave - 2) * 64 + lane;
#define BS_FILL(t) do { \
        LAS unsigned char* fb = lds + ((t) & 1) * ATT_BUF; \
        if ((t) < 32) { \
            _Pragma("unroll") for (int i = 0; i < 3; ++i) { const int ci = li + 384 * i; \
                if (ci < 1024) { const int key = ci >> 4, c16 = ci & 15, c8 = c16 & 7; \
                    const float* src = ck + (size_t)(64 * (t) + key) * 512 + 8 * c16; \
                    const f32x4 a = *(const f32x4*)src, c = *(const f32x4*)(src + 4); \
                    u32x4 w; w.x = cvt_pk_bf16(a[0], a[1]); w.y = cvt_pk_bf16(a[2], a[3]); w.z = cvt_pk_bf16(c[0], c[1]); w.w = cvt_pk_bf16(c[2], c[3]); \
                    *(LAS u32x4*)(fb + ((key >> 5) * 8 + (c16 >> 3) * 4 + (c8 >> 1)) * 1024 + (swap23(key & 31) + 32 * (c8 & 1)) * 16) = w; } } \
            if (li < 256) { const int g = li >> 5, d4 = li & 31; \
                f32x4 r[8]; \
                _Pragma("unroll") for (int kk = 0; kk < 8; ++kk) r[kk] = *(const f32x4*)(cv + (size_t)(64 * (t) + 8 * g + kk) * 512 + 4 * d4); \
                _Pragma("unroll") for (int i = 0; i < 4; ++i) { const int d = 4 * d4 + i; \
                    u32x4 w; w.x = cvt_pk_bf16(r[0][i], r[1][i]); w.y = cvt_pk_bf16(r[2][i], r[3][i]); w.z = cvt_pk_bf16(r[4][i], r[5][i]); w.w = cvt_pk_bf16(r[6][i], r[7][i]); \
                    *(LAS u32x4*)(fb + 16384 + (((g >> 2) * 4 + (d >> 5)) * 2 + ((g >> 1) & 1)) * 1024 + ((d & 31) + 32 * (g & 1)) * 16) = w; } } \
        } else { \
            _Pragma("unroll") for (int i = 0; i < 3; ++i) { const int ci = li + 384 * i; \
                if (ci < 1024) { const int key = ci >> 4, c16 = ci & 15, c8 = c16 & 7; \
                    const u32x4 w = *(const u32x4*)(nk + (size_t)key * 512 + 8 * c16); \
                    *(LAS u32x4*)(fb + ((key >> 5) * 8 + (c16 >> 3) * 4 + (c8 >> 1)) * 1024 + (swap23(key & 31) + 32 * (c8 & 1)) * 16) = w; \
                    const int d = ci >> 3, g = ci & 7; \
                    const u32x4 v = *(const u32x4*)(nv + (size_t)d * KSB_ROWS + 8 * g); \
                    *(LAS u32x4*)(fb + 16384 + (((g >> 2) * 4 + (d >> 5)) * 2 + ((g >> 1) & 1)) * 1024 + ((d & 31) + 32 * (g & 1)) * 16) = v; } } \
        } \
    } while (0)
    if (wave >= 2) {
        BS_FILL(0);
        __syncthreads();
        for (int t = 0; t < T; ++t) {
            if (t + 1 < T) BS_FILL(t + 1);
            __syncthreads();
        }
    } else {
        const int r32 = lane & 31, hi = lane >> 5;
        const int row0 = MP + b * 64 + 32 * wave;
        const bf16_t* Qw = (const bf16_t*)(ws + WS_QB) + (size_t)row0 * 512 + h * 128;
        LAS bf16x8* Qs = (LAS bf16x8*)(lds + ATT_WAVE + wave * 8192);
#pragma unroll
        for (int m = 0; m < 2; ++m)
#pragma unroll
            for (int d0 = 0; d0 < 4; ++d0) Qs[(m * 4 + d0) * 64 + lane] = *(const bf16x8*)(Qw + (size_t)r32 * 512 + 64 * m + 16 * d0 + 8 * hi);
        f32x16 o1[4], o2[4];
#pragma unroll
        for (int db = 0; db < 4; ++db)
#pragma unroll
            for (int r = 0; r < 16; ++r) { o1[db][r] = 0.f; o2[db][r] = 0.f; }
        float l1 = 0.f, l2 = 0.f;
        __syncthreads();
        for (int t = 0; t < T; ++t) {
            const LAS bf16x8* KF = (const LAS bf16x8*)(lds + (t & 1) * ATT_BUF);
            const LAS bf16x8* VF = KF + 1024;
#pragma unroll
            for (int j = 0; j < 2; ++j) {
                bf16x8 pa[2], pb[2];
                {
                    f32x16 sa;
#pragma unroll
                    for (int r = 0; r < 16; ++r) sa[r] = nshift;
#pragma unroll
                    for (int d0 = 0; d0 < 4; ++d0) sa = mfma32(KF[((j * 2 + 0) * 4 + d0) * 64 + lane], Qs[d0 * 64 + lane], sa);
                    float ps = 0.f;
#pragma unroll
                    for (int r = 0; r < 16; ++r) { sa[r] = fast_exp2(sa[r]); ps += sa[r]; }
                    l1 += ps; pa[0] = pack8(sa, 0); pa[1] = pack8(sa, 1);
                }
                {
                    f32x16 sa;
#pragma unroll
                    for (int r = 0; r < 16; ++r) sa[r] = nshift;
#pragma unroll
                    for (int d0 = 0; d0 < 4; ++d0) sa = mfma32(KF[((j * 2 + 1) * 4 + d0) * 64 + lane], Qs[(4 + d0) * 64 + lane], sa);
                    float ps = 0.f;
#pragma unroll
                    for (int r = 0; r < 16; ++r) { sa[r] = fast_exp2(sa[r]); ps += sa[r]; }
                    l2 += ps; pb[0] = pack8(sa, 0); pb[1] = pack8(sa, 1);
                }
#pragma unroll
                for (int db = 0; db < 4; ++db)
#pragma unroll
                    for (int s = 0; s < 2; ++s) {
                        const bf16x8 vf = VF[((j * 4 + db) * 2 + s) * 64 + lane];
                        o1[db] = mfma32(vf, pa[s], o1[db]); o2[db] = mfma32(vf, pb[s], o2[db]);
                    }
            }
            __syncthreads();
        }
        const int le = lane_id_fresh(), r32e = le & 31, hie = le >> 5;
        l1 += shx(l1, le, 32); l2 += shx(l2, le, 32);
        const float i1 = 1.0f / l1, i2 = lam / l2;
        float ss = 0.f;
#pragma unroll
        for (int db = 0; db < 4; ++db)
#pragma unroll
            for (int r = 0; r < 16; ++r) { const float v = o1[db][r] * i1 - o2[db][r] * i2; o1[db][r] = v; ss += v * v; }
        ss += shx(ss, le, 32);
        const float rr = rsqrtf(ss * (1.0f / 128.0f) + EPS) * post;
        bf16_t* Outw = (bf16_t*)(ws + WS_O) + (size_t)row0 * DM + 512 + h * 128;
#pragma unroll
        for (int db = 0; db < 4; ++db)
#pragma unroll
            for (int g = 0; g < 4; ++g) {
                const int d = 32 * db + 8 * g + 4 * hie;
                const f32x4 gs = *(const f32x4*)(gsub + d);
                u32x2 w; w.x = cvt_pk_bf16(o1[db][4 * g] * rr * gs[0], o1[db][4 * g + 1] * rr * gs[1]); w.y = cvt_pk_bf16(o1[db][4 * g + 2] * rr * gs[2], o1[db][4 * g + 3] * rr * gs[3]);
                *(u32x2*)(Outw + (size_t)r32e * DM + d) = w;
            }
    }
#undef BS_FILL
}
constexpr int U_BS = 128, U_BP = 512, U_AP = 1024, U_AS = 256, U_B = U_BS + U_BP, U_ALL = U_B + U_AP + U_AS;
__device__ __forceinline__ void attn_phase(KArgP A, int l, LAS unsigned char* lds, int wave, int cidx) {
    unsigned char* ws = A->ws;
    unsigned* ctr = (unsigned*)(ws + WS_CTL) + cidx;
    const float* cst = (const float*)(ws + WS_CTL + 4096) + l * 8;
#define SGPR_F(x) __builtin_bit_cast(float, __builtin_amdgcn_readfirstlane(__builtin_bit_cast(int, (x))))
    const float shA = SGPR_F(cst[0]), shB = SGPR_F(cst[1]), lam = SGPR_F(cst[2]), post = SGPR_F(cst[3]);
#undef SGPR_F
    volatile LAS int* bw = (volatile LAS int*)(lds + ATT_BW);
    const bf16_t* QA = (const bf16_t*)(ws + WS_QA); const bf16_t* QB = (const bf16_t*)(ws + WS_QB);
    bf16_t* O = (bf16_t*)(ws + WS_O);
    const float* bias = A->in[16] + (size_t)l * 8 * 257;
    const float* gsub = A->in[21] + l * 128;
    for (;;) {
        int lane_l = lane_id_fresh(); asm volatile("" : "+v"(lane_l)); const int lane = lane_l;
        __syncthreads();
        if (wave == 0 && lane == 0) bw[0] = (int)atomicAdd(ctr, 1u);
        __syncthreads();
        const int uid = __builtin_amdgcn_readfirstlane(bw[0]);
        if (uid >= U_ALL) break;
        if (uid < U_BS) {
            attn_bs_block(A, l, uid >> 2, uid & 3, -shB, lam, post, gsub, lds, wave, lane);
        } else if (uid < U_B) {
            int b, h, T, tlim, row0, ldv; const bf16_t* K; const bf16_t* Vt;
            if (uid < U_BS) { b = uid >> 2; h = uid & 3; T = 33; tlim = wave < 2 ? 33 : 0; row0 = MP + b * 64 + 32 * (wave & 1); ldv = KSB_ROWS;
                K = (const bf16_t*)(ws + WS_KSB) + (size_t)(l * 32 + b) * KSB_ROWS * 512 + h * 128;
                Vt = (const bf16_t*)(ws + WS_VSB) + ((size_t)(l * 32 + b) * 512 + h * 128) * KSB_ROWS; }
            else { const int v = uid - U_BS, qb = 7 - (v >> 6), w = v & 63; b = w >> 2; h = w & 3; T = 4 * qb + 4; tlim = 4 * qb + (wave >> 1) + 1; row0 = b * 2048 + 256 * qb + 32 * wave; ldv = 2048;
                K = (const bf16_t*)(ws + WS_KBP) + (size_t)b * 2048 * 512 + h * 128;
                Vt = (const bf16_t*)(ws + WS_VBP) + ((size_t)b * 512 + h * 128) * 2048; }
            attn_b_block(QB + (size_t)row0 * 512 + h * 128, K, Vt, ldv, T, tlim, -shB, lam, post, gsub, O + (size_t)row0 * DM + 512 + h * 128, lds, wave, lane);
        } else {
            int b, h, T, t_lo, t_hi, t_self, row0, ldv; const bf16_t* K; const bf16_t* Vt;
            if (uid < U_B + U_AP) { const int v = uid - U_B, cq = 7 - (v >> 7), w = v & 127; b = w >> 3; h = w & 7;
                const int kc0 = cq >= 2 ? 4 * cq - 8 : 0, cw = 4 * cq + (wave >> 1);
                T = 4 * cq + 4 - kc0; t_self = cw - kc0; t_hi = t_self; t_lo = cw - 8 - kc0 > 0 ? cw - 8 - kc0 : 0; row0 = b * 2048 + 256 * cq + 32 * wave; ldv = 2048;
                K = (const bf16_t*)(ws + WS_KAP) + ((size_t)b * 2048 + 64 * kc0) * 512 + h * 64;
                Vt = (const bf16_t*)(ws + WS_VAP) + ((size_t)b * 512 + h * 64) * 2048 + 64 * kc0; }
            else { const int v = uid - U_B - U_AP; b = v >> 3; h = v & 7; T = 9; t_self = 8; t_lo = wave < 2 ? 0 : 1; t_hi = wave < 2 ? 8 : 0; row0 = MP + b * 64 + 32 * (wave & 1); ldv = KSA_ROWS;
                K = (const bf16_t*)(ws + WS_KSA) + (size_t)(l * 32 + b) * KSA_ROWS * 512 + h * 64;
                Vt = (const bf16_t*)(ws + WS_VSA) + ((size_t)(l * 32 + b) * 512 + h * 64) * KSA_ROWS; }
            LAS float* E = (LAS float*)(lds + ATT_WAVE + wave * 8192);
#pragma unroll
            for (int j = 0; j < 5; ++j) { const int i = lane + 64 * j; int rel = i - 64; rel = rel < -128 ? -128 : (rel > 128 ? 128 : rel); E[i] = LOG2E * bias[h * 257 + rel + 128] - shA; }
            attn_a_block(QA + (size_t)row0 * 512 + h * 64, K, Vt, ldv, T, t_lo, t_hi, t_self, 32 * (wave & 1), O + (size_t)row0 * DM + h * 64, lds, wave, lane);
        }
    }
}

__device__ __forceinline__ bool in_phase(int p) { KArgP k = (KArgP)__builtin_amdgcn_kernarg_segment_ptr(); asm volatile("" : "+s"(k)); return k->ph_lo <= p && p < k->ph_hi; }
__global__ void __launch_bounds__(512, 2) mega_fwd(Args KA) {
    extern __shared__ __attribute__((aligned(16))) unsigned char lds_raw[];
    LAS unsigned char* lds = (LAS unsigned char*)lds_raw;
    const int tid = threadIdx.x, wave = __builtin_amdgcn_readfirstlane(tid >> 6);
    const int G = gridDim.x, bx = blockIdx.x;
    const int vcu = (G % 8 == 0) ? (bx % 8) * (G / 8) + bx / 8 : bx;
    (void)KA;
    if (tid == 0) { ((volatile LAS unsigned*)(lds + ATT_BW + 64))[0] = 0u; ((volatile LAS unsigned*)(lds + ATT_BW + 64))[1] = 0u; ((volatile LAS unsigned*)(lds + ATT_BW + 64))[2] = (unsigned)bx; }
    __syncthreads();
#define FRESH_KAP(name) KArgP name = (KArgP)__builtin_amdgcn_kernarg_segment_ptr(); asm volatile("" : "+s"(name))
#define IN_PH(p) in_phase(p)
#define SEAM(p) do { FRESH_KAP(ks_); if (ks_->coop && (p) + 1 < ks_->ph_hi) { XcdBarrier xb_; xb_.bar = (unsigned*)(ks_->ws + WS_BAR); xb_.x = xb_xcc_id(); xb_.st = (volatile LAS unsigned*)(lds + ATT_BW + 64); xcd_barrier(xb_); } } while (0)
#define KARGS() KArgP kap = (KArgP)__builtin_amdgcn_kernarg_segment_ptr(); asm volatile("" : "+s"(kap)); unsigned char* ws = kap->ws; float* out = kap->out; \
    float* ssq = (float*)(ws + WS_SSQ); bf16_t* xb = (bf16_t*)(ws + WS_XB); bf16_t* ab = (bf16_t*)(ws + WS_A); unsigned char* wl = ws + WS_W + (size_t)l * W_LAYER; (void)ssq; (void)xb; (void)ab; (void)wl; (void)out; \
    const int cx = __builtin_amdgcn_readfirstlane((int)((volatile LAS unsigned*)(lds + ATT_BW + 64))[2])
    if (IN_PH(0)) {
        KArgP kap = (KArgP)__builtin_amdgcn_kernarg_segment_ptr(); asm volatile("" : "+s"(kap));
        prologue(kap, lds, vcu * 8 + wave, G * 8, wave);
#ifdef PROBE_PRO2
        prologue(kap, lds, vcu * 8 + wave, G * 8, wave);
#endif
        { FRESH_KAP(ks_); if (ks_->coop && 1 < ks_->ph_hi) { cg::this_grid().sync();
            if (tid == 0) { unsigned* bar_ = (unsigned*)(ks_->ws + WS_BAR); const unsigned x_ = xb_xcc_id(); const unsigned r_ = xb_add(&bar_[XB_XCNT(x_)], 1u);
                if (G == 256 && r_ < 32u && x_ < 8u) ((volatile LAS unsigned*)(lds + ATT_BW + 64))[2] = r_ * 8u + x_; }
            __syncthreads(); } }
    }
#pragma unroll 1
    for (int l = 0; l < 2; ++l) {
        const int p0 = 1 + 7 * l;
        if (IN_PH(p0 + 0)) {
            KARGS();
            pg8::Gemm g{xb, (const bf16_t*)(wl + W_GU1), MT, 2 * DFF, DM, DM, 0};
            pg8::StaticOrder S; S.init(MT, 2 * DFF, G, cx);
            EpiSwiGLU E{ab, ssq + (size_t)(3 * l) * MT};
            pg8::gemm_phase<EpiSwiGLU, pg8::StaticOrder, true, true>(lds, g, S, E, wave);
#ifdef PROBE_UP2
            pg8::gemm_phase<EpiSwiGLU, pg8::StaticOrder, true, true>(lds, g, S, E, wave);
#endif
            SEAM(p0 + 0);
        }
        if (IN_PH(p0 + 1)) {
            KARGS();
            pg8::Gemm g{ab, (const bf16_t*)(wl + W_D1), MT, DM, DFF, LDP, 2};
            pg8::TailSplitOrder S; S.init(MT, DM, G, cx, 0, DOWN_WGM);
            EpiResid E{l == 0 ? kap->in[0] : out, l == 0 ? kap->in[1] : out + (size_t)MP * DM, out, xb, ssq + (size_t)(3 * l + 1) * MT, 0.5f};
            pg8::gemm_phase<EpiResid, pg8::TailSplitOrder, true, true>(lds, g, S, E, wave);
            SEAM(p0 + 1);
        }
        if (IN_PH(p0 + 2)) {
            {
                KARGS();
                pg8::Gemm g{xb, (const bf16_t*)(wl + W_IN), MT, 2048, DM, DM, 0};
                pg8::TailSplitOrder S; S.init(MT, 2048, G, cx);
                EpiQK E{ssq + (size_t)(3 * l + 1) * MT, ws, out, kap, l};
                pg8::gemm_phase<EpiQK, pg8::TailSplitOrder, true, true>(lds, g, S, E, wave);
#ifdef PROBE_QK2
                pg8::gemm_phase<EpiQK, pg8::TailSplitOrder, true, true>(lds, g, S, E, wave);
#endif
            }
            {
                KARGS();
                pg8::Gemm g{(const bf16_t*)(wl + W_IN) + (size_t)2048 * DM, xb, 1024, MT, DM, DM, 0};
                pg8::TailSplitOrder S; S.init(1024, MT, G, cx);
                EpiVt E{ssq + (size_t)(3 * l + 1) * MT, ws, out, l};
                pg8::gemm_phase<EpiVt, pg8::TailSplitOrder, true, true>(lds, g, S, E, wave);
#ifdef PROBE_VT2
                pg8::gemm_phase<EpiVt, pg8::TailSplitOrder, true, true>(lds, g, S, E, wave);
#endif
            }
            SEAM(p0 + 2);
        }
        if (IN_PH(p0 + 3)) {
            KArgP kap = (KArgP)__builtin_amdgcn_kernarg_segment_ptr(); asm volatile("" : "+s"(kap));
            attn_phase(kap, l, lds, wave, l);
#ifdef PROBE_ATTN2
            attn_phase(kap, l, lds, wave, 2 + l);
#endif
            SEAM(p0 + 3);
        }
        if (IN_PH(p0 + 4)) {
            KARGS();
            pg8::Gemm g{(const bf16_t*)(ws + WS_O), (const bf16_t*)(wl + W_OUT), MT, DM, DM, DM, 0};
            pg8::TailSplitOrder S; S.init(MT, DM, G, cx);
            EpiResid E{out, out + (size_t)MP * DM, out, xb, ssq + (size_t)(3 * l + 2) * MT, 1.0f};
            pg8::gemm_phase<EpiResid, pg8::TailSplitOrder, true, true>(lds, g, S, E, wave);
            SEAM(p0 + 4);
        }
        if (IN_PH(p0 + 5)) {
            KARGS();
            pg8::Gemm g{xb, (const bf16_t*)(wl + W_GU2), MT, 2 * DFF, DM, DM, 0};
            pg8::StaticOrder S; S.init(MT, 2 * DFF, G, cx);
            EpiSwiGLU E{ab, ssq + (size_t)(3 * l + 2) * MT};
            pg8::gemm_phase<EpiSwiGLU, pg8::StaticOrder, true, true>(lds, g, S, E, wave);
            SEAM(p0 + 5);
        }
        if (IN_PH(p0 + 6)) {
            KARGS();
            pg8::Gemm g{ab, (const bf16_t*)(wl + W_D2), MT, DM, DFF, LDP, 2};
            pg8::TailSplitOrder S; S.init(MT, DM, G, cx, 0, DOWN_WGM);
            EpiResid E{out, out + (size_t)MP * DM, out, xb, ssq + (size_t)(3 * l + 3) * MT, 0.5f};
            pg8::gemm_phase<EpiResid, pg8::TailSplitOrder, true, true>(lds, g, S, E, wave);
            SEAM(p0 + 6);
        }
    }
}

#ifndef N_LAUNCH_MODE_GUARD_
#define N_LAUNCH_MODE_GUARD_
#endif
#ifndef N_LAUNCH_MODE
#define N_LAUNCH_MODE 0
#endif
extern "C" void kernel_launch(void* const* d_in, const int* in_sizes, int n_in, void* d_out, int out_size, void* d_ws, size_t ws_size, hipStream_t stream) {
    static int grid = 0;
    if (grid == 0) {
        if (n_in != 27 || ws_size < WS_END) { fprintf(stderr, "kernel_launch: unexpected inputs (n_in %d, ws %zu)\n", n_in, ws_size); grid = -1; return; }
        int dev = 0, cus = 0, per_cu = 0;
        hipGetDevice(&dev);
        hipDeviceGetAttribute(&cus, hipDeviceAttributeMultiprocessorCount, dev);
        hipFuncSetAttribute((const void*)mega_fwd, hipFuncAttributeMaxDynamicSharedMemorySize, LDS_BYTES);
        hipOccupancyMaxActiveBlocksPerMultiprocessor(&per_cu, (const void*)mega_fwd, 512, LDS_BYTES);
        (void)hipGetLastError();
        if (per_cu < 1) per_cu = 1;
        grid = cus;
        if (grid != 256) fprintf(stderr, "kernel_launch: note: %d CUs\n", grid);
    }
    if (grid < 0) return;
    Args a{};
    for (int i = 0; i < 27; ++i) a.in[i] = (const float*)d_in[i];
    a.out = (float*)d_out; a.ws = (unsigned char*)d_ws;
#if N_LAUNCH_MODE == 1
    for (int ph = 0; ph < NPHASE; ++ph) {
        a.ph_lo = ph; a.ph_hi = ph + 1; a.coop = 0;
        hipLaunchKernelGGL(mega_fwd, dim3(grid), dim3(512), LDS_BYTES, stream, a);
    }
#else
    a.ph_lo = 0; a.ph_hi = NPHASE; a.coop = 1;
    void* args[] = {&a};
    hipError_t e = hipLaunchCooperativeKernel((const void*)mega_fwd, dim3(grid), dim3(512), args, LDS_BYTES, stream);
    if (e != hipSuccess) fprintf(stderr, "cooperative launch failed: %s (grid %d)\n", hipGetErrorString(e), grid);
#endif
}
```

```cpp
#include <hip/hip_runtime.h>
#include <hip/hip_cooperative_groups.h>
#include <cstdio>
#include <cstdint>
#include <cstddef>
namespace cg = cooperative_groups;
__device__ __forceinline__ int lane_id_fresh() { int l; asm volatile("v_mbcnt_lo_u32_b32 %0, -1, 0\n\tv_mbcnt_hi_u32_b32 %0, -1, %0" : "=v"(l)); return l; }
#ifndef PG8_PFD
#define PG8_PFD 4
#endif
namespace pg8 {
#define PG8_LAS __attribute__((address_space(3)))
typedef unsigned short bf16_t;
typedef short bf16x8 __attribute__((ext_vector_type(8)));
typedef float f32x4 __attribute__((ext_vector_type(4)));
typedef unsigned u32x4 __attribute__((ext_vector_type(4)));
constexpr int BM = 256, BK = 64, HALF = 128, HTB = HALF * BK * 2  , STAGE_BYTES = 8 * HTB, NXCD = 8, WGM = 8;

__host__ __device__ __forceinline__ int lds_byte(int r, int c) { const int st = (r >> 4) * 2 + (c >> 5), rr = r & 15, cc = c & 31, ob = rr * 64 + cc * 2; return st * 1024 + (ob ^ (((ob >> 9) & 1) << 5)); }
__host__ __device__ __forceinline__ void stage_rc(int b, int& R, int& C) { const int st = b / 1024, sb = b % 1024, swz = sb ^ (((sb >> 9) & 1) << 5); R = (st >> 1) * 16 + swz / 64; C = (st & 1) * 32 + (swz % 64) / 2; }
__host__ __device__ __forceinline__ int perm32(int rho) { const int n = rho >> 4, i = rho & 15; return 8 * (i >> 2) + 4 * n + (i & 3); }

struct Unit { int pm, pn, hm; };
struct Gemm { const bf16_t* A; const bf16_t* Bt; int M, N, K, ld; int blocked; };

struct StaticOrder {
    int nM, nN, nwg, G, c, rev, wgm;
    __host__ __device__ void init(int M, int N, int G_, int c_, int rev_ = 0, int wgm_ = WGM) { nM = M / BM; nN = N / BM; nwg = nM * nN; G = G_; c = c_; rev = rev_; wgm = wgm_; }
    __host__ __device__ __forceinline__ void tile(int wgid, Unit& u) const {
        { const int q = nwg / NXCD, r = nwg % NXCD, xcd = wgid % NXCD, off = wgid / NXCD; wgid = (xcd < r ? xcd * (q + 1) : r * (q + 1) + (xcd - r) * q) + off; }
        const int nig = wgm * nN, gid = wgid / nig, fm = gid * wgm, gsz = (nM - fm) < wgm ? (nM - fm) : wgm;
        u.pm = fm + ((wgid % nig) % gsz); u.pn = (wgid % nig) / gsz; u.hm = 3;
        if (rev) u.pm = nM - 1 - u.pm;
    }
    __host__ __device__ bool next(int i, Unit& u) const {
        const long L = (long)i * G + c; if (L >= nwg) return false;
        tile((int)L, u); return true;
    }
    __device__ __forceinline__ void a_ready(const Unit&) const {}
    __device__ __forceinline__ void done(const Unit&) const {}
};
struct TailSplitOrder : StaticOrder {
    __host__ __device__ bool next(int i, Unit& u) const {
        const int nfull = (nwg / G) * G, L = i * G + c;
        if (L < nfull) { tile(L, u); return true; }
        const int idx = L - nfull;
        if (idx >= 2 * (nwg - nfull)) return false;
        tile(nfull + (idx >> 1), u); u.hm = 1 << (idx & 1); return true;
    }
};

__device__ __forceinline__ unsigned cvt_pk_bf16(float lo, float hi) { unsigned r; asm volatile("v_cvt_pk_bf16_f32 %0, %1, %2" : "=v"(r) : "v"(lo), "v"(hi)); return r; }
typedef float f32x2 __attribute__((ext_vector_type(2)));
template <class Epi, class Sched, bool ALIGN_EPI = false, bool SP2 = false>
__device__ __forceinline__ void gemm_phase(PG8_LAS unsigned char* lds, const Gemm g, const Sched& S, const Epi& E, int wave_in) {
    int tid_l = wave_in * 64 + lane_id_fresh(); asm volatile("" : "+v"(tid_l));
    const int tid = tid_l, wid = __builtin_amdgcn_readfirstlane(tid >> 6), lane = tid & 63, wr = wid >> 2, wc = wid & 3, fr = lane & 15, fq = lane >> 4;
    const int nt = g.K / BK, K = g.blocked ? BK : g.ld;
    unsigned voffA[2], voffB[2];
#pragma unroll
    for (int i = 0; i < 2; ++i) { int R, C; stage_rc(tid * 16 + i * 8192, R, C); const int Rb = Epi::PERM ? ((R & ~31) + perm32(R & 31)) : R;
        voffA[i] = (unsigned)(R * K + C) * 2u; voffB[i] = (unsigned)(Rb * K + C) * 2u;
        if (g.blocked == 2) { voffA[i] = (unsigned)(tid * 16 + i * 8192); voffB[i] = voffA[i]; } }
    const size_t kstep = g.blocked ? (size_t)(BM * BK * 2) : (size_t)(BK * 2);
    const size_t hstep = (size_t)HALF * K * 2;
    const size_t tstep = g.blocked ? (size_t)nt * (BM * BK * 2) : 2 * hstep;
    const unsigned ldsw = (unsigned)wid * 1024u;
    const int aoff = lds_byte(wr * 64 + fr, fq * 8), boff = lds_byte(wc * 32 + fr, fq * 8);
#define PG8_SA(b, h) (((b) * 2 + (h)) * HTB)
#define PG8_SB(b, h) ((4 + (b) * 2 + (h)) * HTB)
#define PG8_STAGE(bufoff, gbase, voff) do { _Pragma("unroll") for (int _i = 0; _i < 2; ++_i) \
        __builtin_amdgcn_global_load_lds((const unsigned*)((const char*)(gbase) + (voff)[_i]), (PG8_LAS unsigned*)(lds + (bufoff) + ldsw + _i * 8192), 16, 0, 0); } while (0)
#define PG8_LDA(dst, b, h) do { _Pragma("unroll") for (int m = 0; m < 4; ++m) _Pragma("unroll") for (int k = 0; k < 2; ++k) dst[m][k] = *(const PG8_LAS bf16x8*)(lds + PG8_SA(b, h) + aoff + m * 2048 + k * 1024); } while (0)
#define PG8_LDB(dst, b, h) do { _Pragma("unroll") for (int n = 0; n < 2; ++n) _Pragma("unroll") for (int k = 0; k < 2; ++k) dst[n][k] = *(const PG8_LAS bf16x8*)(lds + PG8_SB(b, h) + boff + n * 2048 + k * 1024); } while (0)
#define PG8_MMA(ai, bj, At, Bt) do { __builtin_amdgcn_s_setprio(1); _Pragma("unroll") for (int m = 0; m < 4; ++m) _Pragma("unroll") for (int n = 0; n < 2; ++n) _Pragma("unroll") for (int k = 0; k < 2; ++k) \
        acc[ai][bj][m][n] = __builtin_amdgcn_mfma_f32_16x16x32_bf16(Bt[n][k], At[m][k], acc[ai][bj][m][n], 0, 0, 0); __builtin_amdgcn_s_setprio(0); } while (0)
#define PG8_WAIT_V(n) asm volatile("s_waitcnt vmcnt(" #n ")" ::: "memory")
#define PG8_WAIT_L(n) asm volatile("s_waitcnt lgkmcnt(" #n ")" ::: "memory")
#define PG8_BAR __builtin_amdgcn_s_barrier()
#define PG8_SCHED __builtin_amdgcn_sched_barrier(0)
    Unit cur, nxt; int ui = 0;
    if (!S.next(0, cur)) return;
    f32x4 acc[2][2][4][2];
#pragma unroll
    for (int a = 0; a < 2; ++a)
#pragma unroll
        for (int b = 0; b < 2; ++b)
#pragma unroll
            for (int m = 0; m < 4; ++m)
#pragma unroll
                for (int n = 0; n < 2; ++n) acc[a][b][m][n] = (f32x4){0.f, 0.f, 0.f, 0.f};
    bf16x8 At[4][2], B0[2][2], B1[2][2];
    const char* cA = (const char*)g.A + (size_t)cur.pm * tstep; const char* cB = (const char*)g.Bt + (size_t)cur.pn * tstep;
    S.a_ready(cur);
    if constexpr (SP2) {
        PG8_STAGE(PG8_SB(0, 0), cB, voffB); PG8_STAGE(PG8_SB(0, 1), cB + hstep, voffB); PG8_STAGE(PG8_SA(0, 0), cA, voffA); PG8_STAGE(PG8_SA(0, 1), cA + hstep, voffA);
        if (wr == 1) PG8_BAR;
        PG8_WAIT_V(2); PG8_BAR;
        PG8_STAGE(PG8_SB(1, 0), cB + kstep, voffB); PG8_STAGE(PG8_SA(1, 0), cA + kstep, voffA); PG8_STAGE(PG8_SB(1, 1), cB + hstep + kstep, voffB);
        PG8_WAIT_V(6); PG8_BAR;
    } else {
        PG8_STAGE(PG8_SB(0, 0), cB, voffB); PG8_STAGE(PG8_SA(0, 0), cA, voffA); PG8_STAGE(PG8_SB(0, 1), cB + hstep, voffB); PG8_STAGE(PG8_SA(0, 1), cA + hstep, voffA);
        if (wr == 1) PG8_BAR;
        PG8_WAIT_V(4); PG8_BAR;
        PG8_STAGE(PG8_SB(1, 0), cB + kstep, voffB); PG8_STAGE(PG8_SA(1, 0), cA + kstep, voffA); PG8_STAGE(PG8_SB(1, 1), cB + hstep + kstep, voffB);
        PG8_WAIT_V(6); PG8_BAR;
    }
    for (;;) {
        const bool has_next = S.next(ui + 1, nxt);
        const char* nA = has_next ? (const char*)g.A + (size_t)nxt.pm * tstep : cA; const char* nB = has_next ? (const char*)g.Bt + (size_t)nxt.pn * tstep : cB;
        for (int t = 0; t < nt; t += 2) {
            const bool last = (t == nt - 2);
            const char* a1 = cA + (size_t)(t + 1) * kstep;
            const char* a2 = last ? nA : cA + (size_t)(t + 2) * kstep; const char* b2 = last ? nB : cB + (size_t)(t + 2) * kstep;
            const char* a3 = a2 + kstep; const char* b3 = b2 + kstep;
            if (last && has_next) S.a_ready(nxt);
            if constexpr (SP2) {
            PG8_LDB(B0, 0, 0); PG8_LDB(B1, 0, 1); PG8_SCHED; PG8_LDA(At, 0, 0); PG8_STAGE(PG8_SA(1, 1), a1 + hstep, voffA);
            PG8_WAIT_V(8); PG8_WAIT_L(0); PG8_BAR; if (cur.hm & 1) { PG8_MMA(0, 0, At, B0); PG8_MMA(0, 1, At, B1); } PG8_BAR; PG8_SCHED;
            PG8_LDA(At, 0, 1); PG8_STAGE(PG8_SB(0, 0), b2, voffB); PG8_STAGE(PG8_SB(0, 1), b2 + hstep, voffB); PG8_STAGE(PG8_SA(0, 0), a2, voffA);
            PG8_WAIT_V(8); PG8_WAIT_L(0); PG8_BAR; if (cur.hm & 2) { PG8_MMA(1, 0, At, B0); PG8_MMA(1, 1, At, B1); } PG8_BAR; PG8_SCHED;
            PG8_LDB(B0, 1, 0); PG8_LDB(B1, 1, 1); PG8_SCHED; PG8_LDA(At, 1, 0); PG8_STAGE(PG8_SA(0, 1), a2 + hstep, voffA);
            PG8_WAIT_V(8); PG8_WAIT_L(0); PG8_BAR; if (cur.hm & 1) { PG8_MMA(0, 0, At, B0); PG8_MMA(0, 1, At, B1); } PG8_BAR; PG8_SCHED;
            PG8_LDA(At, 1, 1); PG8_STAGE(PG8_SB(1, 0), b3, voffB); PG8_STAGE(PG8_SB(1, 1), b3 + hstep, voffB); PG8_STAGE(PG8_SA(1, 0), a3, voffA);
            PG8_WAIT_V(8); PG8_WAIT_L(0); PG8_BAR; if (cur.hm & 2) { PG8_MMA(1, 0, At, B0); PG8_MMA(1, 1, At, B1); } PG8_BAR; PG8_SCHED;
            } else {
            PG8_LDB(B0, 0, 0); PG8_SCHED; PG8_LDA(At, 0, 0); PG8_STAGE(PG8_SA(1, 1), a1 + hstep, voffA);
            PG8_WAIT_L(8); PG8_BAR; PG8_WAIT_L(0); PG8_MMA(0, 0, At, B0); PG8_BAR; PG8_SCHED;
            PG8_LDB(B1, 0, 1); PG8_STAGE(PG8_SB(0, 0), b2, voffB);
            PG8_BAR; PG8_WAIT_L(0); PG8_MMA(0, 1, At, B1); PG8_BAR;
            PG8_LDA(At, 0, 1); PG8_STAGE(PG8_SA(0, 0), a2, voffA);
            PG8_BAR; PG8_WAIT_L(0); PG8_MMA(1, 0, At, B0); PG8_BAR; PG8_SCHED;
            PG8_STAGE(PG8_SB(0, 1), b2 + hstep, voffB);
            PG8_WAIT_V(6); PG8_BAR; PG8_MMA(1, 1, At, B1); PG8_BAR;
            PG8_LDB(B0, 1, 0); PG8_SCHED; PG8_LDA(At, 1, 0); PG8_STAGE(PG8_SA(0, 1), a2 + hstep, voffA);
            PG8_WAIT_L(8); PG8_BAR; PG8_WAIT_L(0); PG8_MMA(0, 0, At, B0); PG8_BAR; PG8_SCHED;
            PG8_LDB(B1, 1, 1); PG8_STAGE(PG8_SB(1, 0), b3, voffB);
            PG8_BAR; PG8_WAIT_L(0); PG8_MMA(0, 1, At, B1); PG8_BAR;
            PG8_LDA(At, 1, 1); PG8_STAGE(PG8_SA(1, 0), a3, voffA);
            PG8_BAR; PG8_WAIT_L(0); PG8_MMA(1, 0, At, B0); PG8_BAR; PG8_SCHED;
            PG8_STAGE(PG8_SB(1, 1), b3 + hstep, voffB);
            PG8_WAIT_V(6); PG8_BAR; PG8_MMA(1, 1, At, B1); PG8_BAR;
            }
        }
        if constexpr (ALIGN_EPI) { if (wr == 0) PG8_BAR; }
        if constexpr (!Epi::AFTER_DRAIN) { E(acc, cur, wr, wc, fr, fq); S.done(cur); }
        if (!has_next) break;
#pragma unroll
        for (int a = 0; a < 2; ++a)
#pragma unroll
            for (int b = 0; b < 2; ++b)
#pragma unroll
                for (int m = 0; m < 4; ++m)
#pragma unroll
                    for (int n = 0; n < 2; ++n) acc[a][b][m][n] = (f32x4){0.f, 0.f, 0.f, 0.f};
        cur = nxt; cA = nA; cB = nB; ++ui;
        if constexpr (ALIGN_EPI) { if (wr == 1) PG8_BAR; }
    }
    PG8_WAIT_V(0);
    if constexpr (!ALIGN_EPI) { if (wr == 0) PG8_BAR; }
    PG8_BAR;
    if constexpr (Epi::AFTER_DRAIN) { E.fused(acc, cur, wr, wc, fr, fq, lds, wid, lane); S.done(cur); }
#undef PG8_SA
#undef PG8_SB
#undef PG8_STAGE
#undef PG8_LDA
#undef PG8_LDB
#undef PG8_MMA
#undef PG8_WAIT_V
#undef PG8_WAIT_L
#undef PG8_BAR
#undef PG8_SCHED
}
}
using pg8::bf16_t; using pg8::bf16x8; using pg8::f32x4; using pg8::u32x4; using pg8::Unit; using pg8::cvt_pk_bf16;
typedef float f32x16 __attribute__((ext_vector_type(16)));
typedef unsigned u32x2 __attribute__((ext_vector_type(2)));
#define LAS __attribute__((address_space(3)))

constexpr int DM = 1024, SEQ = 2048, DSEQ = 64;
constexpr int MP = 16 * 2048, MS = 32 * 64, MT = MP + MS;
constexpr int DFF = 2816, LDP = 2880;
constexpr int KSA_ROWS = 576, KSB_ROWS = 2112;
constexpr float EPS = 1e-6f, LOG2E = 1.4426950408889634f, QSCALE = 0.125f * 1.4426950408889634f;
constexpr int NPHASE = 15;
#ifndef DOWN_WGM
#define DOWN_WGM 8
#endif
constexpr size_t MiB = 1u << 20;
constexpr size_t WS_CTL = 0, WS_BAR = 65536, WS_SSQ = 1 * MiB, WS_ROPE = 2 * MiB, WS_W = 4 * MiB;
constexpr size_t W_GU1 = 0, W_D1 = 11 * MiB, W_IN = 17 * MiB, W_OUT = 23 * MiB, W_GU2 = 25 * MiB, W_D2 = 36 * MiB, W_LAYER = 42 * MiB;
constexpr size_t WS_XB = 88 * MiB, WS_A = 156 * MiB, WS_QA = WS_A, WS_QB = WS_A + 34 * MiB, WS_O = WS_A + 68 * MiB;
constexpr size_t WS_KAP = 352 * MiB, WS_KBP = 384 * MiB, WS_VAP = 416 * MiB, WS_VBP = 448 * MiB;
constexpr size_t WS_KSA = 480 * MiB, WS_VSA = 516 * MiB, WS_KSB = 552 * MiB, WS_VSB = 684 * MiB, WS_END = 816 * MiB;
static_assert(W_D2 + (size_t)1024 * LDP * 2 <= W_LAYER && WS_W + 2 * W_LAYER <= WS_XB && WS_A + (size_t)MT * LDP * 2 <= WS_KAP, "d_ws map");
constexpr size_t OUT_YP = 0, OUT_YS = 33554432, OUT_PAK = 35651584, OUT_PAV = 44040192, OUT_PBK = 52428800, OUT_PBV = 85983232,
                 OUT_SAK = 119537664, OUT_SAV = 121634816, OUT_SBK = 123731968, OUT_SBV = 125829120;
constexpr int LDS_BYTES = 147456;

struct Args { const float* in[27]; float* out; unsigned char* ws; int ph_lo, ph_hi, coop, pad; };
typedef const __attribute__((address_space(4))) Args* KArgP;

__device__ const double ROPE_INV[32] = {1.0, 0.7498942093324559, 0.5623413251903491, 0.4216965034285822, 0.31622776601683794, 0.23713737056616552, 0.1778279410038923, 0.1333521432163324, 0.1, 0.07498942093324558, 0.05623413251903491, 0.042169650342858224, 0.03162277660168379, 0.023713737056616554, 0.01778279410038923, 0.01333521432163324, 0.01, 0.007498942093324558, 0.005623413251903491, 0.004216965034285823, 0.0031622776601683794, 0.0023713737056616554, 0.0017782794100389228, 0.001333521432163324, 0.001, 0.0007498942093324559, 0.0005623413251903491, 0.00042169650342858224, 0.00031622776601683794, 0.00023713737056616554, 0.00017782794100389227, 0.0001333521432163324};

__device__ __forceinline__ float shx(float v, int lane, int m) { return __builtin_bit_cast(float, __builtin_amdgcn_ds_bpermute((lane ^ m) << 2, __builtin_bit_cast(int, v))); }
__device__ __forceinline__ float wave_sum(float v, int lane) {
#pragma unroll
    for (int o = 1; o < 64; o <<= 1) v += shx(v, lane, o);
    return v;
}
__device__ __forceinline__ float wave_max(float v, int lane) {
#pragma unroll
    for (int o = 1; o < 64; o <<= 1) v = fmaxf(v, shx(v, lane, o));
    return v;
}
__device__ __forceinline__ float fast_rcp(float x) { return __builtin_amdgcn_rcpf(x); }
__device__ __forceinline__ float fast_exp2(float x) { return __builtin_amdgcn_exp2f(x); }

struct EpiSwiGLU {
    static constexpr bool PERM = true, AFTER_DRAIN = false;
    bf16_t* O; const float* ssq;
    __device__ __forceinline__ void operator()(const f32x4 (&acc)[2][2][4][2], const Unit& u, int wr, int wc, int fr, int fq) const {
        const int row0 = u.pm * 256 + wr * 64 + fr, col0 = u.pn * 128 + wc * 32 + 8 * fq;
        float sq[2][4];
#pragma unroll
        for (int ai = 0; ai < 2; ++ai)
#pragma unroll
            for (int m = 0; m < 4; ++m) sq[ai][m] = ssq[row0 + ai * 128 + m * 16];
#pragma unroll
        for (int ai = 0; ai < 2; ++ai)
#pragma unroll
            for (int m = 0; m < 4; ++m) {
                if (!((u.hm >> ai) & 1)) continue;
                const int row = row0 + ai * 128 + m * 16;
                const float rstd = rsqrtf(sq[ai][m] * (1.0f / DM) + EPS);
                float o[8];
#pragma unroll
                for (int n = 0; n < 2; ++n)
#pragma unroll
                    for (int i = 0; i < 4; ++i) {
                        const float g = acc[ai][0][m][n][i] * rstd, up = acc[ai][1][m][n][i] * rstd;
                        const float sg = g * fast_rcp(1.0f + fast_exp2(-g * LOG2E));
                        o[n * 4 + i] = sg * up;
                    }
                u32x4 w; w.x = cvt_pk_bf16(o[0], o[1]); w.y = cvt_pk_bf16(o[2], o[3]); w.z = cvt_pk_bf16(o[4], o[5]); w.w = cvt_pk_bf16(o[6], o[7]);
                *(u32x4*)((char*)O + (((size_t)(row >> 8) * (DFF / 64) + (col0 >> 6)) * 2 + ((row >> 7) & 1)) * 16384 + pg8::lds_byte(row & 127, col0 & 63)) = w;
            }
    }
};
struct EpiResid {
    static constexpr bool PERM = false, AFTER_DRAIN = false;
    const float* xin_p; const float* xin_s; float* xout; bf16_t* xb; float* ssq; float scale;
    __device__ __forceinline__ void operator()(const f32x4 (&acc)[2][2][4][2], const Unit& u, int wr, int wc, int fr, int fq) const {
        const int col0 = u.pn * 256 + wc * 32 + 4 * fq;
#pragma unroll
        for (int ai = 0; ai < 2; ++ai) {
            if (!((u.hm >> ai) & 1)) continue;
            const int rowb = u.pm * 256 + ai * 128 + wr * 64 + fr;
            const float* xi = (rowb < MP) ? xin_p + (size_t)rowb * DM : xin_s + (size_t)(rowb - MP) * DM;
            f32x4 pre[4][2][2];
#pragma unroll
            for (int m = 0; m < 4; ++m)
#pragma unroll
                for (int bj = 0; bj < 2; ++bj)
#pragma unroll
                    for (int n = 0; n < 2; ++n) pre[m][bj][n] = *(const f32x4*)(xi + (size_t)m * 16 * DM + col0 + bj * 128 + n * 16);
#pragma unroll
            for (int m = 0; m < 4; ++m) {
                const int row = rowb + m * 16;
                float sq = 0.f;
#pragma unroll
                for (int bj = 0; bj < 2; ++bj)
#pragma unroll
                    for (int n = 0; n < 2; ++n) {
                        const int c = col0 + bj * 128 + n * 16;
                        const f32x4 v = pre[m][bj][n] + acc[ai][bj][m][n] * scale;
                        *(f32x4*)(xout + (size_t)row * DM + c) = v;
                        u32x2 w; w.x = cvt_pk_bf16(v[0], v[1]); w.y = cvt_pk_bf16(v[2], v[3]);
                        *(u32x2*)(xb + (size_t)row * DM + c) = w;
                        sq += (v[0] * v[0] + v[1] * v[1]) + (v[2] * v[2] + v[3] * v[3]);
                    }
                sq += shx(sq, fr + 16 * fq, 16); sq += shx(sq, fr + 16 * fq, 32);
                if (fq == 0) atomicAdd(ssq + row, sq);
            }
        }
    }
};
struct EpiQK {
    static constexpr bool PERM = true, AFTER_DRAIN = false;
    const float* ssq; unsigned char* ws; float* out; KArgP kap; int l;
    __device__ __forceinline__ void operator()(const f32x4 (&acc)[2][2][4][2], const Unit& u, int wr, int wc, int fr, int fq) const {
        const int sec = u.pn >> 1, hd = 4 * (u.pn & 1) + wc;
        const float* gp = kap->in[12 + sec] + l * 64;
        const float* rope = (const float*)(ws + WS_ROPE);
        bf16_t* QA = (bf16_t*)(ws + WS_QA); bf16_t* QB = (bf16_t*)(ws + WS_QB); bf16_t* KAP = (bf16_t*)(ws + WS_KAP); bf16_t* KBP = (bf16_t*)(ws + WS_KBP);
        bf16_t* KSA = (bf16_t*)(ws + WS_KSA) + (size_t)l * 32 * KSA_ROWS * 512; bf16_t* KSB = (bf16_t*)(ws + WS_KSB) + (size_t)l * 32 * KSB_ROWS * 512;
        float* oPAK = out + OUT_PAK + (size_t)l * 16 * 512 * 512; float* oPBK = out + OUT_PBK + (size_t)l * MP * 512;
        float* oSAK = out + OUT_SAK + (size_t)l * MS * 512; float* oSBK = out + OUT_SBK + (size_t)l * MS * 512;
        f32x4 gl[2], gh[2];
#pragma unroll
        for (int n = 0; n < 2; ++n) { gl[n] = *(const f32x4*)(gp + 8 * fq + 4 * n); gh[n] = *(const f32x4*)(gp + 32 + 8 * fq + 4 * n); }
        const int cbase = hd * 64 + 8 * fq;
        float sqr[2][4];
#pragma unroll
        for (int ai = 0; ai < 2; ++ai)
#pragma unroll
            for (int m = 0; m < 4; ++m) sqr[ai][m] = ssq[u.pm * 256 + ai * 128 + wr * 64 + m * 16 + fr];
#pragma unroll
        for (int ai = 0; ai < 2; ++ai)
#pragma unroll
            for (int m = 0; m < 4; ++m) {
                if (!((u.hm >> ai) & 1)) continue;
                const int row = u.pm * 256 + ai * 128 + wr * 64 + m * 16 + fr;
                const float rstd = rsqrtf(sqr[ai][m] * (1.0f / DM) + EPS);
                f32x4 y[2][2]; float ss = 0.f;
#pragma unroll
                for (int bj = 0; bj < 2; ++bj)
#pragma unroll
                    for (int n = 0; n < 2; ++n) { const f32x4 v = acc[ai][bj][m][n] * rstd; y[bj][n] = v; ss += (v[0] * v[0] + v[1] * v[1]) + (v[2] * v[2] + v[3] * v[3]); }
                ss += shx(ss, fr + 16 * fq, 16); ss += shx(ss, fr + 16 * fq, 32);
                const float rr = rsqrtf(ss * (1.0f / 64.0f) + EPS);
#pragma unroll
                for (int n = 0; n < 2; ++n) { y[0][n] = y[0][n] * rr * gl[n]; y[1][n] = y[1][n] * rr * gh[n]; }
                const bool prompt = row < MP;
                const int sp = row & 2047, bp = row >> 11, ts = (row - MP) & 63, bs = (row - MP) >> 6;
                if (sec >= 2) {
                    const int pos = prompt ? sp : 2048 + ts;
                    const float* cs = rope + (size_t)pos * 64 + 8 * fq;
#pragma unroll
                    for (int n = 0; n < 2; ++n) {
                        const f32x4 c = *(const f32x4*)(cs + 4 * n), s = *(const f32x4*)(cs + 32 + 4 * n);
                        const f32x4 x1 = y[0][n], x2 = y[1][n];
                        y[0][n] = x1 * c - x2 * s; y[1][n] = x2 * c + x1 * s;
                    }
                }
                if (sec == 0 || sec == 2) {
                    bf16_t* dst = (sec == 0 ? QA : QB) + (size_t)row * 512 + cbase;
#pragma unroll
                    for (int bj = 0; bj < 2; ++bj) {
                        const f32x4 a = y[bj][0] * QSCALE, b = y[bj][1] * QSCALE;
                        u32x4 w; w.x = cvt_pk_bf16(a[0], a[1]); w.y = cvt_pk_bf16(a[2], a[3]); w.z = cvt_pk_bf16(b[0], b[1]); w.w = cvt_pk_bf16(b[2], b[3]);
                        *(u32x4*)(dst + 32 * bj) = w;
                    }
                } else {
                    bf16_t* dst; float* fo = nullptr;
                    if (sec == 1) {
                        if (prompt) { dst = KAP + (size_t)row * 512; if (sp >= 1536) fo = oPAK + (size_t)(bp * 512 + sp - 1536) * 512; }
                        else { dst = KSA + (size_t)(bs * KSA_ROWS + 512 + ts) * 512; fo = oSAK + (size_t)(row - MP) * 512; }
                    } else {
                        if (prompt) { dst = KBP + (size_t)row * 512; fo = oPBK + (size_t)row * 512; }
                        else { dst = KSB + (size_t)(bs * KSB_ROWS + 2048 + ts) * 512; fo = oSBK + (size_t)(row - MP) * 512; }
                    }
#pragma unroll
                    for (int bj = 0; bj < 2; ++bj) {
                        const f32x4 a = y[bj][0], b = y[bj][1];
                        u32x4 w; w.x = cvt_pk_bf16(a[0], a[1]); w.y = cvt_pk_bf16(a[2], a[3]); w.z = cvt_pk_bf16(b[0], b[1]); w.w = cvt_pk_bf16(b[2], b[3]);
                        *(u32x4*)(dst + cbase + 32 * bj) = w;
                        if (fo) { *(f32x4*)(fo + cbase + 32 * bj) = a; *(f32x4*)(fo + cbase + 32 * bj + 4) = b; }
                    }
                }
            }
    }
};
struct EpiVt {
    static constexpr bool PERM = true, AFTER_DRAIN = false;
    const float* ssq; unsigned char* ws; float* out; int l;
    __device__ __forceinline__ void operator()(const f32x4 (&acc)[2][2][4][2], const Unit& u, int wr, int wc, int fr, int fq) const {
        bf16_t* VAP = (bf16_t*)(ws + WS_VAP); bf16_t* VBP = (bf16_t*)(ws + WS_VBP);
        bf16_t* VSA = (bf16_t*)(ws + WS_VSA) + (size_t)l * 32 * 512 * KSA_ROWS; bf16_t* VSB = (bf16_t*)(ws + WS_VSB) + (size_t)l * 32 * 512 * KSB_ROWS;
        float* oPAV = out + OUT_PAV + (size_t)l * 16 * 512 * 512; float* oPBV = out + OUT_PBV + (size_t)l * MP * 512;
        float* oSAV = out + OUT_SAV + (size_t)l * MS * 512; float* oSBV = out + OUT_SBV + (size_t)l * MS * 512;
        const int grp = u.pm >> 1;
        const bool prompt = u.pn < (MP / 256);
        f32x4 rs[2][2];
#pragma unroll
        for (int bj = 0; bj < 2; ++bj)
#pragma unroll
            for (int n = 0; n < 2; ++n) {
                const f32x4 q = *(const f32x4*)(ssq + u.pn * 256 + bj * 128 + wc * 32 + 8 * fq + 4 * n);
                f32x4 r; r[0] = rsqrtf(q[0] * (1.0f / DM) + EPS); r[1] = rsqrtf(q[1] * (1.0f / DM) + EPS); r[2] = rsqrtf(q[2] * (1.0f / DM) + EPS); r[3] = rsqrtf(q[3] * (1.0f / DM) + EPS);
                rs[bj][n] = r;
            }
#pragma unroll
        for (int bj = 0; bj < 2; ++bj) {
            const int tok = u.pn * 256 + bj * 128 + wc * 32 + 8 * fq;
            const int bp = tok >> 11, sp = tok & 2047, tt = tok - MP, bs = tt >> 6, ts = tt & 63;
            bf16_t* vdst; size_t vld; float* fo = nullptr;
            if (prompt) { vdst = (grp == 0 ? VAP : VBP) + (size_t)bp * 512 * 2048 + sp; vld = 2048;
                if (grp == 0) { if (sp >= 1536) fo = oPAV + (size_t)(bp * 512 + sp - 1536) * 512; } else fo = oPBV + (size_t)tok * 512; }
            else { if (grp == 0) { vdst = VSA + (size_t)bs * 512 * KSA_ROWS + 512 + ts; vld = KSA_ROWS; fo = oSAV + (size_t)tt * 512; }
                   else { vdst = VSB + (size_t)bs * 512 * KSB_ROWS + 2048 + ts; vld = KSB_ROWS; fo = oSBV + (size_t)tt * 512; } }
#pragma unroll
            for (int ai = 0; ai < 2; ++ai)
#pragma unroll
                for (int m = 0; m < 4; ++m) {
                    if (!((u.hm >> ai) & 1)) continue;
                    const int hrow = (ai * 128 + wr * 64 + m * 16 + fr) + (u.pm & 1) * 256;
                    const f32x4 a = acc[ai][bj][m][0] * rs[bj][0], b = acc[ai][bj][m][1] * rs[bj][1];
                    u32x4 w; w.x = cvt_pk_bf16(a[0], a[1]); w.y = cvt_pk_bf16(a[2], a[3]); w.z = cvt_pk_bf16(b[0], b[1]); w.w = cvt_pk_bf16(b[2], b[3]);
                    *(u32x4*)(vdst + (size_t)hrow * vld) = w;
                    if (fo) {
#pragma unroll
                        for (int i = 0; i < 4; ++i) { fo[(size_t)i * 512 + hrow] = a[i]; fo[(size_t)(4 + i) * 512 + hrow] = b[i]; }
                    }
                }
        }
    }
};
#define XB_TMO      128
#define XB_XCNT(j)  (256  + 64 * (j))
#define XB_XSUB(j)  (1280 + 64 * (j))
#define XB_XGEN(j)  (2304 + 64 * (j))
#define XB_TOP      3328
#define XB_TOPGEN   3392
#define XCD_BAR_WORDS 3456
#define XB_SPIN_CAP (1u << 18)

__device__ __forceinline__ unsigned xb_ld(unsigned* p)              { return __hip_atomic_load(p, __ATOMIC_RELAXED, __HIP_MEMORY_SCOPE_AGENT); }
__device__ __forceinline__ unsigned xb_add(unsigned* p, unsigned v) { return __hip_atomic_fetch_add(p, v, __ATOMIC_RELAXED, __HIP_MEMORY_SCOPE_AGENT); }
__device__ __forceinline__ unsigned xb_xcc_id() { return (unsigned)__builtin_amdgcn_s_getreg((3 << 11) | 20) & 0xFu; }
#define XB_SPIN(cond, bar) do { unsigned _sp = 0; while (cond) { __builtin_amdgcn_s_sleep(1); \
    if ((++_sp & 255u) == 0u) { if (xb_ld(&(bar)[XB_TMO])) break; if (_sp > XB_SPIN_CAP) { atomicAdd(&(bar)[XB_TMO], 1u); break; } } } } while (0)

struct XcdBarrier {
    unsigned* bar; unsigned x;
    volatile LAS unsigned* st;
};

__device__ __forceinline__ XcdBarrier xcd_barrier_post(unsigned* bar, volatile LAS unsigned* st) {
    XcdBarrier b; b.bar = bar; b.x = xb_xcc_id(); b.st = st;
    if (threadIdx.x == 0) (void)xb_add(&bar[XB_XCNT(b.x)], 1u);
    return b;
}
__device__ __forceinline__ void xcd_barrier_complete(unsigned* bar, unsigned x, unsigned& nloc, unsigned& nx) {
    const unsigned G = gridDim.x * gridDim.y * gridDim.z;
    unsigned sum, cnt, mine, sp = 0u;
    for (;;) {
        sum = 0u; cnt = 0u; mine = 0u;
#pragma unroll
        for (unsigned j = 0; j < 16; ++j) { const unsigned c = xb_ld(&bar[XB_XCNT(j)]); sum += c; cnt += (c > 0u) ? 1u : 0u; mine = (j == x) ? c : mine; }
        if (sum == G) break;
        __builtin_amdgcn_s_sleep(1);
        if ((++sp & 255u) == 0u) { if (xb_ld(&bar[XB_TMO])) break; if (sp > XB_SPIN_CAP) { atomicAdd(&bar[XB_TMO], 1u); break; } }
    }
    nloc = mine > 0u ? mine : 1u; nx = cnt > 0u ? cnt : 1u;
}

__device__ __forceinline__ void xcd_barrier(const XcdBarrier& b) {
    asm volatile("s_waitcnt vmcnt(0)" ::: "memory");
    __syncthreads();
    if (threadIdx.x == 0) {
        unsigned* bar = b.bar;
        __builtin_amdgcn_s_waitcnt(0);
        unsigned nloc = b.st[0], nx = b.st[1];
        if (nloc == 0u) { xcd_barrier_complete(bar, b.x, nloc, nx); b.st[0] = nloc; b.st[1] = nx; }
        const unsigned old = xb_add(&bar[XB_XSUB(b.x)], 1u);
        const unsigned gen = old / nloc;
        if (old + 1u == (gen + 1u) * nloc) {
            __builtin_amdgcn_fence(__ATOMIC_RELEASE, "agent");
            asm volatile("s_waitcnt vmcnt(0)" ::: "memory");
            const unsigned og = xb_add(&bar[XB_TOP], 1u);
            const unsigned tg = og / nx;
            if (og + 1u == (tg + 1u) * nx) xb_add(&bar[XB_TOPGEN], 1u);
            else XB_SPIN(xb_ld(&bar[XB_TOPGEN]) == tg, bar);
            __builtin_amdgcn_fence(__ATOMIC_ACQUIRE, "agent");
            xb_add(&bar[XB_XGEN(b.x)], 1u);
            asm volatile("s_waitcnt vmcnt(0)" ::: "memory");
        } else {
            XB_SPIN(xb_ld(&bar[XB_XGEN(b.x)]) == gen, bar);
            __builtin_amdgcn_fence(__ATOMIC_ACQUIRE, "agent");
            asm volatile("s_waitcnt vmcnt(0)" ::: "memory");
        }
    }
    __syncthreads();
}
__device__ __forceinline__ int map_row(int kind, int n) {
    if (kind == 0) return n;
    if (kind == 1) return 256 * (n >> 7) + (n & 127);
    if (kind == 2) return 256 * (n >> 7) + 128 + (n & 127);
    const int sec = n >> 9, w = n & 511;
    if (sec == 2) return 2048 + w;
    if (sec == 5) return 2560 + w;
    const int qsec = sec == 0 ? 0 : sec == 1 ? 1 : sec == 3 ? 2 : 3;
    const int c = qsec * 512 + w, pn = c >> 8, ww = c & 255, hw = ww >> 6, d = ww & 63;
    return 256 * pn + 128 * (d >> 5) + 32 * hw + (d & 31);
}
__device__ __forceinline__ void transpose_item(const float* src, int ld_src, int k0, int n0, const float* gain, bf16_t* dst, size_t ld_dst, int kind, LAS float* scr, int lane) {
    float tv[32];
#pragma unroll
    for (int i = 0; i < 32; ++i) tv[i] = src[(size_t)(k0 + 2 * i + (lane >> 5)) * ld_src + n0 + (lane & 31)];
    if (gain) {
#pragma unroll
        for (int i = 0; i < 32; ++i) tv[i] *= gain[k0 + 2 * i + (lane >> 5)];
    }
#pragma unroll
    for (int i = 0; i < 32; ++i) scr[(2 * i + (lane >> 5)) * 33 + (lane & 31)] = tv[i];
    asm volatile("s_waitcnt lgkmcnt(0)" ::: "memory");
    const int c = lane & 7;
#pragma unroll
    for (int j = 0; j < 4; ++j) {
        const int n = (lane >> 3) + 8 * j; const LAS float* s = scr + (8 * c) * 33 + n;
        u32x4 o; o.x = cvt_pk_bf16(s[0 * 33], s[1 * 33]); o.y = cvt_pk_bf16(s[2 * 33], s[3 * 33]); o.z = cvt_pk_bf16(s[4 * 33], s[5 * 33]); o.w = cvt_pk_bf16(s[6 * 33], s[7 * 33]);
        if (kind == 4) { const int row = n0 + n; *(u32x4*)((char*)dst + (((size_t)(row >> 8) * (DFF / 64) + (k0 >> 6)) * 2 + ((row >> 7) & 1)) * 16384 + pg8::lds_byte(row & 127, 8 * c)) = o; }
        else *(u32x4*)(dst + (size_t)map_row(kind, n0 + n) * ld_dst + k0 + 8 * c) = o;
    }
    asm volatile("s_waitcnt lgkmcnt(0)" ::: "memory");
}
__device__ __forceinline__ void do_job(const float* src, int R, int C, const float* gain, bf16_t* dst, size_t ld_dst, int kind, int item, LAS float* scr, int lane) {
    const int nblk = C >> 5, kb = item / nblk, nb = item - kb * nblk;
    (void)R;
    transpose_item(src, C, 64 * kb, 32 * nb, gain, dst, ld_dst, kind, scr, lane);
}

__device__ __forceinline__ void convert_caches(KArgP A, LAS unsigned char* lds, int l, int gw, int NGW, int wave) {
    int lane_l = lane_id_fresh(); asm volatile("" : "+v"(lane_l)); const int lane = lane_l;
    unsigned char* ws = A->ws;
    LAS float* scr = (LAS float*)(lds + wave * 16384);
    constexpr int I_CAV = 32 * 128;
    for (int it = gw; it < I_CAV; it += NGW) {
        {
            const int lb = l * 32 + (it >> 7), item = it & 127;
            do_job(A->in[3] + (size_t)lb * 512 * 512, 512, 512, nullptr, (bf16_t*)(ws + WS_VSA) + (size_t)lb * 512 * KSA_ROWS, KSA_ROWS, 0, item, scr, lane);
        }
    }
    for (int r = gw; r < 32 * 512; r += NGW) {
        const float* s; bf16_t* d;
        if (r < 32 * 512) { const int lb = l * 32 + (r >> 9), key = r & 511; s = A->in[2] + ((size_t)lb * 512 + key) * 512; d = (bf16_t*)(ws + WS_KSA) + (size_t)(lb * KSA_ROWS + key) * 512; }
        else { const int q = r - 32 * 512, lb = l * 32 + (q >> 11), key = q & 2047; s = A->in[4] + ((size_t)lb * 2048 + key) * 512; d = (bf16_t*)(ws + WS_KSB) + (size_t)(lb * KSB_ROWS + key) * 512; }
        const f32x4 a = *(const f32x4*)(s + 8 * lane), b = *(const f32x4*)(s + 8 * lane + 4);
        u32x4 w; w.x = cvt_pk_bf16(a[0], a[1]); w.y = cvt_pk_bf16(a[2], a[3]); w.z = cvt_pk_bf16(b[0], b[1]); w.w = cvt_pk_bf16(b[2], b[3]);
        *(u32x4*)(d + 8 * lane) = w;
    }
}

__device__ __forceinline__ void prologue(KArgP A, LAS unsigned char* lds, int gw, int NGW, int wave) {
    int lane_l = lane_id_fresh(); asm volatile("" : "+v"(lane_l)); const int lane = lane_l;
    unsigned char* ws = A->ws;
    LAS float* scr = (LAS float*)(lds + wave * 16384);
    constexpr int I_GU = 16 * 88, I_D = 44 * 32, I_IN = 16 * 96, I_O = 16 * 32;
    constexpr int I_LAYER = 4 * I_GU + 2 * I_D + I_IN + I_O;
    constexpr int I_W = 2 * I_LAYER;
    for (int it = gw; it < I_W; it += NGW) {
        {
            const int l = it / I_LAYER; int r = it - l * I_LAYER;
            unsigned char* wl = ws + WS_W + (size_t)l * W_LAYER;
            const float* gf1 = A->in[6] + l * DM; const float* gmx = A->in[10] + l * DM; const float* gf2 = A->in[23] + l * DM;
            if (r < I_GU) { do_job(A->in[7] + (size_t)l * DM * DFF, DM, DFF, gf1, (bf16_t*)(wl + W_GU1), DM, 1, r, scr, lane); continue; } r -= I_GU;
            if (r < I_GU) { do_job(A->in[8] + (size_t)l * DM * DFF, DM, DFF, gf1, (bf16_t*)(wl + W_GU1), DM, 2, r, scr, lane); continue; } r -= I_GU;
            if (r < I_D)  { do_job(A->in[9] + (size_t)l * DM * DFF, DFF, DM, nullptr, (bf16_t*)(wl + W_D1), LDP, 4, r, scr, lane); continue; } r -= I_D;
            if (r < I_IN) { do_job(A->in[11] + (size_t)l * DM * 3072, DM, 3072, gmx, (bf16_t*)(wl + W_IN), DM, 3, r, scr, lane); continue; } r -= I_IN;
            if (r < I_O)  { do_job(A->in[22] + (size_t)l * DM * DM, DM, DM, nullptr, (bf16_t*)(wl + W_OUT), DM, 0, r, scr, lane); continue; } r -= I_O;
            if (r < I_GU) { do_job(A->in[24] + (size_t)l * DM * DFF, DM, DFF, gf2, (bf16_t*)(wl + W_GU2), DM, 1, r, scr, lane); continue; } r -= I_GU;
            if (r < I_GU) { do_job(A->in[25] + (size_t)l * DM * DFF, DM, DFF, gf2, (bf16_t*)(wl + W_GU2), DM, 2, r, scr, lane); continue; } r -= I_GU;
            do_job(A->in[26] + (size_t)l * DM * DFF, DFF, DM, nullptr, (bf16_t*)(wl + W_D2), LDP, 4, r, scr, lane);
        }
    }
    convert_caches(A, lds, 0, gw, NGW, wave);
    convert_caches(A, lds, 1, gw, NGW, wave);
    float* ssq = (float*)(ws + WS_SSQ);
    bf16_t* xb = (bf16_t*)(ws + WS_XB);
    for (int r0 = gw; r0 < MT; r0 += 2 * NGW) {
        const int r1 = r0 + NGW; const bool has1 = r1 < MT;
        const float* xa = (r0 < MP) ? A->in[0] + (size_t)r0 * DM : A->in[1] + (size_t)(r0 - MP) * DM;
        const float* xc = !has1 ? xa : (r1 < MP) ? A->in[0] + (size_t)r1 * DM : A->in[1] + (size_t)(r1 - MP) * DM;
        f32x4 va[4], vc[4];
#pragma unroll
        for (int j = 0; j < 4; ++j) { va[j] = *(const f32x4*)(xa + 256 * j + 4 * lane); vc[j] = *(const f32x4*)(xc + 256 * j + 4 * lane); }
        float sa = 0.f, sc = 0.f;
#pragma unroll
        for (int j = 0; j < 4; ++j) {
            sa += (va[j][0] * va[j][0] + va[j][1] * va[j][1]) + (va[j][2] * va[j][2] + va[j][3] * va[j][3]);
            sc += (vc[j][0] * vc[j][0] + vc[j][1] * vc[j][1]) + (vc[j][2] * vc[j][2] + vc[j][3] * vc[j][3]);
            u32x2 w; w.x = cvt_pk_bf16(va[j][0], va[j][1]); w.y = cvt_pk_bf16(va[j][2], va[j][3]);
            *(u32x2*)(xb + (size_t)r0 * DM + 256 * j + 4 * lane) = w;
            if (has1) { u32x2 w2; w2.x = cvt_pk_bf16(vc[j][0], vc[j][1]); w2.y = cvt_pk_bf16(vc[j][2], vc[j][3]); *(u32x2*)(xb + (size_t)r1 * DM + 256 * j + 4 * lane) = w2; }
        }
        sa = wave_sum(sa, lane); sc = wave_sum(sc, lane);
        if (lane == 0) { ssq[r0] = sa; if (has1) ssq[r1] = sc; }
    }
    for (int i = gw * 64 + lane; i < 6 * MT; i += NGW * 64) ssq[MT + i] = 0.f;
    float* rope = (float*)(ws + WS_ROPE);
    for (int i = gw * 64 + lane; i < 2112 * 32; i += NGW * 64) {
        const int pos = i >> 5, j = i & 31;
        const double a = (double)((float)pos * (float)ROPE_INV[j]);
        const double kq = __builtin_rint(a * 0.63661977236758134308);
        const double rr = (a - kq * 1.5707963267948966192) - kq * 6.123233995736766e-17;
        const double r2 = rr * rr;
        const double sn = rr * (1.0 + r2 * (-1.0 / 6 + r2 * (1.0 / 120 + r2 * (-1.0 / 5040 + r2 * (1.0 / 362880 + r2 * (-1.0 / 39916800 + r2 * (1.0 / 6227020800.0)))))));
        const double cn = 1.0 + r2 * (-0.5 + r2 * (1.0 / 24 + r2 * (-1.0 / 720 + r2 * (1.0 / 40320 + r2 * (-1.0 / 3628800 + r2 * (1.0 / 479001600 + r2 * (-1.0 / 87178291200.0)))))));
        const int q = ((int)kq) & 3;
        const double c = q == 0 ? cn : q == 1 ? -sn : q == 2 ? -cn : sn;
        const double s = q == 0 ? sn : q == 1 ? cn : q == 2 ? -sn : -cn;
        rope[(size_t)pos * 64 + j] = (float)c; rope[(size_t)pos * 64 + 32 + j] = (float)s;
    }
    if (gw == 0) {
        unsigned* ctl = (unsigned*)(ws + WS_CTL);
        float* cst = (float*)(ws + WS_CTL + 4096);
        if (lane < 16) ctl[lane] = 0u;
        for (int i = lane; i < XCD_BAR_WORDS; i += 64) ((unsigned*)(ws + WS_BAR))[i] = 0u;
        for (int l = 0; l < 2; ++l) {
            const float mqa = wave_max(fabsf(A->in[12][l * 64 + lane]), lane), mka = wave_max(fabsf(A->in[13][l * 64 + lane]), lane);
            const float mqb = wave_max(fabsf(A->in[14][l * 64 + lane]), lane), mkb = wave_max(fabsf(A->in[15][l * 64 + lane]), lane);
            float mb = 0.f;
            for (int i = lane; i < 8 * 257; i += 64) mb = fmaxf(mb, fabsf(A->in[16][l * 8 * 257 + i]));
            mb = wave_max(mb, lane);
            const float d1 = wave_sum(A->in[17][l * 64 + lane] * A->in[18][l * 64 + lane], lane), d2 = wave_sum(A->in[19][l * 64 + lane] * A->in[20][l * 64 + lane], lane);
            const float lam_init = l == 0 ? 0.2f : 0.35550906759096934f;
            if (lane == 0) {
                cst[l * 8 + 0] = LOG2E * (8.0f * mqa * mka + mb);
                cst[l * 8 + 1] = LOG2E * (8.0f * mqb * mkb);
                cst[l * 8 + 2] = expf(d1) - expf(d2) + lam_init;
                cst[l * 8 + 3] = 1.0f - lam_init;
            }
        }
    }
}

__device__ __forceinline__ int swap23(int r) { return (r & 19) | ((r & 4) << 1) | ((r & 8) >> 1); }
__device__ __forceinline__ f32x16 mfma32(bf16x8 a, bf16x8 b, f32x16 c) { return __builtin_amdgcn_mfma_f32_32x32x16_bf16(a, b, c, 0, 0, 0); }
__device__ __forceinline__ bf16x8 pack8(const f32x16& p, int s) {
    u32x4 w; w.x = cvt_pk_bf16(p[8 * s + 0], p[8 * s + 1]); w.y = cvt_pk_bf16(p[8 * s + 2], p[8 * s + 3]); w.z = cvt_pk_bf16(p[8 * s + 4], p[8 * s + 5]); w.w = cvt_pk_bf16(p[8 * s + 6], p[8 * s + 7]);
    return __builtin_bit_cast(bf16x8, w);
}
constexpr int ATT_BUF = 32768, ATT_WAVE = 65536, ATT_BW = 131072 + 64;

__device__ __forceinline__ void attn_a_block(const bf16_t* Qw, const bf16_t* Kb, const bf16_t* Vtb, int ldv, int T, int t_lo, int t_hi, int t_self, int qoff,
                                             bf16_t* Outw, LAS unsigned char* lds, int wave, int lane_in) {
    int lane = lane_in; asm volatile("" : "+v"(lane));
    const int r32 = lane & 31, hi = lane >> 5;
    const bool active = t_lo <= t_hi;
    const LAS float* E = (const LAS float*)(lds + ATT_WAVE + wave * 8192);
    bf16x8 qf[4];
#pragma unroll
    for (int d0 = 0; d0 < 4; ++d0) qf[d0] = active ? *(const bf16x8*)(Qw + (size_t)r32 * 512 + 16 * d0 + 8 * hi) : (bf16x8){0, 0, 0, 0, 0, 0, 0, 0};
    f32x16 o0, o1;
#pragma unroll
    for (int r = 0; r < 16; ++r) { o0[r] = 0.f; o1[r] = 0.f; }
    float l = 0.f;
    const float cfar = E[192];
    const int key_l = 8 * wave + (lane & 7), c8 = lane >> 3;
    const bf16_t* kg = Kb + (size_t)key_l * 512 + 8 * c8;
    const bf16_t* vg = Vtb + (size_t)key_l * ldv + 8 * c8;
    const int koff = ((key_l >> 5) * 4 + (c8 >> 1)) * 1024 + (swap23(key_l & 31) + 32 * (c8 & 1)) * 16;
    const int voff = 8192 + (((c8 >> 2) * 2 + (key_l >> 5)) * 2 + ((c8 >> 1) & 1)) * 1024 + ((key_l & 31) + 32 * (c8 & 1)) * 16;
    constexpr int ABUF = 16384;
    u32x4 skA = *(const u32x4*)kg, svA = *(const u32x4*)vg, skB = skA, svB = svA;
    if (T > 1) { skB = *(const u32x4*)(kg + (size_t)64 * 512); svB = *(const u32x4*)(vg + 64); }
    *(LAS u32x4*)(lds + koff) = skA; *(LAS u32x4*)(lds + voff) = svA;
    __syncthreads();
    int cb = 0;
#define A_STEP(t, LK, LV, WK, WV) do { \
        if ((t) + 2 < T) { LK = *(const u32x4*)(kg + (size_t)((t) + 2) * 64 * 512); LV = *(const u32x4*)(vg + ((t) + 2) * 64); } \
        if ((t) >= t_lo && (t) <= t_hi) { \
            const LAS bf16x8* KF = (const LAS bf16x8*)(lds + cb * ABUF); \
            const LAS bf16x8* VF = KF + 512; \
            _Pragma("unroll") for (int j = 0; j < 2; ++j) { \
                f32x16 sa; \
                const int relbase = 64 * (t_self - (t)) - 32 * j + qoff; \
                if (relbase - 31 >= 128) { _Pragma("unroll") for (int r = 0; r < 16; ++r) sa[r] = cfar; } \
                else { const int bi = relbase + 64 + r32 - 8 * hi - 23; _Pragma("unroll") for (int r = 0; r < 16; ++r) sa[r] = E[bi + 23 - (r & 7) - 16 * (r >> 3)]; } \
                _Pragma("unroll") for (int d0 = 0; d0 < 4; ++d0) sa = mfma32(KF[(j * 4 + d0) * 64 + lane], qf[d0], sa); \
                float ps = 0.f; \
                _Pragma("unroll") for (int r = 0; r < 16; ++r) { sa[r] = fast_exp2(sa[r]); ps += sa[r]; } \
                l += ps; \
                const bf16x8 p0 = pack8(sa, 0), p1 = pack8(sa, 1); \
                o0 = mfma32(VF[((j * 2 + 0) * 2 + 0) * 64 + lane], p0, o0); o0 = mfma32(VF[((j * 2 + 0) * 2 + 1) * 64 + lane], p1, o0); \
                o1 = mfma32(VF[((j * 2 + 1) * 2 + 0) * 64 + lane], p0, o1); o1 = mfma32(VF[((j * 2 + 1) * 2 + 1) * 64 + lane], p1, o1); \
            } \
        } \
        const int nb = cb == 2 ? 0 : cb + 1; \
        if ((t) + 1 < T) { *(LAS u32x4*)(lds + nb * ABUF + koff) = WK; *(LAS u32x4*)(lds + nb * ABUF + voff) = WV; } \
        cb = nb; \
        __syncthreads(); \
    } while (0)
    for (int t = 0; t < T; t += 2) {
        A_STEP(t, skA, svA, skB, svB);
        if (t + 1 < T) A_STEP(t + 1, skB, svB, skA, svA);
    }
#undef A_STEP
    if (active) {
        const int le = lane_id_fresh(), r32e = le & 31, hie = le >> 5;
        l += shx(l, le, 32);
        const float inv = 1.0f / l;
#pragma unroll
        for (int g = 0; g < 4; ++g) {
            u32x2 w0, w1;
            w0.x = cvt_pk_bf16(o0[4 * g] * inv, o0[4 * g + 1] * inv); w0.y = cvt_pk_bf16(o0[4 * g + 2] * inv, o0[4 * g + 3] * inv);
            w1.x = cvt_pk_bf16(o1[4 * g] * inv, o1[4 * g + 1] * inv); w1.y = cvt_pk_bf16(o1[4 * g + 2] * inv, o1[4 * g + 3] * inv);
            *(u32x2*)(Outw + (size_t)r32e * DM + 8 * g + 4 * hie) = w0;
            *(u32x2*)(Outw + (size_t)r32e * DM + 32 + 8 * g + 4 * hie) = w1;
        }
    }
}
__device__ __forceinline__ void attn_b_block(const bf16_t* Qw, const bf16_t* Kb, const bf16_t* Vtb, int ldv, int T, int tlim, float nshift, float lam, float post, const float* gsub,
                                             bf16_t* Outw, LAS unsigned char* lds, int wave, int lane_in) {
    int lane = lane_in; asm volatile("" : "+v"(lane));
    const int r32 = lane & 31, hi = lane >> 5;
    LAS bf16x8* Qs = (LAS bf16x8*)(lds + ATT_WAVE + wave * 8192);
    if (tlim > 0) {
#pragma unroll
        for (int m = 0; m < 2; ++m)
#pragma unroll
            for (int d0 = 0; d0 < 4; ++d0) Qs[(m * 4 + d0) * 64 + lane] = *(const bf16x8*)(Qw + (size_t)r32 * 512 + 64 * m + 16 * d0 + 8 * hi);
    }
    f32x16 o1[4], o2[4];
#pragma unroll
    for (int db = 0; db < 4; ++db)
#pragma unroll
        for (int r = 0; r < 16; ++r) { o1[db][r] = 0.f; o2[db][r] = 0.f; }
    float l1 = 0.f, l2 = 0.f;
    const int key_l = 8 * wave + (lane & 7), c8 = lane >> 3;
    const bf16_t* kg = Kb + (size_t)key_l * 512 + 8 * c8;
    const int koff = ((key_l >> 5) * 8 + (c8 >> 1)) * 1024 + (swap23(key_l & 31) + 32 * (c8 & 1)) * 16;
    const int d_l = 16 * wave + (lane & 7);
    const bf16_t* vg = Vtb + (size_t)d_l * ldv + 8 * c8;
    const int voff = 16384 + (((c8 >> 2) * 4 + (d_l >> 5)) * 2 + ((c8 >> 1) & 1)) * 1024 + ((d_l & 31) + 32 * (c8 & 1)) * 16;
    u32x4 sk0 = *(const u32x4*)kg, sk1 = *(const u32x4*)(kg + 64), sv0 = *(const u32x4*)vg, sv1 = *(const u32x4*)(vg + (size_t)8 * ldv);
    *(LAS u32x4*)(lds + koff) = sk0; *(LAS u32x4*)(lds + koff + 4096) = sk1; *(LAS u32x4*)(lds + voff) = sv0; *(LAS u32x4*)(lds + voff + 128) = sv1;
    __syncthreads();
    for (int t = 0; t < T; ++t) {
        const bool more = t + 1 < T;
        if (more) {
            const bf16_t* kn = kg + (size_t)(t + 1) * 64 * 512; const bf16_t* vn = vg + (t + 1) * 64;
            sk0 = *(const u32x4*)kn; sk1 = *(const u32x4*)(kn + 64); sv0 = *(const u32x4*)vn; sv1 = *(const u32x4*)(vn + (size_t)8 * ldv);
        }
        if (t < tlim) {
            const LAS bf16x8* KF = (const LAS bf16x8*)(lds + (t & 1) * ATT_BUF);
            const LAS bf16x8* VF = KF + 1024;
#pragma unroll
            for (int j = 0; j < 2; ++j) {
                bf16x8 pa[2], pb[2];
                {
                    f32x16 sa;
#pragma unroll
                    for (int r = 0; r < 16; ++r) sa[r] = nshift;
#pragma unroll
                    for (int d0 = 0; d0 < 4; ++d0) sa = mfma32(KF[((j * 2 + 0) * 4 + d0) * 64 + lane], Qs[d0 * 64 + lane], sa);
                    float ps = 0.f;
#pragma unroll
                    for (int r = 0; r < 16; ++r) { sa[r] = fast_exp2(sa[r]); ps += sa[r]; }
                    l1 += ps; pa[0] = pack8(sa, 0); pa[1] = pack8(sa, 1);
                }
                {
                    f32x16 sa;
#pragma unroll
                    for (int r = 0; r < 16; ++r) sa[r] = nshift;
#pragma unroll
                    for (int d0 = 0; d0 < 4; ++d0) sa = mfma32(KF[((j * 2 + 1) * 4 + d0) * 64 + lane], Qs[(4 + d0) * 64 + lane], sa);
                    float ps = 0.f;
#pragma unroll
                    for (int r = 0; r < 16; ++r) { sa[r] = fast_exp2(sa[r]); ps += sa[r]; }
                    l2 += ps; pb[0] = pack8(sa, 0); pb[1] = pack8(sa, 1);
                }
#pragma unroll
                for (int db = 0; db < 4; ++db)
#pragma unroll
                    for (int s = 0; s < 2; ++s) {
                        const bf16x8 vf = VF[((j * 4 + db) * 2 + s) * 64 + lane];
                        o1[db] = mfma32(vf, pa[s], o1[db]); o2[db] = mfma32(vf, pb[s], o2[db]);
                    }
            }
        }
        if (more) {
            LAS unsigned char* nb = lds + ((t + 1) & 1) * ATT_BUF;
            *(LAS u32x4*)(nb + koff) = sk0; *(LAS u32x4*)(nb + koff + 4096) = sk1; *(LAS u32x4*)(nb + voff) = sv0; *(LAS u32x4*)(nb + voff + 128) = sv1;
        }
        __syncthreads();
    }
    if (tlim > 0) {
        const int le = lane_id_fresh(), r32e = le & 31, hie = le >> 5;
        l1 += shx(l1, le, 32); l2 += shx(l2, le, 32);
        const float i1 = 1.0f / l1, i2 = lam / l2;
        float ss = 0.f;
#pragma unroll
        for (int db = 0; db < 4; ++db)
#pragma unroll
            for (int r = 0; r < 16; ++r) { const float v = o1[db][r] * i1 - o2[db][r] * i2; o1[db][r] = v; ss += v * v; }
        ss += shx(ss, le, 32);
        const float rr = rsqrtf(ss * (1.0f / 128.0f) + EPS) * post;
#pragma unroll
        for (int db = 0; db < 4; ++db)
#pragma unroll
            for (int g = 0; g < 4; ++g) {
                const int d = 32 * db + 8 * g + 4 * hie;
                const f32x4 gs = *(const f32x4*)(gsub + d);
                u32x2 w; w.x = cvt_pk_bf16(o1[db][4 * g] * rr * gs[0], o1[db][4 * g + 1] * rr * gs[1]); w.y = cvt_pk_bf16(o1[db][4 * g + 2] * rr * gs[2], o1[db][4 * g + 3] * rr * gs[3]);
                *(u32x2*)(Outw + (size_t)r32e * DM + d) = w;
            }
    }
}
__device__ __forceinline__ void attn_bs_block(KArgP A, int l, int b, int h, float nshift, float lam, float post, const float* gsub, LAS unsigned char* lds, int wave, int lane_in) {
    int lane = lane_in; asm volatile("" : "+v"(lane));
    unsigned char* ws = A->ws;
    const int lb = l * 32 + b;
    constexpr int T = 33;
    const float* ck = A->in[4] + (size_t)lb * 2048 * 512 + h * 128;
    const float* cv = A->in[5] + (size_t)lb * 2048 * 512 + h * 128;
    const bf16_t* nk = (const bf16_t*)(ws + WS_KSB) + ((size_t)lb * KSB_ROWS + 2048) * 512 + h * 128;
    const bf16_t* nv = (const bf16_t*)(ws + WS_VSB) + ((size_t)lb * 512 + h * 128) * KSB_ROWS + 2048;
    const int li = (wave - 2) * 64 + lane;
#define BS_FILL(t) do { \
        LAS unsigned char* fb = lds + ((t) & 1) * ATT_BUF; \
        if ((t) < 32) { \
            _Pragma("unroll") for (int i = 0; i < 3; ++i) { const int ci = li + 384 * i; \
                if (ci < 1024) { const int key = ci >> 4, c16 = ci & 15, c8 = c16 & 7; \
                    const float* src = ck + (size_t)(64 * (t) + key) * 512 + 8 * c16; \
                    const f32x4 a = *(const f32x4*)src, c = *(const f32x4*)(src + 4); \
                    u32x4 w; w.x = cvt_pk_bf16(a[0], a[1]); w.y = cvt_pk_bf16(a[2], a[3]); w.z = cvt_pk_bf16(c[0], c[1]); w.w = cvt_pk_bf16(c[2], c[3]); \
                    *(LAS u32x4*)(fb + ((key >> 5) * 8 + (c16 >> 3) * 4 + (c8 >> 1)) * 1024 + (swap23(key & 31) + 32 * (c8 & 1)) * 16) = w; } } \
            if (li < 256) { const int g = li >> 5, d4 = li & 31; \
                f32x4 r[8]; \
                _Pragma("unroll") for (int kk = 0; kk < 8; ++kk) r[kk] = *(const f32x4*)(cv + (size_t)(64 * (t) + 8 * g + kk) * 512 + 4 * d4); \
                _Pragma("unroll") for (int i = 0; i < 4; ++i) { const int d = 4 * d4 + i; \
                    u32x4 w; w.x = cvt_pk_bf16(r[0][i], r[1][i]); w.y = cvt_pk_bf16(r[2][i], r[3][i]); w.z = cvt_pk_bf16(r[4][i], r[5][i]); w.w = cvt_pk_bf16(r[6][i], r[7][i]); \
                    *(LAS u32x4*)(fb + 16384 + (((g >> 2) * 4 + (d >> 5)) * 2 + ((g >> 1) & 1)) * 1024 + ((d & 31) + 32 * (g & 1)) * 16) = w; } } \
        } else { \
            _Pragma("unroll") for (int i = 0; i < 3; ++i) { const int ci = li + 384 * i; \
                if (ci < 1024) { const int key = ci >> 4, c16 = ci & 15, c8 = c16 & 7; \
                    const u32x4 w = *(const u32x4*)(nk + (size_t)key * 512 + 8 * c16); \
                    *(LAS u32x4*)(fb + ((key >> 5) * 8 + (c16 >> 3) * 4 + (c8 >> 1)) * 1024 + (swap23(key & 31) + 32 * (c8 & 1)) * 16) = w; \
                    const int d = ci >> 3, g = ci & 7; \
                    const u32x4 v = *(const u32x4*)(nv + (size_t)d * KSB_ROWS + 8 * g); \
                    *(LAS u32x4*)(fb + 16384 + (((g >> 2) * 4 + (d >> 5)) * 2 + ((g >> 1) & 1)) * 1024 + ((d & 31) + 32 * (g & 1)) * 16) = v; } } \
        } \
    } while (0)
    if (wave >= 2) {
        BS_FILL(0);
        __syncthreads();
        for (int t = 0; t < T; ++t) {
            if (t + 1 < T) BS_FILL(t + 1);
            __syncthreads();
        }
    } else {
        const int r32 = lane & 31, hi = lane >> 5;
        const int row0 = MP + b * 64 + 32 * wave;
        const bf16_t* Qw = (const bf16_t*)(ws + WS_QB) + (size_t)row0 * 512 + h * 128;
        LAS bf16x8* Qs = (LAS bf16x8*)(lds + ATT_WAVE + wave * 8192);
#pragma unroll
        for (int m = 0; m < 2; ++m)
#pragma unroll
            for (int d0 = 0; d0 < 4; ++d0) Qs[(m * 4 + d0) * 64 + lane] = *(const bf16x8*)(Qw + (size_t)r32 * 512 + 64 * m + 16 * d0 + 8 * hi);
        f32x16 o1[4], o2[4];
#pragma unroll
        for (int db = 0; db < 4; ++db)
#pragma unroll
            for (int r = 0; r < 16; ++r) { o1[db][r] = 0.f; o2[db][r] = 0.f; }
        float l1 = 0.f, l2 = 0.f;
        __syncthreads();
        for (int t = 0; t < T; ++t) {
            const LAS bf16x8* KF = (const LAS bf16x8*)(lds + (t & 1) * ATT_BUF);
            const LAS bf16x8* VF = KF + 1024;
#pragma unroll
            for (int j = 0; j < 2; ++j) {
                bf16x8 pa[2], pb[2];
                {
                    f32x16 sa;
#pragma unroll
                    for (int r = 0; r < 16; ++r) sa[r] = nshift;
#pragma unroll
                    for (int d0 = 0; d0 < 4; ++d0) sa = mfma32(KF[((j * 2 + 0) * 4 + d0) * 64 + lane], Qs[d0 * 64 + lane], sa);
                    float ps = 0.f;
#pragma unroll
                    for (int r = 0; r < 16; ++r) { sa[r] = fast_exp2(sa[r]); ps += sa[r]; }
                    l1 += ps; pa[0] = pack8(sa, 0); pa[1] = pack8(sa, 1);
                }
                {
                    f32x16 sa;
#pragma unroll
                    for (int r = 0; r < 16; ++r) sa[r] = nshift;
#pragma unroll
                    for (int d0 = 0; d0 < 4; ++d0) sa = mfma32(KF[((j * 2 + 1) * 4 + d0) * 64 + lane], Qs[(4 + d0) * 64 + lane], sa);
                    float ps = 0.f;
#pragma unroll
                    for (int r = 0; r < 16; ++r) { sa[r] = fast_exp2(sa[r]); ps += sa[r]; }
                    l2 += ps; pb[0] = pack8(sa, 0); pb[1] = pack8(sa, 1);
                }
#pragma unroll
                for (int db = 0; db < 4; ++db)
#pragma unroll
                    for (int s = 0; s < 2; ++s) {
                        const bf16x8 vf = VF[((j * 4 + db) * 2 + s) * 64 + lane];
                        o1[db] = mfma32(vf, pa[s], o1[db]); o2[db] = mfma32(vf, pb[s], o2[db]);
                    }
            }
            __syncthreads();
        }
        const int le = lane_id_fresh(), r32e = le & 31, hie = le >> 5;
        l1 += shx(l1, le, 32); l2 += shx(l2, le, 32);
        const float i1 = 1.0f / l1, i2 = lam / l2;
        float ss = 0.f;
#pragma unroll
        for (int db = 0; db < 4; ++db)
#pragma unroll
            for (int r = 0; r < 16; ++r) { const float v = o1[db][r] * i1 - o2[db][r] * i2; o1[db][r] = v; ss += v * v; }
        ss += shx(ss, le, 32);
        const float rr = rsqrtf(ss * (1.0f / 128.0f) + EPS) * post;
        bf16_t* Outw = (bf16_t*)(ws + WS_O) + (size_t)row0 * DM + 512 + h * 128;
#pragma unroll
        for (int db = 0; db < 4; ++db)
#pragma unroll
            for (int g = 0; g < 4; ++g) {
                const int d = 32 * db + 8 * g + 4 * hie;
                const f32x4 gs = *(const f32x4*)(gsub + d);
                u32x2 w; w.x = cvt_pk_bf16(o1[db][4 * g] * rr * gs[0], o1[db][4 * g + 1] * rr * gs[1]); w.y = cvt_pk_bf16(o1[db][4 * g + 2] * rr * gs[2], o1[db][4 * g + 3] * rr * gs[3]);
                *(u32x2*)(Outw + (size_t)r32e * DM + d) = w;
            }
    }
#undef BS_FILL
}
constexpr int U_BS = 128, U_BP = 512, U_AP = 1024, U_AS = 256, U_B = U_BS + U_BP, U_ALL = U_B + U_AP + U_AS;
__device__ __forceinline__ void attn_phase(KArgP A, int l, LAS unsigned char* lds, int wave, int cidx) {
    unsigned char* ws = A->ws;
    unsigned* ctr = (unsigned*)(ws + WS_CTL) + cidx;
    const float* cst = (const float*)(ws + WS_CTL + 4096) + l * 8;
#define SGPR_F(x) __builtin_bit_cast(float, __builtin_amdgcn_readfirstlane(__builtin_bit_cast(int, (x))))
    const float shA = SGPR_F(cst[0]), shB = SGPR_F(cst[1]), lam = SGPR_F(cst[2]), post = SGPR_F(cst[3]);
#undef SGPR_F
    volatile LAS int* bw = (volatile LAS int*)(lds + ATT_BW);
    const bf16_t* QA = (const bf16_t*)(ws + WS_QA); const bf16_t* QB = (const bf16_t*)(ws + WS_QB);
    bf16_t* O = (bf16_t*)(ws + WS_O);
    const float* bias = A->in[16] + (size_t)l * 8 * 257;
    const float* gsub = A->in[21] + l * 128;
    for (;;) {
        int lane_l = lane_id_fresh(); asm volatile("" : "+v"(lane_l)); const int lane = lane_l;
        __syncthreads();
        if (wave == 0 && lane == 0) bw[0] = (int)atomicAdd(ctr, 1u);
        __syncthreads();
        const int uid = __builtin_amdgcn_readfirstlane(bw[0]);
        if (uid >= U_ALL) break;
        if (uid < U_BS) {
            attn_bs_block(A, l, uid >> 2, uid & 3, -shB, lam, post, gsub, lds, wave, lane);
        } else if (uid < U_B) {
            int b, h, T, tlim, row0, ldv; const bf16_t* K; const bf16_t* Vt;
            if (uid < U_BS) { b = uid >> 2; h = uid & 3; T = 33; tlim = wave < 2 ? 33 : 0; row0 = MP + b * 64 + 32 * (wave & 1); ldv = KSB_ROWS;
                K = (const bf16_t*)(ws + WS_KSB) + (size_t)(l * 32 + b) * KSB_ROWS * 512 + h * 128;
                Vt = (const bf16_t*)(ws + WS_VSB) + ((size_t)(l * 32 + b) * 512 + h * 128) * KSB_ROWS; }
            else { const int v = uid - U_BS, qb = 7 - (v >> 6), w = v & 63; b = w >> 2; h = w & 3; T = 4 * qb + 4; tlim = 4 * qb + (wave >> 1) + 1; row0 = b * 2048 + 256 * qb + 32 * wave; ldv = 2048;
                K = (const bf16_t*)(ws + WS_KBP) + (size_t)b * 2048 * 512 + h * 128;
                Vt = (const bf16_t*)(ws + WS_VBP) + ((size_t)b * 512 + h * 128) * 2048; }
            attn_b_block(QB + (size_t)row0 * 512 + h * 128, K, Vt, ldv, T, tlim, -shB, lam, post, gsub, O + (size_t)row0 * DM + 512 + h * 128, lds, wave, lane);
        } else {
            int b, h, T, t_lo, t_hi, t_self, row0, ldv; const bf16_t* K; const bf16_t* Vt;
            if (uid < U_B + U_AP) { const int v = uid - U_B, cq = 7 - (v >> 7), w = v & 127; b = w >> 3; h = w & 7;
                const int kc0 = cq >= 2 ? 4 * cq - 8 : 0, cw = 4 * cq + (wave >> 1);
                T = 4 * cq + 4 - kc0; t_self = cw - kc0; t_hi = t_self; t_lo = cw - 8 - kc0 > 0 ? cw - 8 - kc0 : 0; row0 = b * 2048 + 256 * cq + 32 * wave; ldv = 2048;
                K = (const bf16_t*)(ws + WS_KAP) + ((size_t)b * 2048 + 64 * kc0) * 512 + h * 64;
                Vt = (const bf16_t*)(ws + WS_VAP) + ((size_t)b * 512 + h * 64) * 2048 + 64 * kc0; }
            else { const int v = uid - U_B - U_AP; b = v >> 3; h = v & 7; T = 9; t_self = 8; t_lo = wave < 2 ? 0 : 1; t_hi = wave < 2 ? 8 : 0; row0 = MP + b * 64 + 32 * (wave & 1); ldv = KSA_ROWS;
                K = (const bf16_t*)(ws + WS_KSA) + (size_t)(l * 32 + b) * KSA_ROWS * 512 + h * 64;
                Vt = (const bf16_t*)(ws + WS_VSA) + ((size_t)(l * 32 + b) * 512 + h * 64) * KSA_ROWS; }
            LAS float* E = (LAS float*)(lds + ATT_WAVE + wave * 8192);
#pragma unroll
            for (int j = 0; j < 5; ++j) { const int i = lane + 64 * j; int rel = i - 64; rel = rel < -128 ? -128 : (rel > 128 ? 128 : rel); E[i] = LOG2E * bias[h * 257 + rel + 128] - shA; }
            attn_a_block(QA + (size_t)row0 * 512 + h * 64, K, Vt, ldv, T, t_lo, t_hi, t_self, 32 * (wave & 1), O + (size_t)row0 * DM + h * 64, lds, wave, lane);
        }
    }
}

__device__ __forceinline__ bool in_phase(int p) { KArgP k = (KArgP)__builtin_amdgcn_kernarg_segment_ptr(); asm volatile("" : "+s"(k)); return k->ph_lo <= p && p < k->ph_hi; }
__global__ void __launch_bounds__(512, 2) mega_fwd(Args KA) {
    extern __shared__ __attribute__((aligned(16))) unsigned char lds_raw[];
    LAS unsigned char* lds = (LAS unsigned char*)lds_raw;
    const int tid = threadIdx.x, wave = __builtin_amdgcn_readfirstlane(tid >> 6);
    const int G = gridDim.x, bx = blockIdx.x;
    const int vcu = (G % 8 == 0) ? (bx % 8) * (G / 8) + bx / 8 : bx;
    (void)KA;
    if (tid == 0) { ((volatile LAS unsigned*)(lds + ATT_BW + 64))[0] = 0u; ((volatile LAS unsigned*)(lds + ATT_BW + 64))[1] = 0u; ((volatile LAS unsigned*)(lds + ATT_BW + 64))[2] = (unsigned)bx; }
    __syncthreads();
#define FRESH_KAP(name) KArgP name = (KArgP)__builtin_amdgcn_kernarg_segment_ptr(); asm volatile("" : "+s"(name))
#define IN_PH(p) in_phase(p)
#define SEAM(p) do { FRESH_KAP(ks_); if (ks_->coop && (p) + 1 < ks_->ph_hi) { XcdBarrier xb_; xb_.bar = (unsigned*)(ks_->ws + WS_BAR); xb_.x = xb_xcc_id(); xb_.st = (volatile LAS unsigned*)(lds + ATT_BW + 64); xcd_barrier(xb_); } } while (0)
#define KARGS() KArgP kap = (KArgP)__builtin_amdgcn_kernarg_segment_ptr(); asm volatile("" : "+s"(kap)); unsigned char* ws = kap->ws; float* out = kap->out; \
    float* ssq = (float*)(ws + WS_SSQ); bf16_t* xb = (bf16_t*)(ws + WS_XB); bf16_t* ab = (bf16_t*)(ws + WS_A); unsigned char* wl = ws + WS_W + (size_t)l * W_LAYER; (void)ssq; (void)xb; (void)ab; (void)wl; (void)out; \
    const int cx = __builtin_amdgcn_readfirstlane((int)((volatile LAS unsigned*)(lds + ATT_BW + 64))[2])
    if (IN_PH(0)) {
        KArgP kap = (KArgP)__builtin_amdgcn_kernarg_segment_ptr(); asm volatile("" : "+s"(kap));
        prologue(kap, lds, vcu * 8 + wave, G * 8, wave);
#ifdef PROBE_PRO2
        prologue(kap, lds, vcu * 8 + wave, G * 8, wave);
#endif
        { FRESH_KAP(ks_); if (ks_->coop && 1 < ks_->ph_hi) { cg::this_grid().sync();
            if (tid == 0) { unsigned* bar_ = (unsigned*)(ks_->ws + WS_BAR); const unsigned x_ = xb_xcc_id(); const unsigned r_ = xb_add(&bar_[XB_XCNT(x_)], 1u);
                if (G == 256 && r_ < 32u && x_ < 8u) ((volatile LAS unsigned*)(lds + ATT_BW + 64))[2] = r_ * 8u + x_; }
            __syncthreads(); } }
    }
#pragma unroll 1
    for (int l = 0; l < 2; ++l) {
        const int p0 = 1 + 7 * l;
        if (IN_PH(p0 + 0)) {
            KARGS();
            pg8::Gemm g{xb, (const bf16_t*)(wl + W_GU1), MT, 2 * DFF, DM, DM, 0};
            pg8::StaticOrder S; S.init(MT, 2 * DFF, G, cx);
            EpiSwiGLU E{ab, ssq + (size_t)(3 * l) * MT};
            pg8::gemm_phase<EpiSwiGLU, pg8::StaticOrder, true, true>(lds, g, S, E, wave);
#ifdef PROBE_UP2
            pg8::gemm_phase<EpiSwiGLU, pg8::StaticOrder, true, true>(lds, g, S, E, wave);
#endif
            SEAM(p0 + 0);
        }
        if (IN_PH(p0 + 1)) {
            KARGS();
            pg8::Gemm g{ab, (const bf16_t*)(wl + W_D1), MT, DM, DFF, LDP, 2};
            pg8::TailSplitOrder S; S.init(MT, DM, G, cx, 0, DOWN_WGM);
            EpiResid E{l == 0 ? kap->in[0] : out, l == 0 ? kap->in[1] : out + (size_t)MP * DM, out, xb, ssq + (size_t)(3 * l + 1) * MT, 0.5f};
            pg8::gemm_phase<EpiResid, pg8::TailSplitOrder, true, true>(lds, g, S, E, wave);
            SEAM(p0 + 1);
        }
        if (IN_PH(p0 + 2)) {
            {
                KARGS();
                pg8::Gemm g{xb, (const bf16_t*)(wl + W_IN), MT, 2048, DM, DM, 0};
                pg8::TailSplitOrder S; S.init(MT, 2048, G, cx);
                EpiQK E{ssq + (size_t)(3 * l + 1) * MT, ws, out, kap, l};
                pg8::gemm_phase<EpiQK, pg8::TailSplitOrder, true, true>(lds, g, S, E, wave);
#ifdef PROBE_QK2
                pg8::gemm_phase<EpiQK, pg8::TailSplitOrder, true, true>(lds, g, S, E, wave);
#endif
            }
            {
                KARGS();
                pg8::Gemm g{(const bf16_t*)(wl + W_IN) + (size_t)2048 * DM, xb, 1024, MT, DM, DM, 0};
                pg8::TailSplitOrder S; S.init(1024, MT, G, cx);
                EpiVt E{ssq + (size_t)(3 * l + 1) * MT, ws, out, l};
                pg8::gemm_phase<EpiVt, pg8::TailSplitOrder, true, true>(lds, g, S, E, wave);
#ifdef PROBE_VT2
                pg8::gemm_phase<EpiVt, pg8::TailSplitOrder, true, true>(lds, g, S, E, wave);
#endif
            }
            SEAM(p0 + 2);
        }
        if (IN_PH(p0 + 3)) {
            KArgP kap = (KArgP)__builtin_amdgcn_kernarg_segment_ptr(); asm volatile("" : "+s"(kap));
            attn_phase(kap, l, lds, wave, l);
#ifdef PROBE_ATTN2
            attn_phase(kap, l, lds, wave, 2 + l);
#endif
            SEAM(p0 + 3);
        }
        if (IN_PH(p0 + 4)) {
            KARGS();
            pg8::Gemm g{(const bf16_t*)(ws + WS_O), (const bf16_t*)(wl + W_OUT), MT, DM, DM, DM, 0};
            pg8::TailSplitOrder S; S.init(MT, DM, G, cx);
            EpiResid E{out, out + (size_t)MP * DM, out, xb, ssq + (size_t)(3 * l + 2) * MT, 1.0f};
            pg8::gemm_phase<EpiResid, pg8::TailSplitOrder, true, true>(lds, g, S, E, wave);
            SEAM(p0 + 4);
        }
        if (IN_PH(p0 + 5)) {
            KARGS();
            pg8::Gemm g{xb, (const bf16_t*)(wl + W_GU2), MT, 2 * DFF, DM, DM, 0};
            pg8::StaticOrder S; S.init(MT, 2 * DFF, G, cx);
            EpiSwiGLU E{ab, ssq + (size_t)(3 * l + 2) * MT};
            pg8::gemm_phase<EpiSwiGLU, pg8::StaticOrder, true, true>(lds, g, S, E, wave);
            SEAM(p0 + 5);
        }
        if (IN_PH(p0 + 6)) {
            KARGS();
            pg8::Gemm g{ab, (const bf16_t*)(wl + W_D2), MT, DM, DFF, LDP, 2};
            pg8::TailSplitOrder S; S.init(MT, DM, G, cx, 0, DOWN_WGM);
            EpiResid E{out, out + (size_t)MP * DM, out, xb, ssq + (size_t)(3 * l + 3) * MT, 0.5f};
            pg8::gemm_phase<EpiResid, pg8::TailSplitOrder, true, true>(lds, g, S, E, wave);
            SEAM(p0 + 6);
        }
    }
}

#ifndef N_LAUNCH_MODE_GUARD_
#define N_LAUNCH_MODE_GUARD_
#endif
#ifndef N_LAUNCH_MODE
#define N_LAUNCH_MODE 0
#endif
extern "C" void kernel_launch(void* const* d_in, const int* in_sizes, int n_in, void* d_out, int out_size, void* d_ws, size_t ws_size, hipStream_t stream) {
    static int grid = 0;
    if (grid == 0) {
        if (n_in != 27 || ws_size < WS_END) { fprintf(stderr, "kernel_launch: unexpected inputs (n_in %d, ws %zu)\n", n_in, ws_size); grid = -1; return; }
        int dev = 0, cus = 0, per_cu = 0;
        hipGetDevice(&dev);
        hipDeviceGetAttribute(&cus, hipDeviceAttributeMultiprocessorCount, dev);
        hipFuncSetAttribute((const void*)mega_fwd, hipFuncAttributeMaxDynamicSharedMemorySize, LDS_BYTES);
        hipOccupancyMaxActiveBlocksPerMultiprocessor(&per_cu, (const void*)mega_fwd, 512, LDS_BYTES);
        (void)hipGetLastError();
        if (per_cu < 1) per_cu = 1;
        grid = cus;
        if (grid != 256) fprintf(stderr, "kernel_launch: note: %d CUs\n", grid);
    }
    if (grid < 0) return;
    Args a{};
    for (int i = 0; i < 27; ++i) a.in[i] = (const float*)d_in[i];
    a.out = (float*)d_out; a.ws = (unsigned char*)d_ws;
#if N_LAUNCH_MODE == 1
    for (int ph = 0; ph < NPHASE; ++ph) {
        a.ph_lo = ph; a.ph_hi = ph + 1; a.coop = 0;
        hipLaunchKernelGGL(mega_fwd, dim3(grid), dim3(512), LDS_BYTES, stream, a);
    }
#else
    a.ph_lo = 0; a.ph_hi = NPHASE; a.coop = 1;
    void* args[] = {&a};
    hipError_t e = hipLaunchCooperativeKernel((const void*)mega_fwd, dim3(grid), dim3(512), args, LDS_BYTES, stream);
    if (e != hipSuccess) fprintf(stderr, "cooperative launch failed: %s (grid %d)\n", hipGetErrorString(e), grid);
#endif
}
```

```cpp
#include <hip/hip_runtime.h>
#include <hip/hip_cooperative_groups.h>
#include <cstdio>
#include <cstdint>
#include <cstddef>
namespace cg = cooperative_groups;
__device__ __forceinline__ int lane_id_fresh() { int l; asm volatile("v_mbcnt_lo_u32_b32 %0, -1, 0\n\tv_mbcnt_hi_u32_b32 %0, -1, %0" : "=v"(l)); return l; }
#ifndef PG8_PFD
#define PG8_PFD 4
#endif
namespace pg8 {
#define PG8_LAS __attribute__((address_space(3)))
typedef unsigned short bf16_t;
typedef short bf16x8 __attribute__((ext_vector_type(8)));
typedef float f32x4 __attribute__((ext_vector_type(4)));
typedef unsigned u32x4 __attribute__((ext_vector_type(4)));
constexpr int BM = 256, BK = 64, HALF = 128, HTB = HALF * BK * 2  , STAGE_BYTES = 8 * HTB, NXCD = 8, WGM = 8;

__host__ __device__ __forceinline__ int lds_byte(int r, int c) { const int st = (r >> 4) * 2 + (c >> 5), rr = r & 15, cc = c & 31, ob = rr * 64 + cc * 2; return st * 1024 + (ob ^ (((ob >> 9) & 1) << 5)); }
__host__ __device__ __forceinline__ void stage_rc(int b, int& R, int& C) { const int st = b / 1024, sb = b % 1024, swz = sb ^ (((sb >> 9) & 1) << 5); R = (st >> 1) * 16 + swz / 64; C = (st & 1) * 32 + (swz % 64) / 2; }
__host__ __device__ __forceinline__ int perm32(int rho) { const int n = rho >> 4, i = rho & 15; return 8 * (i >> 2) + 4 * n + (i & 3); }

struct Unit { int pm, pn, hm; };
struct Gemm { const bf16_t* A; const bf16_t* Bt; int M, N, K, ld; int blocked; };

struct StaticOrder {
    int nM, nN, nwg, G, c, rev, wgm;
    __host__ __device__ void init(int M, int N, int G_, int c_, int rev_ = 0, int wgm_ = WGM) { nM = M / BM; nN = N / BM; nwg = nM * nN; G = G_; c = c_; rev = rev_; wgm = wgm_; }
    __host__ __device__ __forceinline__ void tile(int wgid, Unit& u) const {
        { const int q = nwg / NXCD, r = nwg % NXCD, xcd = wgid % NXCD, off = wgid / NXCD; wgid = (xcd < r ? xcd * (q + 1) : r * (q + 1) + (xcd - r) * q) + off; }
        const int nig = wgm * nN, gid = wgid / nig, fm = gid * wgm, gsz = (nM - fm) < wgm ? (nM - fm) : wgm;
        u.pm = fm + ((wgid % nig) % gsz); u.pn = (wgid % nig) / gsz; u.hm = 3;
        if (rev) u.pm = nM - 1 - u.pm;
    }
    __host__ __device__ bool next(int i, Unit& u) const {
        const long L = (long)i * G + c; if (L >= nwg) return false;
        tile((int)L, u); return true;
    }
    __device__ __forceinline__ void a_ready(const Unit&) const {}
    __device__ __forceinline__ void done(const Unit&) const {}
};
struct TailSplitOrder : StaticOrder {
    __host__ __device__ bool next(int i, Unit& u) const {
        const int nfull = (nwg / G) * G, L = i * G + c;
        if (L < nfull) { tile(L, u); return true; }
        const int idx = L - nfull;
        if (idx >= 2 * (nwg - nfull)) return false;
        tile(nfull + (idx >> 1), u); u.hm = 1 << (idx & 1); return true;
    }
};

__device__ __forceinline__ unsigned cvt_pk_bf16(float lo, float hi) { unsigned r; asm volatile("v_cvt_pk_bf16_f32 %0, %1, %2" : "=v"(r) : "v"(lo), "v"(hi)); return r; }
typedef float f32x2 __attribute__((ext_vector_type(2)));
template <class Epi, class Sched, bool ALIGN_EPI = false, bool SP2 = false>
__device__ __forceinline__ void gemm_phase(PG8_LAS unsigned char* lds, const Gemm g, const Sched& S, const Epi& E, int wave_in) {
    int tid_l = wave_in * 64 + lane_id_fresh(); asm volatile("" : "+v"(tid_l));
    const int tid = tid_l, wid = __builtin_amdgcn_readfirstlane(tid >> 6), lane = tid & 63, wr = wid >> 2, wc = wid & 3, fr = lane & 15, fq = lane >> 4;
    const int nt = g.K / BK, K = g.blocked ? BK : g.ld;
    unsigned voffA[2], voffB[2];
#pragma unroll
    for (int i = 0; i < 2; ++i) { int R, C; stage_rc(tid * 16 + i * 8192, R, C); const int Rb = Epi::PERM ? ((R & ~31) + perm32(R & 31)) : R;
        voffA[i] = (unsigned)(R * K + C) * 2u; voffB[i] = (unsigned)(Rb * K + C) * 2u;
        if (g.blocked == 2) { voffA[i] = (unsigned)(tid * 16 + i * 8192); voffB[i] = voffA[i]; } }
    const size_t kstep = g.blocked ? (size_t)(BM * BK * 2) : (size_t)(BK * 2);
    const size_t hstep = (size_t)HALF * K * 2;
    const size_t tstep = g.blocked ? (size_t)nt * (BM * BK * 2) : 2 * hstep;
    const unsigned ldsw = (unsigned)wid * 1024u;
    const int aoff = lds_byte(wr * 64 + fr, fq * 8), boff = lds_byte(wc * 32 + fr, fq * 8);
#define PG8_SA(b, h) (((b) * 2 + (h)) * HTB)
#define PG8_SB(b, h) ((4 + (b) * 2 + (h)) * HTB)
#define PG8_STAGE(bufoff, gbase, voff) do { _Pragma("unroll") for (int _i = 0; _i < 2; ++_i) \
        __builtin_amdgcn_global_load_lds((const unsigned*)((const char*)(gbase) + (voff)[_i]), (PG8_LAS unsigned*)(lds + (bufoff) + ldsw + _i * 8192), 16, 0, 0); } while (0)
#define PG8_LDA(dst, b, h) do { _Pragma("unroll") for (int m = 0; m < 4; ++m) _Pragma("unroll") for (int k = 0; k < 2; ++k) dst[m][k] = *(const PG8_LAS bf16x8*)(lds + PG8_SA(b, h) + aoff + m * 2048 + k * 1024); } while (0)
#define PG8_LDB(dst, b, h) do { _Pragma("unroll") for (int n = 0; n < 2; ++n) _Pragma("unroll") for (int k = 0; k < 2; ++k) dst[n][k] = *(const PG8_LAS bf16x8*)(lds + PG8_SB(b, h) + boff + n * 2048 + k * 1024); } while (0)
#define PG8_MMA(ai, bj, At, Bt) do { __builtin_amdgcn_s_setprio(1); _Pragma("unroll") for (int m = 0; m < 4; ++m) _Pragma("unroll") for (int n = 0; n < 2; ++n) _Pragma("unroll") for (int k = 0; k < 2; ++k) \
        acc[ai][bj][m][n] = __builtin_amdgcn_mfma_f32_16x16x32_bf16(Bt[n][k], At[m][k], acc[ai][bj][m][n], 0, 0, 0); __builtin_amdgcn_s_setprio(0); } while (0)
#define PG8_WAIT_V(n) asm volatile("s_waitcnt vmcnt(" #n ")" ::: "memory")
#define PG8_WAIT_L(n) asm volatile("s_waitcnt lgkmcnt(" #n ")" ::: "memory")
#define PG8_BAR __builtin_amdgcn_s_barrier()
#define PG8_SCHED __builtin_amdgcn_sched_barrier(0)
    Unit cur, nxt; int ui = 0;
    if (!S.next(0, cur)) return;
    f32x4 acc[2][2][4][2];
#pragma unroll
    for (int a = 0; a < 2; ++a)
#pragma unroll
        for (int b = 0; b < 2; ++b)
#pragma unroll
            for (int m = 0; m < 4; ++m)
#pragma unroll
                for (int n = 0; n < 2; ++n) acc[a][b][m][n] = (f32x4){0.f, 0.f, 0.f, 0.f};
    bf16x8 At[4][2], B0[2][2], B1[2][2];
    const char* cA = (const char*)g.A + (size_t)cur.pm * tstep; const char* cB = (const char*)g.Bt + (size_t)cur.pn * tstep;
    S.a_ready(cur);
    if constexpr (SP2) {
        PG8_STAGE(PG8_SB(0, 0), cB, voffB); PG8_STAGE(PG8_SB(0, 1), cB + hstep, voffB); PG8_STAGE(PG8_SA(0, 0), cA, voffA); PG8_STAGE(PG8_SA(0, 1), cA + hstep, voffA);
        if (wr == 1) PG8_BAR;
        PG8_WAIT_V(2); PG8_BAR;
        PG8_STAGE(PG8_SB(1, 0), cB + kstep, voffB); PG8_STAGE(PG8_SA(1, 0), cA + kstep, voffA); PG8_STAGE(PG8_SB(1, 1), cB + hstep + kstep, voffB);
        PG8_WAIT_V(6); PG8_BAR;
    } else {
        PG8_STAGE(PG8_SB(0, 0), cB, voffB); PG8_STAGE(PG8_SA(0, 0), cA, voffA); PG8_STAGE(PG8_SB(0, 1), cB + hstep, voffB); PG8_STAGE(PG8_SA(0, 1), cA + hstep, voffA);
        if (wr == 1) PG8_BAR;
        PG8_WAIT_V(4); PG8_BAR;
        PG8_STAGE(PG8_SB(1, 0), cB + kstep, voffB); PG8_STAGE(PG8_SA(1, 0), cA + kstep, voffA); PG8_STAGE(PG8_SB(1, 1), cB + hstep + kstep, voffB);
        PG8_WAIT_V(6); PG8_BAR;
    }
    for (;;) {
        const bool has_next = S.next(ui + 1, nxt);
        const char* nA = has_next ? (const char*)g.A + (size_t)nxt.pm * tstep : cA; const char* nB = has_next ? (const char*)g.Bt + (size_t)nxt.pn * tstep : cB;
        for (int t = 0; t < nt; t += 2) {
            const bool last = (t == nt - 2);
            const char* a1 = cA + (size_t)(t + 1) * kstep;
            const char* a2 = last ? nA : cA + (size_t)(t + 2) * kstep; const char* b2 = last ? nB : cB + (size_t)(t + 2) * kstep;
            const char* a3 = a2 + kstep; const char* b3 = b2 + kstep;
            if (last && has_next) S.a_ready(nxt);
            if constexpr (SP2) {
            PG8_LDB(B0, 0, 0); PG8_LDB(B1, 0, 1); PG8_SCHED; PG8_LDA(At, 0, 0); PG8_STAGE(PG8_SA(1, 1), a1 + hstep, voffA);
            PG8_WAIT_V(8); PG8_WAIT_L(0); PG8_BAR; if (cur.hm & 1) { PG8_MMA(0, 0, At, B0); PG8_MMA(0, 1, At, B1); } PG8_BAR; PG8_SCHED;
            PG8_LDA(At, 0, 1); PG8_STAGE(PG8_SB(0, 0), b2, voffB); PG8_STAGE(PG8_SB(0, 1), b2 + hstep, voffB); PG8_STAGE(PG8_SA(0, 0), a2, voffA);
            PG8_WAIT_V(8); PG8_WAIT_L(0); PG8_BAR; if (cur.hm & 2) { PG8_MMA(1, 0, At, B0); PG8_MMA(1, 1, At, B1); } PG8_BAR; PG8_SCHED;
            PG8_LDB(B0, 1, 0); PG8_LDB(B1, 1, 1); PG8_SCHED; PG8_LDA(At, 1, 0); PG8_STAGE(PG8_SA(0, 1), a2 + hstep, voffA);
            PG8_WAIT_V(8); PG8_WAIT_L(0); PG8_BAR; if (cur.hm & 1) { PG8_MMA(0, 0, At, B0); PG8_MMA(0, 1, At, B1); } PG8_BAR; PG8_SCHED;
            PG8_LDA(At, 1, 1); PG8_STAGE(PG8_SB(1, 0), b3, voffB); PG8_STAGE(PG8_SB(1, 1), b3 + hstep, voffB); PG8_STAGE(PG8_SA(1, 0), a3, voffA);
            PG8_WAIT_V(8); PG8_WAIT_L(0); PG8_BAR; if (cur.hm & 2) { PG8_MMA(1, 0, At, B0); PG8_MMA(1, 1, At, B1); } PG8_BAR; PG8_SCHED;
            } else {
            PG8_LDB(B0, 0, 0); PG8_SCHED; PG8_LDA(At, 0, 0); PG8_STAGE(PG8_SA(1, 1), a1 + hstep, voffA);
            PG8_WAIT_L(8); PG8_BAR; PG8_WAIT_L(0); PG8_MMA(0, 0, At, B0); PG8_BAR; PG8_SCHED;
            PG8_LDB(B1, 0, 1); PG8_STAGE(PG8_SB(0, 0), b2, voffB);
            PG8_BAR; PG8_WAIT_L(0); PG8_MMA(0, 1, At, B1); PG8_BAR;
            PG8_LDA(At, 0, 1); PG8_STAGE(PG8_SA(0, 0), a2, voffA);
            PG8_BAR; PG8_WAIT_L(0); PG8_MMA(1, 0, At, B0); PG8_BAR; PG8_SCHED;
            PG8_STAGE(PG8_SB(0, 1), b2 + hstep, voffB);
            PG8_WAIT_V(6); PG8_BAR; PG8_MMA(1, 1, At, B1); PG8_BAR;
            PG8_LDB(B0, 1, 0); PG8_SCHED; PG8_LDA(At, 1, 0); PG8_STAGE(PG8_SA(0, 1), a2 + hstep, voffA);
            PG8_WAIT_L(8); PG8_BAR; PG8_WAIT_L(0); PG8_MMA(0, 0, At, B0); PG8_BAR; PG8_SCHED;
            PG8_LDB(B1, 1, 1); PG8_STAGE(PG8_SB(1, 0), b3, voffB);
            PG8_BAR; PG8_WAIT_L(0); PG8_MMA(0, 1, At, B1); PG8_BAR;
            PG8_LDA(At, 1, 1); PG8_STAGE(PG8_SA(1, 0), a3, voffA);
            PG8_BAR; PG8_WAIT_L(0); PG8_MMA(1, 0, At, B0); PG8_BAR; PG8_SCHED;
            PG8_STAGE(PG8_SB(1, 1), b3 + hstep, voffB);
            PG8_WAIT_V(6); PG8_BAR; PG8_MMA(1, 1, At, B1); PG8_BAR;
            }
        }
        if constexpr (ALIGN_EPI) { if (wr == 0) PG8_BAR; }
        if constexpr (!Epi::AFTER_DRAIN) { E(acc, cur, wr, wc, fr, fq); S.done(cur); }
        if (!has_next) break;
#pragma unroll
        for (int a = 0; a < 2; ++a)
#pragma unroll
            for (int b = 0; b < 2; ++b)
#pragma unroll
                for (int m = 0; m < 4; ++m)
#pragma unroll
                    for (int n = 0; n < 2; ++n) acc[a][b][m][n] = (f32x4){0.f, 0.f, 0.f, 0.f};
        cur = nxt; cA = nA; cB = nB; ++ui;
        if constexpr (ALIGN_EPI) { if (wr == 1) PG8_BAR; }
    }
    PG8_WAIT_V(0);
    if constexpr (!ALIGN_EPI) { if (wr == 0) PG8_BAR; }
    PG8_BAR;
    if constexpr (Epi::AFTER_DRAIN) { E.fused(acc, cur, wr, wc, fr, fq, lds, wid, lane); S.done(cur); }
#undef PG8_SA
#undef PG8_SB
#undef PG8_STAGE
#undef PG8_LDA
#undef PG8_LDB
#undef PG8_MMA
#undef PG8_WAIT_V
#undef PG8_WAIT_L
#undef PG8_BAR
#undef PG8_SCHED
}
}
using pg8::bf16_t; using pg8::bf16x8; using pg8::f32x4; using pg8::u32x4; using pg8::Unit; using pg8::cvt_pk_bf16;
typedef float f32x16 __attribute__((ext_vector_type(16)));
typedef unsigned u32x2 __attribute__((ext_vector_type(2)));
#define LAS __attribute__((address_space(3)))

constexpr int DM = 1024, SEQ = 2048, DSEQ = 64;
constexpr int MP = 16 * 2048, MS = 32 * 64, MT = MP + MS;
constexpr int DFF = 2816, LDP = 2880;
constexpr int KSA_ROWS = 576, KSB_ROWS = 2112;
constexpr float EPS = 1e-6f, LOG2E = 1.4426950408889634f, QSCALE = 0.125f * 1.4426950408889634f;
constexpr int NPHASE = 15;
#ifndef DOWN_WGM
#define DOWN_WGM 8
#endif
constexpr size_t MiB = 1u << 20;
constexpr size_t WS_CTL = 0, WS_BAR = 65536, WS_SSQ = 1 * MiB, WS_ROPE = 2 * MiB, WS_W = 4 * MiB;
constexpr size_t W_GU1 = 0, W_D1 = 11 * MiB, W_IN = 17 * MiB, W_OUT = 23 * MiB, W_GU2 = 25 * MiB, W_D2 = 36 * MiB, W_LAYER = 42 * MiB;
constexpr size_t WS_XB = 88 * MiB, WS_A = 156 * MiB, WS_QA = WS_A, WS_QB = WS_A + 34 * MiB, WS_O = WS_A + 68 * MiB;
constexpr size_t WS_KAP = 352 * MiB, WS_KBP = 384 * MiB, WS_VAP = 416 * MiB, WS_VBP = 448 * MiB;
constexpr size_t WS_KSA = 480 * MiB, WS_VSA = 516 * MiB, WS_KSB = 552 * MiB, WS_VSB = 684 * MiB, WS_END = 816 * MiB;
static_assert(W_D2 + (size_t)1024 * LDP * 2 <= W_LAYER && WS_W + 2 * W_LAYER <= WS_XB && WS_A + (size_t)MT * LDP * 2 <= WS_KAP, "d_ws map");
constexpr size_t OUT_YP = 0, OUT_YS = 33554432, OUT_PAK = 35651584, OUT_PAV = 44040192, OUT_PBK = 52428800, OUT_PBV = 85983232,
                 OUT_SAK = 119537664, OUT_SAV = 121634816, OUT_SBK = 123731968, OUT_SBV = 125829120;
constexpr int LDS_BYTES = 147456;

struct Args { const float* in[27]; float* out; unsigned char* ws; int ph_lo, ph_hi, coop, pad; };
typedef const __attribute__((address_space(4))) Args* KArgP;

__device__ const double ROPE_INV[32] = {1.0, 0.7498942093324559, 0.5623413251903491, 0.4216965034285822, 0.31622776601683794, 0.23713737056616552, 0.1778279410038923, 0.1333521432163324, 0.1, 0.07498942093324558, 0.05623413251903491, 0.042169650342858224, 0.03162277660168379, 0.023713737056616554, 0.01778279410038923, 0.01333521432163324, 0.01, 0.007498942093324558, 0.005623413251903491, 0.004216965034285823, 0.0031622776601683794, 0.0023713737056616554, 0.0017782794100389228, 0.001333521432163324, 0.001, 0.0007498942093324559, 0.0005623413251903491, 0.00042169650342858224, 0.00031622776601683794, 0.00023713737056616554, 0.00017782794100389227, 0.0001333521432163324};

__device__ __forceinline__ float shx(float v, int lane, int m) { return __builtin_bit_cast(float, __builtin_amdgcn_ds_bpermute((lane ^ m) << 2, __builtin_bit_cast(int, v))); }
__device__ __forceinline__ float wave_sum(float v, int lane) {
#pragma unroll
    for (int o = 1; o < 64; o <<= 1) v += shx(v, lane, o);
    return v;
}
__device__ __forceinline__ float wave_max(float v, int lane) {
#pragma unroll
    for (int o = 1; o < 64; o <<= 1) v = fmaxf(v, shx(v, lane, o));
    return v;
}
__device__ __forceinline__ float fast_rcp(float x) { return __builtin_amdgcn_rcpf(x); }
__device__ __forceinline__ float fast_exp2(float x) { return __builtin_amdgcn_exp2f(x); }

struct EpiSwiGLU {
    static constexpr bool PERM = true, AFTER_DRAIN = false;
    bf16_t* O; const float* ssq;
    __device__ __forceinline__ void operator()(const f32x4 (&acc)[2][2][4][2], const Unit& u, int wr, int wc, int fr, int fq) const {
        const int row0 = u.pm * 256 + wr * 64 + fr, col0 = u.pn * 128 + wc * 32 + 8 * fq;
        float sq[2][4];
#pragma unroll
        for (int ai = 0; ai < 2; ++ai)
#pragma unroll
            for (int m = 0; m < 4; ++m) sq[ai][m] = ssq[row0 + ai * 128 + m * 16];
#pragma unroll
        for (int ai = 0; ai < 2; ++ai)
#pragma unroll
            for (int m = 0; m < 4; ++m) {
                if (!((u.hm >> ai) & 1)) continue;
                const int row = row0 + ai * 128 + m * 16;
                const float rstd = rsqrtf(sq[ai][m] * (1.0f / DM) + EPS);
                float o[8];
#pragma unroll
                for (int n = 0; n < 2; ++n)
#pragma unroll
                    for (int i = 0; i < 4; ++i) {
                        const float g = acc[ai][0][m][n][i] * rstd, up = acc[ai][1][m][n][i] * rstd;
                        const float sg = g * fast_rcp(1.0f + fast_exp2(-g * LOG2E));
                        o[n * 4 + i] = sg * up;
                    }
                u32x4 w; w.x = cvt_pk_bf16(o[0], o[1]); w.y = cvt_pk_bf16(o[2], o[3]); w.z = cvt_pk_bf16(o[4], o[5]); w.w = cvt_pk_bf16(o[6], o[7]);
                *(u32x4*)((char*)O + (((size_t)(row >> 8) * (DFF / 64) + (col0 >> 6)) * 2 + ((row >> 7) & 1)) * 16384 + pg8::lds_byte(row & 127, col0 & 63)) = w;
            }
    }
};
struct EpiResid {
    static constexpr bool PERM = false, AFTER_DRAIN = false;
    const float* xin_p; const float* xin_s; float* xout; bf16_t* xb; float* ssq; float scale; int res_bf16, write_f32;
    __device__ __forceinline__ void operator()(const f32x4 (&acc)[2][2][4][2], const Unit& u, int wr, int wc, int fr, int fq) const {
        const int col0 = u.pn * 256 + wc * 32 + 4 * fq;
#pragma unroll
        for (int ai = 0; ai < 2; ++ai) {
            if (!((u.hm >> ai) & 1)) continue;
            const int rowb = u.pm * 256 + ai * 128 + wr * 64 + fr;
            f32x4 pre[4][2][2];
            if (res_bf16) {
                u32x2 pw[4][2][2];
#pragma unroll
                for (int m = 0; m < 4; ++m)
#pragma unroll
                    for (int bj = 0; bj < 2; ++bj)
#pragma unroll
                        for (int n = 0; n < 2; ++n) pw[m][bj][n] = *(const u32x2*)(xb + (size_t)(rowb + m * 16) * DM + col0 + bj * 128 + n * 16);
#pragma unroll
                for (int m = 0; m < 4; ++m)
#pragma unroll
                    for (int bj = 0; bj < 2; ++bj)
#pragma unroll
                        for (int n = 0; n < 2; ++n) { const u32x2 w = pw[m][bj][n]; f32x4 p;
                            p[0] = __builtin_bit_cast(float, w.x << 16); p[1] = __builtin_bit_cast(float, w.x & 0xffff0000u);
                            p[2] = __builtin_bit_cast(float, w.y << 16); p[3] = __builtin_bit_cast(float, w.y & 0xffff0000u); pre[m][bj][n] = p; }
            } else {
                const float* xi = (rowb < MP) ? xin_p + (size_t)rowb * DM : xin_s + (size_t)(rowb - MP) * DM;
#pragma unroll
                for (int m = 0; m < 4; ++m)
#pragma unroll
                    for (int bj = 0; bj < 2; ++bj)
#pragma unroll
                        for (int n = 0; n < 2; ++n) pre[m][bj][n] = *(const f32x4*)(xi + (size_t)m * 16 * DM + col0 + bj * 128 + n * 16);
            }
#pragma unroll
            for (int m = 0; m < 4; ++m) {
                const int row = rowb + m * 16;
                float sq = 0.f;
#pragma unroll
                for (int bj = 0; bj < 2; ++bj)
#pragma unroll
                    for (int n = 0; n < 2; ++n) {
                        const int c = col0 + bj * 128 + n * 16;
                        const f32x4 v = pre[m][bj][n] + acc[ai][bj][m][n] * scale;
                        if (write_f32) *(f32x4*)(xout + (size_t)row * DM + c) = v;
                        u32x2 w; w.x = cvt_pk_bf16(v[0], v[1]); w.y = cvt_pk_bf16(v[2], v[3]);
                        *(u32x2*)(xb + (size_t)row * DM + c) = w;
                        sq += (v[0] * v[0] + v[1] * v[1]) + (v[2] * v[2] + v[3] * v[3]);
                    }
                sq += shx(sq, fr + 16 * fq, 16); sq += shx(sq, fr + 16 * fq, 32);
                if (fq == 0) atomicAdd(ssq + row, sq);
            }
        }
    }
};
struct EpiQK {
    static constexpr bool PERM = true, AFTER_DRAIN = false;
    const float* ssq; unsigned char* ws; float* out; KArgP kap; int l;
    __device__ __forceinline__ void operator()(const f32x4 (&acc)[2][2][4][2], const Unit& u, int wr, int wc, int fr, int fq) const {
        const int sec = u.pn >> 1, hd = 4 * (u.pn & 1) + wc;
        const float* gp = kap->in[12 + sec] + l * 64;
        const float* rope = (const float*)(ws + WS_ROPE);
        bf16_t* QA = (bf16_t*)(ws + WS_QA); bf16_t* QB = (bf16_t*)(ws + WS_QB); bf16_t* KAP = (bf16_t*)(ws + WS_KAP); bf16_t* KBP = (bf16_t*)(ws + WS_KBP);
        bf16_t* KSA = (bf16_t*)(ws + WS_KSA) + (size_t)l * 32 * KSA_ROWS * 512; bf16_t* KSB = (bf16_t*)(ws + WS_KSB) + (size_t)l * 32 * KSB_ROWS * 512;
        float* oPAK = out + OUT_PAK + (size_t)l * 16 * 512 * 512; float* oPBK = out + OUT_PBK + (size_t)l * MP * 512;
        float* oSAK = out + OUT_SAK + (size_t)l * MS * 512; float* oSBK = out + OUT_SBK + (size_t)l * MS * 512;
        f32x4 gl[2], gh[2];
#pragma unroll
        for (int n = 0; n < 2; ++n) { gl[n] = *(const f32x4*)(gp + 8 * fq + 4 * n); gh[n] = *(const f32x4*)(gp + 32 + 8 * fq + 4 * n); }
        const int cbase = hd * 64 + 8 * fq;
        float sqr[2][4];
#pragma unroll
        for (int ai = 0; ai < 2; ++ai)
#pragma unroll
            for (int m = 0; m < 4; ++m) sqr[ai][m] = ssq[u.pm * 256 + ai * 128 + wr * 64 + m * 16 + fr];
#pragma unroll
        for (int ai = 0; ai < 2; ++ai)
#pragma unroll
            for (int m = 0; m < 4; ++m) {
                if (!((u.hm >> ai) & 1)) continue;
                const int row = u.pm * 256 + ai * 128 + wr * 64 + m * 16 + fr;
                const float rstd = rsqrtf(sqr[ai][m] * (1.0f / DM) + EPS);
                f32x4 y[2][2]; float ss = 0.f;
#pragma unroll
                for (int bj = 0; bj < 2; ++bj)
#pragma unroll
                    for (int n = 0; n < 2; ++n) { const f32x4 v = acc[ai][bj][m][n] * rstd; y[bj][n] = v; ss += (v[0] * v[0] + v[1] * v[1]) + (v[2] * v[2] + v[3] * v[3]); }
                ss += shx(ss, fr + 16 * fq, 16); ss += shx(ss, fr + 16 * fq, 32);
                const float rr = rsqrtf(ss * (1.0f / 64.0f) + EPS);
#pragma unroll
                for (int n = 0; n < 2; ++n) { y[0][n] = y[0][n] * rr * gl[n]; y[1][n] = y[1][n] * rr * gh[n]; }
                const bool prompt = row < MP;
                const int sp = row & 2047, bp = row >> 11, ts = (row - MP) & 63, bs = (row - MP) >> 6;
                if (sec >= 2) {
                    const int pos = prompt ? sp : 2048 + ts;
                    const float* cs = rope + (size_t)pos * 64 + 8 * fq;
#pragma unroll
                    for (int n = 0; n < 2; ++n) {
                        const f32x4 c = *(const f32x4*)(cs + 4 * n), s = *(const f32x4*)(cs + 32 + 4 * n);
                        const f32x4 x1 = y[0][n], x2 = y[1][n];
                        y[0][n] = x1 * c - x2 * s; y[1][n] = x2 * c + x1 * s;
                    }
                }
                if (sec == 0 || sec == 2) {
                    bf16_t* dst = (sec == 0 ? QA : QB) + (size_t)row * 512 + cbase;
#pragma unroll
                    for (int bj = 0; bj < 2; ++bj) {
                        const f32x4 a = y[bj][0] * QSCALE, b = y[bj][1] * QSCALE;
                        u32x4 w; w.x = cvt_pk_bf16(a[0], a[1]); w.y = cvt_pk_bf16(a[2], a[3]); w.z = cvt_pk_bf16(b[0], b[1]); w.w = cvt_pk_bf16(b[2], b[3]);
                        *(u32x4*)(dst + 32 * bj) = w;
                    }
                } else {
                    bf16_t* dst; float* fo = nullptr;
                    if (sec == 1) {
                        if (prompt) { dst = KAP + (size_t)row * 512; if (sp >= 1536) fo = oPAK + (size_t)(bp * 512 + sp - 1536) * 512; }
                        else { dst = KSA + (size_t)(bs * KSA_ROWS + 512 + ts) * 512; fo = oSAK + (size_t)(row - MP) * 512; }
                    } else {
                        if (prompt) { dst = KBP + (size_t)row * 512; fo = oPBK + (size_t)row * 512; }
                        else { dst = KSB + (size_t)(bs * KSB_ROWS + 2048 + ts) * 512; fo = oSBK + (size_t)(row - MP) * 512; }
                    }
#pragma unroll
                    for (int bj = 0; bj < 2; ++bj) {
                        const f32x4 a = y[bj][0], b = y[bj][1];
                        u32x4 w; w.x = cvt_pk_bf16(a[0], a[1]); w.y = cvt_pk_bf16(a[2], a[3]); w.z = cvt_pk_bf16(b[0], b[1]); w.w = cvt_pk_bf16(b[2], b[3]);
                        *(u32x4*)(dst + cbase + 32 * bj) = w;
                        if (fo) { *(f32x4*)(fo + cbase + 32 * bj) = a; *(f32x4*)(fo + cbase + 32 * bj + 4) = b; }
                    }
                }
            }
    }
};
struct EpiVt {
    static constexpr bool PERM = true, AFTER_DRAIN = false;
    const float* ssq; unsigned char* ws; float* out; int l;
    __device__ __forceinline__ void operator()(const f32x4 (&acc)[2][2][4][2], const Unit& u, int wr, int wc, int fr, int fq) const {
        bf16_t* VAP = (bf16_t*)(ws + WS_VAP); bf16_t* VBP = (bf16_t*)(ws + WS_VBP);
        bf16_t* VSA = (bf16_t*)(ws + WS_VSA) + (size_t)l * 32 * 512 * KSA_ROWS; bf16_t* VSB = (bf16_t*)(ws + WS_VSB) + (size_t)l * 32 * 512 * KSB_ROWS;
        float* oPAV = out + OUT_PAV + (size_t)l * 16 * 512 * 512; float* oPBV = out + OUT_PBV + (size_t)l * MP * 512;
        float* oSAV = out + OUT_SAV + (size_t)l * MS * 512; float* oSBV = out + OUT_SBV + (size_t)l * MS * 512;
        const int grp = u.pm >> 1;
        const bool prompt = u.pn < (MP / 256);
        f32x4 rs[2][2];
#pragma unroll
        for (int bj = 0; bj < 2; ++bj)
#pragma unroll
            for (int n = 0; n < 2; ++n) {
                const f32x4 q = *(const f32x4*)(ssq + u.pn * 256 + bj * 128 + wc * 32 + 8 * fq + 4 * n);
                f32x4 r; r[0] = rsqrtf(q[0] * (1.0f / DM) + EPS); r[1] = rsqrtf(q[1] * (1.0f / DM) + EPS); r[2] = rsqrtf(q[2] * (1.0f / DM) + EPS); r[3] = rsqrtf(q[3] * (1.0f / DM) + EPS);
                rs[bj][n] = r;
            }
#pragma unroll
        for (int bj = 0; bj < 2; ++bj) {
            const int tok = u.pn * 256 + bj * 128 + wc * 32 + 8 * fq;
            const int bp = tok >> 11, sp = tok & 2047, tt = tok - MP, bs = tt >> 6, ts = tt & 63;
            bf16_t* vdst; size_t vld; float* fo = nullptr;
            if (prompt) { vdst = (grp == 0 ? VAP : VBP) + (size_t)bp * 512 * 2048 + sp; vld = 2048;
                if (grp == 0) { if (sp >= 1536) fo = oPAV + (size_t)(bp * 512 + sp - 1536) * 512; } else fo = oPBV + (size_t)tok * 512; }
            else { if (grp == 0) { vdst = VSA + (size_t)bs * 512 * KSA_ROWS + 512 + ts; vld = KSA_ROWS; fo = oSAV + (size_t)tt * 512; }
                   else { vdst = VSB + (size_t)bs * 512 * KSB_ROWS + 2048 + ts; vld = KSB_ROWS; fo = oSBV + (size_t)tt * 512; } }
#pragma unroll
            for (int ai = 0; ai < 2; ++ai)
#pragma unroll
                for (int m = 0; m < 4; ++m) {
                    if (!((u.hm >> ai) & 1)) continue;
                    const int hrow = (ai * 128 + wr * 64 + m * 16 + fr) + (u.pm & 1) * 256;
                    const f32x4 a = acc[ai][bj][m][0] * rs[bj][0], b = acc[ai][bj][m][1] * rs[bj][1];
                    u32x4 w; w.x = cvt_pk_bf16(a[0], a[1]); w.y = cvt_pk_bf16(a[2], a[3]); w.z = cvt_pk_bf16(b[0], b[1]); w.w = cvt_pk_bf16(b[2], b[3]);
                    *(u32x4*)(vdst + (size_t)hrow * vld) = w;
                    if (fo) {
#pragma unroll
                        for (int i = 0; i < 4; ++i) { fo[(size_t)i * 512 + hrow] = a[i]; fo[(size_t)(4 + i) * 512 + hrow] = b[i]; }
                    }
                }
        }
    }
};
#define XB_TMO      128
#define XB_XCNT(j)  (256  + 64 * (j))
#define XB_XSUB(j)  (1280 + 64 * (j))
#define XB_XGEN(j)  (2304 + 64 * (j))
#define XB_TOP      3328
#define XB_TOPGEN   3392
#define XCD_BAR_WORDS 3456
#define XB_SPIN_CAP (1u << 18)

__device__ __forceinline__ unsigned xb_ld(unsigned* p)              { return __hip_atomic_load(p, __ATOMIC_RELAXED, __HIP_MEMORY_SCOPE_AGENT); }
__device__ __forceinline__ unsigned xb_add(unsigned* p, unsigned v) { return __hip_atomic_fetch_add(p, v, __ATOMIC_RELAXED, __HIP_MEMORY_SCOPE_AGENT); }
__device__ __forceinline__ unsigned xb_xcc_id() { return (unsigned)__builtin_amdgcn_s_getreg((3 << 11) | 20) & 0xFu; }
#define XB_SPIN(cond, bar) do { unsigned _sp = 0; while (cond) { __builtin_amdgcn_s_sleep(1); \
    if ((++_sp & 255u) == 0u) { if (xb_ld(&(bar)[XB_TMO])) break; if (_sp > XB_SPIN_CAP) { atomicAdd(&(bar)[XB_TMO], 1u); break; } } } } while (0)

struct XcdBarrier {
    unsigned* bar; unsigned x;
    volatile LAS unsigned* st;
};

__device__ __forceinline__ XcdBarrier xcd_barrier_post(unsigned* bar, volatile LAS unsigned* st) {
    XcdBarrier b; b.bar = bar; b.x = xb_xcc_id(); b.st = st;
    if (threadIdx.x == 0) (void)xb_add(&bar[XB_XCNT(b.x)], 1u);
    return b;
}
__device__ __forceinline__ void xcd_barrier_complete(unsigned* bar, unsigned x, unsigned& nloc, unsigned& nx) {
    const unsigned G = gridDim.x * gridDim.y * gridDim.z;
    unsigned sum, cnt, mine, sp = 0u;
    for (;;) {
        sum = 0u; cnt = 0u; mine = 0u;
#pragma unroll
        for (unsigned j = 0; j < 16; ++j) { const unsigned c = xb_ld(&bar[XB_XCNT(j)]); sum += c; cnt += (c > 0u) ? 1u : 0u; mine = (j == x) ? c : mine; }
        if (sum == G) break;
        __builtin_amdgcn_s_sleep(1);
        if ((++sp & 255u) == 0u) { if (xb_ld(&bar[XB_TMO])) break; if (sp > XB_SPIN_CAP) { atomicAdd(&bar[XB_TMO], 1u); break; } }
    }
    nloc = mine > 0u ? mine : 1u; nx = cnt > 0u ? cnt : 1u;
}

__device__ __forceinline__ void xcd_barrier(const XcdBarrier& b) {
    asm volatile("s_waitcnt vmcnt(0)" ::: "memory");
    __syncthreads();
    if (threadIdx.x == 0) {
        unsigned* bar = b.bar;
        __builtin_amdgcn_s_waitcnt(0);
        unsigned nloc = b.st[0], nx = b.st[1];
        if (nloc == 0u) { xcd_barrier_complete(bar, b.x, nloc, nx); b.st[0] = nloc; b.st[1] = nx; }
        const unsigned old = xb_add(&bar[XB_XSUB(b.x)], 1u);
        const unsigned gen = old / nloc;
        if (old + 1u == (gen + 1u) * nloc) {
            __builtin_amdgcn_fence(__ATOMIC_RELEASE, "agent");
            asm volatile("s_waitcnt vmcnt(0)" ::: "memory");
            const unsigned og = xb_add(&bar[XB_TOP], 1u);
            const unsigned tg = og / nx;
            if (og + 1u == (tg + 1u) * nx) xb_add(&bar[XB_TOPGEN], 1u);
            else XB_SPIN(xb_ld(&bar[XB_TOPGEN]) == tg, bar);
            __builtin_amdgcn_fence(__ATOMIC_ACQUIRE, "agent");
            xb_add(&bar[XB_XGEN(b.x)], 1u);
            asm volatile("s_waitcnt vmcnt(0)" ::: "memory");
        } else {
            XB_SPIN(xb_ld(&bar[XB_XGEN(b.x)]) == gen, bar);
            __builtin_amdgcn_fence(__ATOMIC_ACQUIRE, "agent");
            asm volatile("s_waitcnt vmcnt(0)" ::: "memory");
        }
    }
    __syncthreads();
}
__device__ __forceinline__ int map_row(int kind, int n) {
    if (kind == 0) return n;
    if (kind == 1) return 256 * (n >> 7) + (n & 127);
    if (kind == 2) return 256 * (n >> 7) + 128 + (n & 127);
    const int sec = n >> 9, w = n & 511;
    if (sec == 2) return 2048 + w;
    if (sec == 5) return 2560 + w;
    const int qsec = sec == 0 ? 0 : sec == 1 ? 1 : sec == 3 ? 2 : 3;
    const int c = qsec * 512 + w, pn = c >> 8, ww = c & 255, hw = ww >> 6, d = ww & 63;
    return 256 * pn + 128 * (d >> 5) + 32 * hw + (d & 31);
}
__device__ __forceinline__ void transpose_item(const float* src, int ld_src, int k0, int n0, const float* gain, bf16_t* dst, size_t ld_dst, int kind, LAS float* scr, int lane) {
    float tv[32];
#pragma unroll
    for (int i = 0; i < 32; ++i) tv[i] = src[(size_t)(k0 + 2 * i + (lane >> 5)) * ld_src + n0 + (lane & 31)];
    if (gain) {
#pragma unroll
        for (int i = 0; i < 32; ++i) tv[i] *= gain[k0 + 2 * i + (lane >> 5)];
    }
#pragma unroll
    for (int i = 0; i < 32; ++i) scr[(2 * i + (lane >> 5)) * 33 + (lane & 31)] = tv[i];
    asm volatile("s_waitcnt lgkmcnt(0)" ::: "memory");
    const int c = lane & 7;
#pragma unroll
    for (int j = 0; j < 4; ++j) {
        const int n = (lane >> 3) + 8 * j; const LAS float* s = scr + (8 * c) * 33 + n;
        u32x4 o; o.x = cvt_pk_bf16(s[0 * 33], s[1 * 33]); o.y = cvt_pk_bf16(s[2 * 33], s[3 * 33]); o.z = cvt_pk_bf16(s[4 * 33], s[5 * 33]); o.w = cvt_pk_bf16(s[6 * 33], s[7 * 33]);
        if (kind == 4) { const int row = n0 + n; *(u32x4*)((char*)dst + (((size_t)(row >> 8) * (DFF / 64) + (k0 >> 6)) * 2 + ((row >> 7) & 1)) * 16384 + pg8::lds_byte(row & 127, 8 * c)) = o; }
        else *(u32x4*)(dst + (size_t)map_row(kind, n0 + n) * ld_dst + k0 + 8 * c) = o;
    }
    asm volatile("s_waitcnt lgkmcnt(0)" ::: "memory");
}
__device__ __forceinline__ void do_job(const float* src, int R, int C, const float* gain, bf16_t* dst, size_t ld_dst, int kind, int item, LAS float* scr, int lane) {
    const int nblk = C >> 5, kb = item / nblk, nb = item - kb * nblk;
    (void)R;
    transpose_item(src, C, 64 * kb, 32 * nb, gain, dst, ld_dst, kind, scr, lane);
}

__device__ __forceinline__ void convert_caches(KArgP A, LAS unsigned char* lds, int l, int gw, int NGW, int wave) {
    int lane_l = lane_id_fresh(); asm volatile("" : "+v"(lane_l)); const int lane = lane_l;
    unsigned char* ws = A->ws;
    LAS float* scr = (LAS float*)(lds + wave * 16384);
    constexpr int I_CAV = 32 * 128;
    for (int it = gw; it < I_CAV; it += NGW) {
        {
            const int lb = l * 32 + (it >> 7), item = it & 127;
            do_job(A->in[3] + (size_t)lb * 512 * 512, 512, 512, nullptr, (bf16_t*)(ws + WS_VSA) + (size_t)lb * 512 * KSA_ROWS, KSA_ROWS, 0, item, scr, lane);
        }
    }
    for (int r = gw; r < 32 * 512; r += NGW) {
        const float* s; bf16_t* d;
        if (r < 32 * 512) { const int lb = l * 32 + (r >> 9), key = r & 511; s = A->in[2] + ((size_t)lb * 512 + key) * 512; d = (bf16_t*)(ws + WS_KSA) + (size_t)(lb * KSA_ROWS + key) * 512; }
        else { const int q = r - 32 * 512, lb = l * 32 + (q >> 11), key = q & 2047; s = A->in[4] + ((size_t)lb * 2048 + key) * 512; d = (bf16_t*)(ws + WS_KSB) + (size_t)(lb * KSB_ROWS + key) * 512; }
        const f32x4 a = *(const f32x4*)(s + 8 * lane), b = *(const f32x4*)(s + 8 * lane + 4);
        u32x4 w; w.x = cvt_pk_bf16(a[0], a[1]); w.y = cvt_pk_bf16(a[2], a[3]); w.z = cvt_pk_bf16(b[0], b[1]); w.w = cvt_pk_bf16(b[2], b[3]);
        *(u32x4*)(d + 8 * lane) = w;
    }
}

__device__ __forceinline__ void prologue(KArgP A, LAS unsigned char* lds, int gw, int NGW, int wave) {
    int lane_l = lane_id_fresh(); asm volatile("" : "+v"(lane_l)); const int lane = lane_l;
    unsigned char* ws = A->ws;
    LAS float* scr = (LAS float*)(lds + wave * 16384);
    constexpr int I_GU = 16 * 88, I_D = 44 * 32, I_IN = 16 * 96, I_O = 16 * 32;
    constexpr int I_LAYER = 4 * I_GU + 2 * I_D + I_IN + I_O;
    constexpr int I_W = 2 * I_LAYER;
    for (int it = gw; it < I_W; it += NGW) {
        {
            const int l = it / I_LAYER; int r = it - l * I_LAYER;
            unsigned char* wl = ws + WS_W + (size_t)l * W_LAYER;
            const float* gf1 = A->in[6] + l * DM; const float* gmx = A->in[10] + l * DM; const float* gf2 = A->in[23] + l * DM;
            if (r < I_GU) { do_job(A->in[7] + (size_t)l * DM * DFF, DM, DFF, gf1, (bf16_t*)(wl + W_GU1), DM, 1, r, scr, lane); continue; } r -= I_GU;
            if (r < I_GU) { do_job(A->in[8] + (size_t)l * DM * DFF, DM, DFF, gf1, (bf16_t*)(wl + W_GU1), DM, 2, r, scr, lane); continue; } r -= I_GU;
            if (r < I_D)  { do_job(A->in[9] + (size_t)l * DM * DFF, DFF, DM, nullptr, (bf16_t*)(wl + W_D1), LDP, 4, r, scr, lane); continue; } r -= I_D;
            if (r < I_IN) { do_job(A->in[11] + (size_t)l * DM * 3072, DM, 3072, gmx, (bf16_t*)(wl + W_IN), DM, 3, r, scr, lane); continue; } r -= I_IN;
            if (r < I_O)  { do_job(A->in[22] + (size_t)l * DM * DM, DM, DM, nullptr, (bf16_t*)(wl + W_OUT), DM, 0, r, scr, lane); continue; } r -= I_O;
            if (r < I_GU) { do_job(A->in[24] + (size_t)l * DM * DFF, DM, DFF, gf2, (bf16_t*)(wl + W_GU2), DM, 1, r, scr, lane); continue; } r -= I_GU;
            if (r < I_GU) { do_job(A->in[25] + (size_t)l * DM * DFF, DM, DFF, gf2, (bf16_t*)(wl + W_GU2), DM, 2, r, scr, lane); continue; } r -= I_GU;
            do_job(A->in[26] + (size_t)l * DM * DFF, DFF, DM, nullptr, (bf16_t*)(wl + W_D2), LDP, 4, r, scr, lane);
        }
    }
    convert_caches(A, lds, 0, gw, NGW, wave);
    convert_caches(A, lds, 1, gw, NGW, wave);
    float* ssq = (float*)(ws + WS_SSQ);
    bf16_t* xb = (bf16_t*)(ws + WS_XB);
    for (int r0 = gw; r0 < MT; r0 += 2 * NGW) {
        const int r1 = r0 + NGW; const bool has1 = r1 < MT;
        const float* xa = (r0 < MP) ? A->in[0] + (size_t)r0 * DM : A->in[1] + (size_t)(r0 - MP) * DM;
        const float* xc = !has1 ? xa : (r1 < MP) ? A->in[0] + (size_t)r1 * DM : A->in[1] + (size_t)(r1 - MP) * DM;
        f32x4 va[4], vc[4];
#pragma unroll
        for (int j = 0; j < 4; ++j) { va[j] = *(const f32x4*)(xa + 256 * j + 4 * lane); vc[j] = *(const f32x4*)(xc + 256 * j + 4 * lane); }
        float sa = 0.f, sc = 0.f;
#pragma unroll
        for (int j = 0; j < 4; ++j) {
            sa += (va[j][0] * va[j][0] + va[j][1] * va[j][1]) + (va[j][2] * va[j][2] + va[j][3] * va[j][3]);
            sc += (vc[j][0] * vc[j][0] + vc[j][1] * vc[j][1]) + (vc[j][2] * vc[j][2] + vc[j][3] * vc[j][3]);
            u32x2 w; w.x = cvt_pk_bf16(va[j][0], va[j][1]); w.y = cvt_pk_bf16(va[j][2], va[j][3]);
            *(u32x2*)(xb + (size_t)r0 * DM + 256 * j + 4 * lane) = w;
            if (has1) { u32x2 w2; w2.x = cvt_pk_bf16(vc[j][0], vc[j][1]); w2.y = cvt_pk_bf16(vc[j][2], vc[j][3]); *(u32x2*)(xb + (size_t)r1 * DM + 256 * j + 4 * lane) = w2; }
        }
        sa = wave_sum(sa, lane); sc = wave_sum(sc, lane);
        if (lane == 0) { ssq[r0] = sa; if (has1) ssq[r1] = sc; }
    }
    for (int i = gw * 64 + lane; i < 6 * MT; i += NGW * 64) ssq[MT + i] = 0.f;
    float* rope = (float*)(ws + WS_ROPE);
    for (int i = gw * 64 + lane; i < 2112 * 32; i += NGW * 64) {
        const int pos = i >> 5, j = i & 31;
        const double a = (double)((float)pos * (float)ROPE_INV[j]);
        const double kq = __builtin_rint(a * 0.63661977236758134308);
        const double rr = (a - kq * 1.5707963267948966192) - kq * 6.123233995736766e-17;
        const double r2 = rr * rr;
        const double sn = rr * (1.0 + r2 * (-1.0 / 6 + r2 * (1.0 / 120 + r2 * (-1.0 / 5040 + r2 * (1.0 / 362880 + r2 * (-1.0 / 39916800 + r2 * (1.0 / 6227020800.0)))))));
        const double cn = 1.0 + r2 * (-0.5 + r2 * (1.0 / 24 + r2 * (-1.0 / 720 + r2 * (1.0 / 40320 + r2 * (-1.0 / 3628800 + r2 * (1.0 / 479001600 + r2 * (-1.0 / 87178291200.0)))))));
        const int q = ((int)kq) & 3;
        const double c = q == 0 ? cn : q == 1 ? -sn : q == 2 ? -cn : sn;
        const double s = q == 0 ? sn : q == 1 ? cn : q == 2 ? -sn : -cn;
        rope[(size_t)pos * 64 + j] = (float)c; rope[(size_t)pos * 64 + 32 + j] = (float)s;
    }
    if (gw == 0) {
        unsigned* ctl = (unsigned*)(ws + WS_CTL);
        float* cst = (float*)(ws + WS_CTL + 4096);
        if (lane < 16) ctl[lane] = 0u;
        for (int i = lane; i < XCD_BAR_WORDS; i += 64) ((unsigned*)(ws + WS_BAR))[i] = 0u;
        for (int l = 0; l < 2; ++l) {
            const float mqa = wave_max(fabsf(A->in[12][l * 64 + lane]), lane), mka = wave_max(fabsf(A->in[13][l * 64 + lane]), lane);
            const float mqb = wave_max(fabsf(A->in[14][l * 64 + lane]), lane), mkb = wave_max(fabsf(A->in[15][l * 64 + lane]), lane);
            float mb = 0.f;
            for (int i = lane; i < 8 * 257; i += 64) mb = fmaxf(mb, fabsf(A->in[16][l * 8 * 257 + i]));
            mb = wave_max(mb, lane);
            const float d1 = wave_sum(A->in[17][l * 64 + lane] * A->in[18][l * 64 + lane], lane), d2 = wave_sum(A->in[19][l * 64 + lane] * A->in[20][l * 64 + lane], lane);
            const float lam_init = l == 0 ? 0.2f : 0.35550906759096934f;
            if (lane == 0) {
                cst[l * 8 + 0] = LOG2E * (8.0f * mqa * mka + mb);
                cst[l * 8 + 1] = LOG2E * (8.0f * mqb * mkb);
                cst[l * 8 + 2] = expf(d1) - expf(d2) + lam_init;
                cst[l * 8 + 3] = 1.0f - lam_init;
            }
        }
    }
}

__device__ __forceinline__ int swap23(int r) { return (r & 19) | ((r & 4) << 1) | ((r & 8) >> 1); }
__device__ __forceinline__ f32x16 mfma32(bf16x8 a, bf16x8 b, f32x16 c) { return __builtin_amdgcn_mfma_f32_32x32x16_bf16(a, b, c, 0, 0, 0); }
__device__ __forceinline__ bf16x8 pack8(const f32x16& p, int s) {
    u32x4 w; w.x = cvt_pk_bf16(p[8 * s + 0], p[8 * s + 1]); w.y = cvt_pk_bf16(p[8 * s + 2], p[8 * s + 3]); w.z = cvt_pk_bf16(p[8 * s + 4], p[8 * s + 5]); w.w = cvt_pk_bf16(p[8 * s + 6], p[8 * s + 7]);
    return __builtin_bit_cast(bf16x8, w);
}
constexpr int ATT_BUF = 32768, ATT_WAVE = 65536, ATT_BW = 131072 + 64;

__device__ __forceinline__ void attn_a_block(const bf16_t* Qw, const bf16_t* Kb, const bf16_t* Vtb, int ldv, int T, int t_lo, int t_hi, int t_self, int qoff,
                                             bf16_t* Outw, LAS unsigned char* lds, int wave, int lane_in) {
    int lane = lane_in; asm volatile("" : "+v"(lane));
    const int r32 = lane & 31, hi = lane >> 5;
    const bool active = t_lo <= t_hi;
    const LAS float* E = (const LAS float*)(lds + ATT_WAVE + wave * 8192);
    bf16x8 qf[4];
#pragma unroll
    for (int d0 = 0; d0 < 4; ++d0) qf[d0] = active ? *(const bf16x8*)(Qw + (size_t)r32 * 512 + 16 * d0 + 8 * hi) : (bf16x8){0, 0, 0, 0, 0, 0, 0, 0};
    f32x16 o0, o1;
#pragma unroll
    for (int r = 0; r < 16; ++r) { o0[r] = 0.f; o1[r] = 0.f; }
    float l = 0.f;
    const float cfar = E[192];
    const int key_l = 8 * wave + (lane & 7), c8 = lane >> 3;
    const bf16_t* kg = Kb + (size_t)key_l * 512 + 8 * c8;
    const bf16_t* vg = Vtb + (size_t)key_l * ldv + 8 * c8;
    const int koff = ((key_l >> 5) * 4 + (c8 >> 1)) * 1024 + (swap23(key_l & 31) + 32 * (c8 & 1)) * 16;
    const int voff = 8192 + (((c8 >> 2) * 2 + (key_l >> 5)) * 2 + ((c8 >> 1) & 1)) * 1024 + ((key_l & 31) + 32 * (c8 & 1)) * 16;
    constexpr int ABUF = 16384;
    u32x4 skA = *(const u32x4*)kg, svA = *(const u32x4*)vg, skB = skA, svB = svA;
    if (T > 1) { skB = *(const u32x4*)(kg + (size_t)64 * 512); svB = *(const u32x4*)(vg + 64); }
    *(LAS u32x4*)(lds + koff) = skA; *(LAS u32x4*)(lds + voff) = svA;
    __syncthreads();
    int cb = 0;
#define A_STEP(t, LK, LV, WK, WV) do { \
        if ((t) + 2 < T) { LK = *(const u32x4*)(kg + (size_t)((t) + 2) * 64 * 512); LV = *(const u32x4*)(vg + ((t) + 2) * 64); } \
        if ((t) >= t_lo && (t) <= t_hi) { \
            const LAS bf16x8* KF = (const LAS bf16x8*)(lds + cb * ABUF); \
            const LAS bf16x8* VF = KF + 512; \
            _Pragma("unroll") for (int j = 0; j < 2; ++j) { \
                f32x16 sa; \
                const int relbase = 64 * (t_self - (t)) - 32 * j + qoff; \
                if (relbase - 31 >= 128) { _Pragma("unroll") for (int r = 0; r < 16; ++r) sa[r] = cfar; } \
                else { const int bi = relbase + 64 + r32 - 8 * hi - 23; _Pragma("unroll") for (int r = 0; r < 16; ++r) sa[r] = E[bi + 23 - (r & 7) - 16 * (r >> 3)]; } \
                _Pragma("unroll") for (int d0 = 0; d0 < 4; ++d0) sa = mfma32(KF[(j * 4 + d0) * 64 + lane], qf[d0], sa); \
                float ps = 0.f; \
                _Pragma("unroll") for (int r = 0; r < 16; ++r) { sa[r] = fast_exp2(sa[r]); ps += sa[r]; } \
                l += ps; \
                const bf16x8 p0 = pack8(sa, 0), p1 = pack8(sa, 1); \
                o0 = mfma32(VF[((j * 2 + 0) * 2 + 0) * 64 + lane], p0, o0); o0 = mfma32(VF[((j * 2 + 0) * 2 + 1) * 64 + lane], p1, o0); \
                o1 = mfma32(VF[((j * 2 + 1) * 2 + 0) * 64 + lane], p0, o1); o1 = mfma32(VF[((j * 2 + 1) * 2 + 1) * 64 + lane], p1, o1); \
            } \
        } \
        const int nb = cb == 2 ? 0 : cb + 1; \
        if ((t) + 1 < T) { *(LAS u32x4*)(lds + nb * ABUF + koff) = WK; *(LAS u32x4*)(lds + nb * ABUF + voff) = WV; } \
        cb = nb; \
        __syncthreads(); \
    } while (0)
    for (int t = 0; t < T; t += 2) {
        A_STEP(t, skA, svA, skB, svB);
        if (t + 1 < T) A_STEP(t + 1, skB, svB, skA, svA);
    }
#undef A_STEP
    if (active) {
        const int le = lane_id_fresh(), r32e = le & 31, hie = le >> 5;
        l += shx(l, le, 32);
        const float inv = 1.0f / l;
#pragma unroll
        for (int g = 0; g < 4; ++g) {
            u32x2 w0, w1;
            w0.x = cvt_pk_bf16(o0[4 * g] * inv, o0[4 * g + 1] * inv); w0.y = cvt_pk_bf16(o0[4 * g + 2] * inv, o0[4 * g + 3] * inv);
            w1.x = cvt_pk_bf16(o1[4 * g] * inv, o1[4 * g + 1] * inv); w1.y = cvt_pk_bf16(o1[4 * g + 2] * inv, o1[4 * g + 3] * inv);
            *(u32x2*)(Outw + (size_t)r32e * DM + 8 * g + 4 * hie) = w0;
            *(u32x2*)(Outw + (size_t)r32e * DM + 32 + 8 * g + 4 * hie) = w1;
        }
    }
}
__device__ __forceinline__ void attn_b_block(const bf16_t* Qw, const bf16_t* Kb, const bf16_t* Vtb, int ldv, int T, int tlim, float nshift, float lam, float post, const float* gsub,
                                             bf16_t* Outw, LAS unsigned char* lds, int wave, int lane_in) {
    int lane = lane_in; asm volatile("" : "+v"(lane));
    const int r32 = lane & 31, hi = lane >> 5;
    LAS bf16x8* Qs = (LAS bf16x8*)(lds + ATT_WAVE + wave * 8192);
    if (tlim > 0) {
#pragma unroll
        for (int m = 0; m < 2; ++m)
#pragma unroll
            for (int d0 = 0; d0 < 4; ++d0) Qs[(m * 4 + d0) * 64 + lane] = *(const bf16x8*)(Qw + (size_t)r32 * 512 + 64 * m + 16 * d0 + 8 * hi);
    }
    f32x16 o1[4], o2[4];
#pragma unroll
    for (int db = 0; db < 4; ++db)
#pragma unroll
        for (int r = 0; r < 16; ++r) { o1[db][r] = 0.f; o2[db][r] = 0.f; }
    float l1 = 0.f, l2 = 0.f;
    const int key_l = 8 * wave + (lane & 7), c8 = lane >> 3;
    const bf16_t* kg = Kb + (size_t)key_l * 512 + 8 * c8;
    const int koff = ((key_l >> 5) * 8 + (c8 >> 1)) * 1024 + (swap23(key_l & 31) + 32 * (c8 & 1)) * 16;
    const int d_l = 16 * wave + (lane & 7);
    const bf16_t* vg = Vtb + (size_t)d_l * ldv + 8 * c8;
    const int voff = 16384 + (((c8 >> 2) * 4 + (d_l >> 5)) * 2 + ((c8 >> 1) & 1)) * 1024 + ((d_l & 31) + 32 * (c8 & 1)) * 16;
    u32x4 sk0 = *(const u32x4*)kg, sk1 = *(const u32x4*)(kg + 64), sv0 = *(const u32x4*)vg, sv1 = *(const u32x4*)(vg + (size_t)8 * ldv);
    *(LAS u32x4*)(lds + koff) = sk0; *(LAS u32x4*)(lds + koff + 4096) = sk1; *(LAS u32x4*)(lds + voff) = sv0; *(LAS u32x4*)(lds + voff + 128) = sv1;
    __syncthreads();
    for (int t = 0; t < T; ++t) {
        const bool more = t + 1 < T;
        if (more) {
            const bf16_t* kn = kg + (size_t)(t + 1) * 64 * 512; const bf16_t* vn = vg + (t + 1) * 64;
            sk0 = *(const u32x4*)kn; sk1 = *(const u32x4*)(kn + 64); sv0 = *(const u32x4*)vn; sv1 = *(const u32x4*)(vn + (size_t)8 * ldv);
        }
        if (t < tlim) {
            const LAS bf16x8* KF = (const LAS bf16x8*)(lds + (t & 1) * ATT_BUF);
            const LAS bf16x8* VF = KF + 1024;
#pragma unroll
            for (int j = 0; j < 2; ++j) {
                bf16x8 pa[2], pb[2];
                {
                    f32x16 sa;
#pragma unroll
                    for (int r = 0; r < 16; ++r) sa[r] = nshift;
#pragma unroll
                    for (int d0 = 0; d0 < 4; ++d0) sa = mfma32(KF[((j * 2 + 0) * 4 + d0) * 64 + lane], Qs[d0 * 64 + lane], sa);
                    float ps = 0.f;
#pragma unroll
                    for (int r = 0; r < 16; ++r) { sa[r] = fast_exp2(sa[r]); ps += sa[r]; }
                    l1 += ps; pa[0] = pack8(sa, 0); pa[1] = pack8(sa, 1);
                }
                {
                    f32x16 sa;
#pragma unroll
                    for (int r = 0; r < 16; ++r) sa[r] = nshift;
#pragma unroll
                    for (int d0 = 0; d0 < 4; ++d0) sa = mfma32(KF[((j * 2 + 1) * 4 + d0) * 64 + lane], Qs[(4 + d0) * 64 + lane], sa);
                    float ps = 0.f;
#pragma unroll
                    for (int r = 0; r < 16; ++r) { sa[r] = fast_exp2(sa[r]); ps += sa[r]; }
                    l2 += ps; pb[0] = pack8(sa, 0); pb[1] = pack8(sa, 1);
                }
#pragma unroll
                for (int db = 0; db < 4; ++db)
#pragma unroll
                    for (int s = 0; s < 2; ++s) {
                        const bf16x8 vf = VF[((j * 4 + db) * 2 + s) * 64 + lane];
                        o1[db] = mfma32(vf, pa[s], o1[db]); o2[db] = mfma32(vf, pb[s], o2[db]);
                    }
            }
        }
        if (more) {
            LAS unsigned char* nb = lds + ((t + 1) & 1) * ATT_BUF;
            *(LAS u32x4*)(nb + koff) = sk0; *(LAS u32x4*)(nb + koff + 4096) = sk1; *(LAS u32x4*)(nb + voff) = sv0; *(LAS u32x4*)(nb + voff + 128) = sv1;
        }
        __syncthreads();
    }
    if (tlim > 0) {
        const int le = lane_id_fresh(), r32e = le & 31, hie = le >> 5;
        l1 += shx(l1, le, 32); l2 += shx(l2, le, 32);
        const float i1 = 1.0f / l1, i2 = lam / l2;
        float ss = 0.f;
#pragma unroll
        for (int db = 0; db < 4; ++db)
#pragma unroll
            for (int r = 0; r < 16; ++r) { const float v = o1[db][r] * i1 - o2[db][r] * i2; o1[db][r] = v; ss += v * v; }
        ss += shx(ss, le, 32);
        const float rr = rsqrtf(ss * (1.0f / 128.0f) + EPS) * post;
#pragma unroll
        for (int db = 0; db < 4; ++db)
#pragma unroll
            for (int g = 0; g < 4; ++g) {
                const int d = 32 * db + 8 * g + 4 * hie;
                const f32x4 gs = *(const f32x4*)(gsub + d);
                u32x2 w; w.x = cvt_pk_bf16(o1[db][4 * g] * rr * gs[0], o1[db][4 * g + 1] * rr * gs[1]); w.y = cvt_pk_bf16(o1[db][4 * g + 2] * rr * gs[2], o1[db][4 * g + 3] * rr * gs[3]);
                *(u32x2*)(Outw + (size_t)r32e * DM + d) = w;
            }
    }
}
__device__ __forceinline__ void attn_bs_block(KArgP A, int l, int b, int h, float nshift, float lam, float post, const float* gsub, LAS unsigned char* lds, int wave, int lane_in) {
    int lane = lane_in; asm volatile("" : "+v"(lane));
    unsigned char* ws = A->ws;
    const int lb = l * 32 + b;
    constexpr int T = 33;
    const float* ck = A->in[4] + (size_t)lb * 2048 * 512 + h * 128;
    const float* cv = A->in[5] + (size_t)lb * 2048 * 512 + h * 128;
    const bf16_t* nk = (const bf16_t*)(ws + WS_KSB) + ((size_t)lb * KSB_ROWS + 2048) * 512 + h * 128;
    const bf16_t* nv = (const bf16_t*)(ws + WS_VSB) + ((size_t)lb * 512 + h * 128) * KSB_ROWS + 2048;
    const int li = (wave - 2) * 64 + lane;
#define BS_FILL(t) do { \
        LAS unsigned char* fb = lds + ((t) & 1) * ATT_BUF; \
        if ((t) < 32) { \
            _Pragma("unroll") for (int i = 0; i < 3; ++i) { const int ci = li + 384 * i; \
                if (ci < 1024) { const int key = ci >> 4, c16 = ci & 15, c8 = c16 & 7; \
                    const float* src = ck + (size_t)(64 * (t) + key) * 512 + 8 * c16; \
                    const f32x4 a = *(const f32x4*)src, c = *(const f32x4*)(src + 4); \
                    u32x4 w; w.x = cvt_pk_bf16(a[0], a[1]); w.y = cvt_pk_bf16(a[2], a[3]); w.z = cvt_pk_bf16(c[0], c[1]); w.w = cvt_pk_bf16(c[2], c[3]); \
                    *(LAS u32x4*)(fb + ((key >> 5) * 8 + (c16 >> 3) * 4 + (c8 >> 1)) * 1024 + (swap23(key & 31) + 32 * (c8 & 1)) * 16) = w; } } \
            if (li < 256) { const int g = li >> 5, d4 = li & 31; \
                f32x4 r[8]; \
                _Pragma("unroll") for (int kk = 0; kk < 8; ++kk) r[kk] = *(const f32x4*)(cv + (size_t)(64 * (t) + 8 * g + kk) * 512 + 4 * d4); \
                _Pragma("unroll") for (int i = 0; i < 4; ++i) { const int d = 4 * d4 + i; \
                    u32x4 w; w.x = cvt_pk_bf16(r[0][i], r[1][i]); w.y = cvt_pk_bf16(r[2][i], r[3][i]); w.z = cvt_pk_bf16(r[4][i], r[5][i]); w.w = cvt_pk_bf16(r[6][i], r[7][i]); \
                    *(LAS u32x4*)(fb + 16384 + (((g >> 2) * 4 + (d >> 5)) * 2 + ((g >> 1) & 1)) * 1024 + ((d & 31) + 32 * (g & 1)) * 16) = w; } } \
        } else { \
            _Pragma("unroll") for (int i = 0; i < 3; ++i) { const int ci = li + 384 * i; \
                if (ci < 1024) { const int key = ci >> 4, c16 = ci & 15, c8 = c16 & 7; \
                    const u32x4 w = *(const u32x4*)(nk + (size_t)key * 512 + 8 * c16); \
                    *(LAS u32x4*)(fb + ((key >> 5) * 8 + (c16 >> 3) * 4 + (c8 >> 1)) * 1024 + (swap23(key & 31) + 32 * (c8 & 1)) * 16) = w; \
                    const int d = ci >> 3, g = ci & 7; \
                    const u32x4 v = *(const u32x4*)(nv + (size_t)d * KSB_ROWS + 8 * g); \
                    *(LAS u32x4*)(fb + 16384 + (((g >> 2) * 4 + (d >> 5)) * 2 + ((g >> 1) & 1)) * 1024 + ((d & 31) + 32 * (g & 1)) * 16) = v; } } \
        } \
    } while (0)
    if (wave >= 2) {
        BS_FILL(0);
        __syncthreads();
        for (int t = 0; t < T; ++t) {
            if (t + 1 < T) BS_FILL(t + 1);
            __syncthreads();
        }
    } else {
        const int r32 = lane & 31, hi = lane >> 5;
        const int row0 = MP + b * 64 + 32 * wave;
        const bf16_t* Qw = (const bf16_t*)(ws + WS_QB) + (size_t)row0 * 512 + h * 128;
        LAS bf16x8* Qs = (LAS bf16x8*)(lds + ATT_WAVE + wave * 8192);
#pragma unroll
        for (int m = 0; m < 2; ++m)
#pragma unroll
            for (int d0 = 0; d0 < 4; ++d0) Qs[(m * 4 + d0) * 64 + lane] = *(const bf16x8*)(Qw + (size_t)r32 * 512 + 64 * m + 16 * d0 + 8 * hi);
        f32x16 o1[4], o2[4];
#pragma unroll
        for (int db = 0; db < 4; ++db)
#pragma unroll
            for (int r = 0; r < 16; ++r) { o1[db][r] = 0.f; o2[db][r] = 0.f; }
        float l1 = 0.f, l2 = 0.f;
        __syncthreads();
        for (int t = 0; t < T; ++t) {
            const LAS bf16x8* KF = (const LAS bf16x8*)(lds + (t & 1) * ATT_BUF);
            const LAS bf16x8* VF = KF + 1024;
#pragma unroll
            for (int j = 0; j < 2; ++j) {
                bf16x8 pa[2], pb[2];
                {
                    f32x16 sa;
#pragma unroll
                    for (int r = 0; r < 16; ++r) sa[r] = nshift;
#pragma unroll
                    for (int d0 = 0; d0 < 4; ++d0) sa = mfma32(KF[((j * 2 + 0) * 4 + d0) * 64 + lane], Qs[d0 * 64 + lane], sa);
                    float ps = 0.f;
#pragma unroll
                    for (int r = 0; r < 16; ++r) { sa[r] = fast_exp2(sa[r]); ps += sa[r]; }
                    l1 += ps; pa[0] = pack8(sa, 0); pa[1] = pack8(sa, 1);
                }
                {
                    f32x16 sa;
#pragma unroll
                    for (int r = 0; r < 16; ++r) sa[r] = nshift;
#pragma unroll
                    for (int d0 = 0; d0 < 4; ++d0) sa = mfma32(KF[((j * 2 + 1) * 4 + d0) * 64 + lane], Qs[(4 + d0) * 64 + lane], sa);
                    float ps = 0.f;
#pragma unroll
                    for (int r = 0; r < 16; ++r) { sa[r] = fast_exp2(sa[r]); ps += sa[r]; }
                    l2 += ps; pb[0] = pack8(sa, 0); pb[1] = pack8(sa, 1);
                }
#pragma unroll
                for (int db = 0; db < 4; ++db)
#pragma unroll
                    for (int s = 0; s < 2; ++s) {
                        const bf16x8 vf = VF[((j * 4 + db) * 2 + s) * 64 + lane];
                        o1[db] = mfma32(vf, pa[s], o1[db]); o2[db] = mfma32(vf, pb[s], o2[db]);
                    }
            }
            __syncthreads();
        }
        const int le = lane_id_fresh(), r32e = le & 31, hie = le >> 5;
        l1 += shx(l1, le, 32); l2 += shx(l2, le, 32);
        const float i1 = 1.0f / l1, i2 = lam / l2;
        float ss = 0.f;
#pragma unroll
        for (int db = 0; db < 4; ++db)
#pragma unroll
            for (int r = 0; r < 16; ++r) { const float v = o1[db][r] * i1 - o2[db][r] * i2; o1[db][r] = v; ss += v * v; }
        ss += shx(ss, le, 32);
        const float rr = rsqrtf(ss * (1.0f / 128.0f) + EPS) * post;
        bf16_t* Outw = (bf16_t*)(ws + WS_O) + (size_t)row0 * DM + 512 + h * 128;
#pragma unroll
        for (int db = 0; db < 4; ++db)
#pragma unroll
            for (int g = 0; g < 4; ++g) {
                const int d = 32 * db + 8 * g + 4 * hie;
                const f32x4 gs = *(const f32x4*)(gsub + d);
                u32x2 w; w.x = cvt_pk_bf16(o1[db][4 * g] * rr * gs[0], o1[db][4 * g + 1] * rr * gs[1]); w.y = cvt_pk_bf16(o1[db][4 * g + 2] * rr * gs[2], o1[db][4 * g + 3] * rr * gs[3]);
                *(u32x2*)(Outw + (size_t)r32e * DM + d) = w;
            }
    }
#undef BS_FILL
}
constexpr int U_BS = 128, U_BP = 512, U_AP = 1024, U_AS = 256, U_B = U_BS + U_BP, U_ALL = U_B + U_AP + U_AS;
__device__ __forceinline__ void attn_phase(KArgP A, int l, LAS unsigned char* lds, int wave, int cidx) {
    unsigned char* ws = A->ws;
    unsigned* ctr = (unsigned*)(ws + WS_CTL) + cidx;
    const float* cst = (const float*)(ws + WS_CTL + 4096) + l * 8;
#define SGPR_F(x) __builtin_bit_cast(float, __builtin_amdgcn_readfirstlane(__builtin_bit_cast(int, (x))))
    const float shA = SGPR_F(cst[0]), shB = SGPR_F(cst[1]), lam = SGPR_F(cst[2]), post = SGPR_F(cst[3]);
#undef SGPR_F
    volatile LAS int* bw = (volatile LAS int*)(lds + ATT_BW);
    const bf16_t* QA = (const bf16_t*)(ws + WS_QA); const bf16_t* QB = (const bf16_t*)(ws + WS_QB);
    bf16_t* O = (bf16_t*)(ws + WS_O);
    const float* bias = A->in[16] + (size_t)l * 8 * 257;
    const float* gsub = A->in[21] + l * 128;
    for (;;) {
        int lane_l = lane_id_fresh(); asm volatile("" : "+v"(lane_l)); const int lane = lane_l;
        __syncthreads();
        if (wave == 0 && lane == 0) bw[0] = (int)atomicAdd(ctr, 1u);
        __syncthreads();
        const int uid = __builtin_amdgcn_readfirstlane(bw[0]);
        if (uid >= U_ALL) break;
        if (uid < U_BS) {
            attn_bs_block(A, l, uid >> 2, uid & 3, -shB, lam, post, gsub, lds, wave, lane);
        } else if (uid < U_B) {
            int b, h, T, tlim, row0, ldv; const bf16_t* K; const bf16_t* Vt;
            if (uid < U_BS) { b = uid >> 2; h = uid & 3; T = 33; tlim = wave < 2 ? 33 : 0; row0 = MP + b * 64 + 32 * (wave & 1); ldv = KSB_ROWS;
                K = (const bf16_t*)(ws + WS_KSB) + (size_t)(l * 32 + b) * KSB_ROWS * 512 + h * 128;
                Vt = (const bf16_t*)(ws + WS_VSB) + ((size_t)(l * 32 + b) * 512 + h * 128) * KSB_ROWS; }
            else { const int v = uid - U_BS, qb = 7 - (v >> 6), w = v & 63; b = w >> 2; h = w & 3; T = 4 * qb + 4; tlim = 4 * qb + (wave >> 1) + 1; row0 = b * 2048 + 256 * qb + 32 * wave; ldv = 2048;
                K = (const bf16_t*)(ws + WS_KBP) + (size_t)b * 2048 * 512 + h * 128;
                Vt = (const bf16_t*)(ws + WS_VBP) + ((size_t)b * 512 + h * 128) * 2048; }
            attn_b_block(QB + (size_t)row0 * 512 + h * 128, K, Vt, ldv, T, tlim, -shB, lam, post, gsub, O + (size_t)row0 * DM + 512 + h * 128, lds, wave, lane);
        } else {
            int b, h, T, t_lo, t_hi, t_self, row0, ldv; const bf16_t* K; const bf16_t* Vt;
            if (uid < U_B + U_AP) { const int v = uid - U_B, cq = 7 - (v >> 7), w = v & 127; b = w >> 3; h = w & 7;
                const int kc0 = cq >= 2 ? 4 * cq - 8 : 0, cw = 4 * cq + (wave >> 1);
                T = 4 * cq + 4 - kc0; t_self = cw - kc0; t_hi = t_self; t_lo = cw - 8 - kc0 > 0 ? cw - 8 - kc0 : 0; row0 = b * 2048 + 256 * cq + 32 * wave; ldv = 2048;
                K = (const bf16_t*)(ws + WS_KAP) + ((size_t)b * 2048 + 64 * kc0) * 512 + h * 64;
                Vt = (const bf16_t*)(ws + WS_VAP) + ((size_t)b * 512 + h * 64) * 2048 + 64 * kc0; }
            else { const int v = uid - U_B - U_AP; b = v >> 3; h = v & 7; T = 9; t_self = 8; t_lo = wave < 2 ? 0 : 1; t_hi = wave < 2 ? 8 : 0; row0 = MP + b * 64 + 32 * (wave & 1); ldv = KSA_ROWS;
                K = (const bf16_t*)(ws + WS_KSA) + (size_t)(l * 32 + b) * KSA_ROWS * 512 + h * 64;
                Vt = (const bf16_t*)(ws + WS_VSA) + ((size_t)(l * 32 + b) * 512 + h * 64) * KSA_ROWS; }
            LAS float* E = (LAS float*)(lds + ATT_WAVE + wave * 8192);
#pragma unroll
            for (int j = 0; j < 5; ++j) { const int i = lane + 64 * j; int rel = i - 64; rel = rel < -128 ? -128 : (rel > 128 ? 128 : rel); E[i] = LOG2E * bias[h * 257 + rel + 128] - shA; }
            attn_a_block(QA + (size_t)row0 * 512 + h * 64, K, Vt, ldv, T, t_lo, t_hi, t_self, 32 * (wave & 1), O + (size_t)row0 * DM + h * 64, lds, wave, lane);
        }
    }
}

__device__ __forceinline__ bool in_phase(int p) { KArgP k = (KArgP)__builtin_amdgcn_kernarg_segment_ptr(); asm volatile("" : "+s"(k)); return k->ph_lo <= p && p < k->ph_hi; }
__global__ void __launch_bounds__(512, 2) mega_fwd(Args KA) {
    extern __shared__ __attribute__((aligned(16))) unsigned char lds_raw[];
    LAS unsigned char* lds = (LAS unsigned char*)lds_raw;
    const int tid = threadIdx.x, wave = __builtin_amdgcn_readfirstlane(tid >> 6);
    const int G = gridDim.x, bx = blockIdx.x;
    const int vcu = (G % 8 == 0) ? (bx % 8) * (G / 8) + bx / 8 : bx;
    (void)KA;
    if (tid == 0) { ((volatile LAS unsigned*)(lds + ATT_BW + 64))[0] = 0u; ((volatile LAS unsigned*)(lds + ATT_BW + 64))[1] = 0u; ((volatile LAS unsigned*)(lds + ATT_BW + 64))[2] = (unsigned)bx; }
    __syncthreads();
#define FRESH_KAP(name) KArgP name = (KArgP)__builtin_amdgcn_kernarg_segment_ptr(); asm volatile("" : "+s"(name))
#define IN_PH(p) in_phase(p)
#define SEAM(p) do { FRESH_KAP(ks_); if (ks_->coop && (p) + 1 < ks_->ph_hi) { XcdBarrier xb_; xb_.bar = (unsigned*)(ks_->ws + WS_BAR); xb_.x = xb_xcc_id(); xb_.st = (volatile LAS unsigned*)(lds + ATT_BW + 64); xcd_barrier(xb_); } } while (0)
#define KARGS() KArgP kap = (KArgP)__builtin_amdgcn_kernarg_segment_ptr(); asm volatile("" : "+s"(kap)); unsigned char* ws = kap->ws; float* out = kap->out; \
    float* ssq = (float*)(ws + WS_SSQ); bf16_t* xb = (bf16_t*)(ws + WS_XB); bf16_t* ab = (bf16_t*)(ws + WS_A); unsigned char* wl = ws + WS_W + (size_t)l * W_LAYER; (void)ssq; (void)xb; (void)ab; (void)wl; (void)out; \
    const int cx = __builtin_amdgcn_readfirstlane((int)((volatile LAS unsigned*)(lds + ATT_BW + 64))[2])
    if (IN_PH(0)) {
        KArgP kap = (KArgP)__builtin_amdgcn_kernarg_segment_ptr(); asm volatile("" : "+s"(kap));
        prologue(kap, lds, vcu * 8 + wave, G * 8, wave);
#ifdef PROBE_PRO2
        prologue(kap, lds, vcu * 8 + wave, G * 8, wave);
#endif
        { FRESH_KAP(ks_); if (ks_->coop && 1 < ks_->ph_hi) { cg::this_grid().sync();
            if (tid == 0) { unsigned* bar_ = (unsigned*)(ks_->ws + WS_BAR); const unsigned x_ = xb_xcc_id(); const unsigned r_ = xb_add(&bar_[XB_XCNT(x_)], 1u);
                if (G == 256 && r_ < 32u && x_ < 8u) ((volatile LAS unsigned*)(lds + ATT_BW + 64))[2] = r_ * 8u + x_; }
            __syncthreads(); } }
    }
#pragma unroll 1
    for (int l = 0; l < 2; ++l) {
        const int p0 = 1 + 7 * l;
        if (IN_PH(p0 + 0)) {
            KARGS();
            pg8::Gemm g{xb, (const bf16_t*)(wl + W_GU1), MT, 2 * DFF, DM, DM, 0};
            pg8::StaticOrder S; S.init(MT, 2 * DFF, G, cx);
            EpiSwiGLU E{ab, ssq + (size_t)(3 * l) * MT};
            pg8::gemm_phase<EpiSwiGLU, pg8::StaticOrder, true, true>(lds, g, S, E, wave);
#ifdef PROBE_UP2
            pg8::gemm_phase<EpiSwiGLU, pg8::StaticOrder, true, true>(lds, g, S, E, wave);
#endif
            SEAM(p0 + 0);
        }
        if (IN_PH(p0 + 1)) {
            KARGS();
            pg8::Gemm g{ab, (const bf16_t*)(wl + W_D1), MT, DM, DFF, LDP, 2};
            pg8::TailSplitOrder S; S.init(MT, DM, G, cx, 0, DOWN_WGM);
            EpiResid E{kap->in[0], kap->in[1], out, xb, ssq + (size_t)(3 * l + 1) * MT, 0.5f, l == 0 ? 0 : 1, 0};
            pg8::gemm_phase<EpiResid, pg8::TailSplitOrder, true, true>(lds, g, S, E, wave);
            SEAM(p0 + 1);
        }
        if (IN_PH(p0 + 2)) {
            {
                KARGS();
                pg8::Gemm g{xb, (const bf16_t*)(wl + W_IN), MT, 2048, DM, DM, 0};
                pg8::TailSplitOrder S; S.init(MT, 2048, G, cx);
                EpiQK E{ssq + (size_t)(3 * l + 1) * MT, ws, out, kap, l};
                pg8::gemm_phase<EpiQK, pg8::TailSplitOrder, true, true>(lds, g, S, E, wave);
#ifdef PROBE_QK2
                pg8::gemm_phase<EpiQK, pg8::TailSplitOrder, true, true>(lds, g, S, E, wave);
#endif
            }
            {
                KARGS();
                pg8::Gemm g{(const bf16_t*)(wl + W_IN) + (size_t)2048 * DM, xb, 1024, MT, DM, DM, 0};
                pg8::TailSplitOrder S; S.init(1024, MT, G, cx);
                EpiVt E{ssq + (size_t)(3 * l + 1) * MT, ws, out, l};
                pg8::gemm_phase<EpiVt, pg8::TailSplitOrder, true, true>(lds, g, S, E, wave);
#ifdef PROBE_VT2
                pg8::gemm_phase<EpiVt, pg8::TailSplitOrder, true, true>(lds, g, S, E, wave);
#endif
            }
            SEAM(p0 + 2);
        }
        if (IN_PH(p0 + 3)) {
            KArgP kap = (KArgP)__builtin_amdgcn_kernarg_segment_ptr(); asm volatile("" : "+s"(kap));
            attn_phase(kap, l, lds, wave, l);
#ifdef PROBE_ATTN2
            attn_phase(kap, l, lds, wave, 2 + l);
#endif
            SEAM(p0 + 3);
        }
        if (IN_PH(p0 + 4)) {
            KARGS();
            pg8::Gemm g{(const bf16_t*)(ws + WS_O), (const bf16_t*)(wl + W_OUT), MT, DM, DM, DM, 0};
            pg8::TailSplitOrder S; S.init(MT, DM, G, cx);
            EpiResid E{out, out + (size_t)MP * DM, out, xb, ssq + (size_t)(3 * l + 2) * MT, 1.0f, 1, 0};
            pg8::gemm_phase<EpiResid, pg8::TailSplitOrder, true, true>(lds, g, S, E, wave);
            SEAM(p0 + 4);
        }
        if (IN_PH(p0 + 5)) {
            KARGS();
            pg8::Gemm g{xb, (const bf16_t*)(wl + W_GU2), MT, 2 * DFF, DM, DM, 0};
            pg8::StaticOrder S; S.init(MT, 2 * DFF, G, cx);
            EpiSwiGLU E{ab, ssq + (size_t)(3 * l + 2) * MT};
            pg8::gemm_phase<EpiSwiGLU, pg8::StaticOrder, true, true>(lds, g, S, E, wave);
            SEAM(p0 + 5);
        }
        if (IN_PH(p0 + 6)) {
            KARGS();
            pg8::Gemm g{ab, (const bf16_t*)(wl + W_D2), MT, DM, DFF, LDP, 2};
            pg8::TailSplitOrder S; S.init(MT, DM, G, cx, 0, DOWN_WGM);
            EpiResid E{out, out + (size_t)MP * DM, out, xb, ssq + (size_t)(3 * l + 3) * MT, 0.5f, 1, l == 1 ? 1 : 0};
            pg8::gemm_phase<EpiResid, pg8::TailSplitOrder, true, true>(lds, g, S, E, wave);
            SEAM(p0 + 6);
        }
    }
}

#ifndef N_LAUNCH_MODE_GUARD_
#define N_LAUNCH_MODE_GUARD_
#endif
#ifndef N_LAUNCH_MODE
#define N_LAUNCH_MODE 0
#endif
extern "C" void kernel_launch(void* const* d_in, const int* in_sizes, int n_in, void* d_out, int out_size, void* d_ws, size_t ws_size, hipStream_t stream) {
    static int grid = 0;
    if (grid == 0) {
        if (n_in != 27 || ws_size < WS_END) { fprintf(stderr, "kernel_launch: unexpected inputs (n_in %d, ws %zu)\n", n_in, ws_size); grid = -1; return; }
        int dev = 0, cus = 0, per_cu = 0;
        hipGetDevice(&dev);
        hipDeviceGetAttribute(&cus, hipDeviceAttributeMultiprocessorCount, dev);
        hipFuncSetAttribute((const void*)mega_fwd, hipFuncAttributeMaxDynamicSharedMemorySize, LDS_BYTES);
        hipOccupancyMaxActiveBlocksPerMultiprocessor(&per_cu, (const void*)mega_fwd, 512, LDS_BYTES);
        (void)hipGetLastError();
        if (per_cu < 1) per_cu = 1;
        grid = cus;
        if (grid != 256) fprintf(stderr, "kernel_launch: note: %d CUs\n", grid);
    }
    if (grid < 0) return;
    Args a{};
    for (int i = 0; i < 27; ++i) a.in[i] = (const float*)d_in[i];
    a.out = (float*)d_out; a.ws = (unsigned char*)d_ws;
#if N_LAUNCH_MODE == 1
    for (int ph = 0; ph < NPHASE; ++ph) {
        a.ph_lo = ph; a.ph_hi = ph + 1; a.coop = 0;
        hipLaunchKernelGGL(mega_fwd, dim3(grid), dim3(512), LDS_BYTES, stream, a);
    }
#else
    a.ph_lo = 0; a.ph_hi = NPHASE; a.coop = 1;
    void* args[] = {&a};
    hipError_t e = hipLaunchCooperativeKernel((const void*)mega_fwd, dim3(grid), dim3(512), args, LDS_BYTES, stream);
    if (e != hipSuccess) fprintf(stderr, "cooperative launch failed: %s (grid %d)\n", hipGetErrorString(e), grid);
#endif
}
```

```cpp
#include <hip/hip_runtime.h>
#include <hip/hip_cooperative_groups.h>
#include <cstdio>
#include <cstdint>
#include <cstddef>
namespace cg = cooperative_groups;
__device__ __forceinline__ int lane_id_fresh() { int l; asm volatile("v_mbcnt_lo_u32_b32 %0, -1, 0\n\tv_mbcnt_hi_u32_b32 %0, -1, %0" : "=v"(l)); return l; }
#ifndef PG8_PFD
#define PG8_PFD 4
#endif
namespace pg8 {
#define PG8_LAS __attribute__((address_space(3)))
typedef unsigned short bf16_t;
typedef short bf16x8 __attribute__((ext_vector_type(8)));
typedef float f32x4 __attribute__((ext_vector_type(4)));
typedef unsigned u32x4 __attribute__((ext_vector_type(4)));
constexpr int BM = 256, BK = 64, HALF = 128, HTB = HALF * BK * 2  , STAGE_BYTES = 8 * HTB, NXCD = 8, WGM = 8;

__host__ __device__ __forceinline__ int lds_byte(int r, int c) { const int st = (r >> 4) * 2 + (c >> 5), rr = r & 15, cc = c & 31, ob = rr * 64 + cc * 2; return st * 1024 + (ob ^ (((ob >> 9) & 1) << 5)); }
__host__ __device__ __forceinline__ void stage_rc(int b, int& R, int& C) { const int st = b / 1024, sb = b % 1024, swz = sb ^ (((sb >> 9) & 1) << 5); R = (st >> 1) * 16 + swz / 64; C = (st & 1) * 32 + (swz % 64) / 2; }
__host__ __device__ __forceinline__ int perm32(int rho) { const int n = rho >> 4, i = rho & 15; return 8 * (i >> 2) + 4 * n + (i & 3); }

struct Unit { int pm, pn, hm; };
struct Gemm { const bf16_t* A; const bf16_t* Bt; int M, N, K, ld; int blocked; };

struct StaticOrder {
    int nM, nN, nwg, G, c, rev, wgm;
    __host__ __device__ void init(int M, int N, int G_, int c_, int rev_ = 0, int wgm_ = WGM) { nM = M / BM; nN = N / BM; nwg = nM * nN; G = G_; c = c_; rev = rev_; wgm = wgm_; }
    __host__ __device__ __forceinline__ void tile(int wgid, Unit& u) const {
        { const int q = nwg / NXCD, r = nwg % NXCD, xcd = wgid % NXCD, off = wgid / NXCD; wgid = (xcd < r ? xcd * (q + 1) : r * (q + 1) + (xcd - r) * q) + off; }
        const int nig = wgm * nN, gid = wgid / nig, fm = gid * wgm, gsz = (nM - fm) < wgm ? (nM - fm) : wgm;
        u.pm = fm + ((wgid % nig) % gsz); u.pn = (wgid % nig) / gsz; u.hm = 3;
        if (rev) u.pm = nM - 1 - u.pm;
    }
    __host__ __device__ bool next(int i, Unit& u) const {
        const long L = (long)i * G + c; if (L >= nwg) return false;
        tile((int)L, u); return true;
    }
    __device__ __forceinline__ void a_ready(const Unit&) const {}
    __device__ __forceinline__ void done(const Unit&) const {}
};
struct TailSplitOrder : StaticOrder {
    __host__ __device__ bool next(int i, Unit& u) const {
        const int nfull = (nwg / G) * G, L = i * G + c;
        if (L < nfull) { tile(L, u); return true; }
        const int idx = L - nfull;
        if (idx >= 2 * (nwg - nfull)) return false;
        tile(nfull + (idx >> 1), u); u.hm = 1 << (idx & 1); return true;
    }
};

__device__ __forceinline__ unsigned cvt_pk_bf16(float lo, float hi) { unsigned r; asm volatile("v_cvt_pk_bf16_f32 %0, %1, %2" : "=v"(r) : "v"(lo), "v"(hi)); return r; }
typedef float f32x2 __attribute__((ext_vector_type(2)));
template <class Epi, class Sched, bool ALIGN_EPI = false, bool SP2 = false>
__device__ __forceinline__ void gemm_phase(PG8_LAS unsigned char* lds, const Gemm g, const Sched& S, const Epi& E, int wave_in) {
    int tid_l = wave_in * 64 + lane_id_fresh(); asm volatile("" : "+v"(tid_l));
    const int tid = tid_l, wid = __builtin_amdgcn_readfirstlane(tid >> 6), lane = tid & 63, wr = wid >> 2, wc = wid & 3, fr = lane & 15, fq = lane >> 4;
    const int nt = g.K / BK, K = g.blocked ? BK : g.ld;
    unsigned voffA[2], voffB[2];
#pragma unroll
    for (int i = 0; i < 2; ++i) { int R, C; stage_rc(tid * 16 + i * 8192, R, C); const int Rb = Epi::PERM ? ((R & ~31) + perm32(R & 31)) : R;
        voffA[i] = (unsigned)(R * K + C) * 2u; voffB[i] = (unsigned)(Rb * K + C) * 2u;
        if (g.blocked == 2) { voffA[i] = (unsigned)(tid * 16 + i * 8192); voffB[i] = voffA[i]; } }
    const size_t kstep = g.blocked ? (size_t)(BM * BK * 2) : (size_t)(BK * 2);
    const size_t hstep = (size_t)HALF * K * 2;
    const size_t tstep = g.blocked ? (size_t)nt * (BM * BK * 2) : 2 * hstep;
    const unsigned ldsw = (unsigned)wid * 1024u;
    const int aoff = lds_byte(wr * 64 + fr, fq * 8), boff = lds_byte(wc * 32 + fr, fq * 8);
#define PG8_SA(b, h) (((b) * 2 + (h)) * HTB)
#define PG8_SB(b, h) ((4 + (b) * 2 + (h)) * HTB)
#define PG8_STAGE(bufoff, gbase, voff) do { _Pragma("unroll") for (int _i = 0; _i < 2; ++_i) \
        __builtin_amdgcn_global_load_lds((const unsigned*)((const char*)(gbase) + (voff)[_i]), (PG8_LAS unsigned*)(lds + (bufoff) + ldsw + _i * 8192), 16, 0, 0); } while (0)
#define PG8_LDA(dst, b, h) do { _Pragma("unroll") for (int m = 0; m < 4; ++m) _Pragma("unroll") for (int k = 0; k < 2; ++k) dst[m][k] = *(const PG8_LAS bf16x8*)(lds + PG8_SA(b, h) + aoff + m * 2048 + k * 1024); } while (0)
#define PG8_LDB(dst, b, h) do { _Pragma("unroll") for (int n = 0; n < 2; ++n) _Pragma("unroll") for (int k = 0; k < 2; ++k) dst[n][k] = *(const PG8_LAS bf16x8*)(lds + PG8_SB(b, h) + boff + n * 2048 + k * 1024); } while (0)
#define PG8_MMA(ai, bj, At, Bt) do { __builtin_amdgcn_s_setprio(1); _Pragma("unroll") for (int m = 0; m < 4; ++m) _Pragma("unroll") for (int n = 0; n < 2; ++n) _Pragma("unroll") for (int k = 0; k < 2; ++k) \
        acc[ai][bj][m][n] = __builtin_amdgcn_mfma_f32_16x16x32_bf16(Bt[n][k], At[m][k], acc[ai][bj][m][n], 0, 0, 0); __builtin_amdgcn_s_setprio(0); } while (0)
#define PG8_WAIT_V(n) asm volatile("s_waitcnt vmcnt(" #n ")" ::: "memory")
#define PG8_WAIT_L(n) asm volatile("s_waitcnt lgkmcnt(" #n ")" ::: "memory")
#define PG8_BAR __builtin_amdgcn_s_barrier()
#define PG8_SCHED __builtin_amdgcn_sched_barrier(0)
    Unit cur, nxt; int ui = 0;
    if (!S.next(0, cur)) return;
    f32x4 acc[2][2][4][2];
#pragma unroll
    for (int a = 0; a < 2; ++a)
#pragma unroll
        for (int b = 0; b < 2; ++b)
#pragma unroll
            for (int m = 0; m < 4; ++m)
#pragma unroll
                for (int n = 0; n < 2; ++n) acc[a][b][m][n] = (f32x4){0.f, 0.f, 0.f, 0.f};
    bf16x8 At[4][2], B0[2][2], B1[2][2];
    const char* cA = (const char*)g.A + (size_t)cur.pm * tstep; const char* cB = (const char*)g.Bt + (size_t)cur.pn * tstep;
    S.a_ready(cur);
    if constexpr (SP2) {
        PG8_STAGE(PG8_SB(0, 0), cB, voffB); PG8_STAGE(PG8_SB(0, 1), cB + hstep, voffB); PG8_STAGE(PG8_SA(0, 0), cA, voffA); PG8_STAGE(PG8_SA(0, 1), cA + hstep, voffA);
        if (wr == 1) PG8_BAR;
        PG8_WAIT_V(2); PG8_BAR;
        PG8_STAGE(PG8_SB(1, 0), cB + kstep, voffB); PG8_STAGE(PG8_SA(1, 0), cA + kstep, voffA); PG8_STAGE(PG8_SB(1, 1), cB + hstep + kstep, voffB);
        PG8_WAIT_V(6); PG8_BAR;
    } else {
        PG8_STAGE(PG8_SB(0, 0), cB, voffB); PG8_STAGE(PG8_SA(0, 0), cA, voffA); PG8_STAGE(PG8_SB(0, 1), cB + hstep, voffB); PG8_STAGE(PG8_SA(0, 1), cA + hstep, voffA);
        if (wr == 1) PG8_BAR;
        PG8_WAIT_V(4); PG8_BAR;
        PG8_STAGE(PG8_SB(1, 0), cB + kstep, voffB); PG8_STAGE(PG8_SA(1, 0), cA + kstep, voffA); PG8_STAGE(PG8_SB(1, 1), cB + hstep + kstep, voffB);
        PG8_WAIT_V(6); PG8_BAR;
    }
    for (;;) {
        const bool has_next = S.next(ui + 1, nxt);
        const char* nA = has_next ? (const char*)g.A + (size_t)nxt.pm * tstep : cA; const char* nB = has_next ? (const char*)g.Bt + (size_t)nxt.pn * tstep : cB;
        for (int t = 0; t < nt; t += 2) {
            const bool last = (t == nt - 2);
            const char* a1 = cA + (size_t)(t + 1) * kstep;
            const char* a2 = last ? nA : cA + (size_t)(t + 2) * kstep; const char* b2 = last ? nB : cB + (size_t)(t + 2) * kstep;
            const char* a3 = a2 + kstep; const char* b3 = b2 + kstep;
            if (last && has_next) S.a_ready(nxt);
            if constexpr (SP2) {
            PG8_LDB(B0, 0, 0); PG8_LDB(B1, 0, 1); PG8_SCHED; PG8_LDA(At, 0, 0); PG8_STAGE(PG8_SA(1, 1), a1 + hstep, voffA);
            PG8_WAIT_V(8); PG8_WAIT_L(0); PG8_BAR; if (cur.hm & 1) { PG8_MMA(0, 0, At, B0); PG8_MMA(0, 1, At, B1); } PG8_BAR; PG8_SCHED;
            PG8_LDA(At, 0, 1); PG8_STAGE(PG8_SB(0, 0), b2, voffB); PG8_STAGE(PG8_SB(0, 1), b2 + hstep, voffB); PG8_STAGE(PG8_SA(0, 0), a2, voffA);
            PG8_WAIT_V(8); PG8_WAIT_L(0); PG8_BAR; if (cur.hm & 2) { PG8_MMA(1, 0, At, B0); PG8_MMA(1, 1, At, B1); } PG8_BAR; PG8_SCHED;
            PG8_LDB(B0, 1, 0); PG8_LDB(B1, 1, 1); PG8_SCHED; PG8_LDA(At, 1, 0); PG8_STAGE(PG8_SA(0, 1), a2 + hstep, voffA);
            PG8_WAIT_V(8); PG8_WAIT_L(0); PG8_BAR; if (cur.hm & 1) { PG8_MMA(0, 0, At, B0); PG8_MMA(0, 1, At, B1); } PG8_BAR; PG8_SCHED;
            PG8_LDA(At, 1, 1); PG8_STAGE(PG8_SB(1, 0), b3, voffB); PG8_STAGE(PG8_SB(1, 1), b3 + hstep, voffB); PG8_STAGE(PG8_SA(1, 0), a3, voffA);
            PG8_WAIT_V(8); PG8_WAIT_L(0); PG8_BAR; if (cur.hm & 2) { PG8_MMA(1, 0, At, B0); PG8_MMA(1, 1, At, B1); } PG8_BAR; PG8_SCHED;
            } else {
            PG8_LDB(B0, 0, 0); PG8_SCHED; PG8_LDA(At, 0, 0); PG8_STAGE(PG8_SA(1, 1), a1 + hstep, voffA);
            PG8_WAIT_L(8); PG8_BAR; PG8_WAIT_L(0); PG8_MMA(0, 0, At, B0); PG8_BAR; PG8_SCHED;
            PG8_LDB(B1, 0, 1); PG8_STAGE(PG8_SB(0, 0), b2, voffB);
            PG8_BAR; PG8_WAIT_L(0); PG8_MMA(0, 1, At, B1); PG8_BAR;
            PG8_LDA(At, 0, 1); PG8_STAGE(PG8_SA(0, 0), a2, voffA);
            PG8_BAR; PG8_WAIT_L(0); PG8_MMA(1, 0, At, B0); PG8_BAR; PG8_SCHED;
            PG8_STAGE(PG8_SB(0, 1), b2 + hstep, voffB);
            PG8_WAIT_V(6); PG8_BAR; PG8_MMA(1, 1, At, B1); PG8_BAR;
            PG8_LDB(B0, 1, 0); PG8_SCHED; PG8_LDA(At, 1, 0); PG8_STAGE(PG8_SA(0, 1), a2 + hstep, voffA);
            PG8_WAIT_L(8); PG8_BAR; PG8_WAIT_L(0); PG8_MMA(0, 0, At, B0); PG8_BAR; PG8_SCHED;
            PG8_LDB(B1, 1, 1); PG8_STAGE(PG8_SB(1, 0), b3, voffB);
            PG8_BAR; PG8_WAIT_L(0); PG8_MMA(0, 1, At, B1); PG8_BAR;
            PG8_LDA(At, 1, 1); PG8_STAGE(PG8_SA(1, 0), a3, voffA);
            PG8_BAR; PG8_WAIT_L(0); PG8_MMA(1, 0, At, B0); PG8_BAR; PG8_SCHED;
            PG8_STAGE(PG8_SB(1, 1), b3 + hstep, voffB);
            PG8_WAIT_V(6); PG8_BAR; PG8_MMA(1, 1, At, B1); PG8_BAR;
            }
        }
        if constexpr (ALIGN_EPI) { if (wr == 0) PG8_BAR; }
        if constexpr (!Epi::AFTER_DRAIN) { E(acc, cur, wr, wc, fr, fq); S.done(cur); }
        if (!has_next) break;
#pragma unroll
        for (int a = 0; a < 2; ++a)
#pragma unroll
            for (int b = 0; b < 2; ++b)
#pragma unroll
                for (int m = 0; m < 4; ++m)
#pragma unroll
                    for (int n = 0; n < 2; ++n) acc[a][b][m][n] = (f32x4){0.f, 0.f, 0.f, 0.f};
        cur = nxt; cA = nA; cB = nB; ++ui;
        if constexpr (ALIGN_EPI) { if (wr == 1) PG8_BAR; }
    }
    PG8_WAIT_V(0);
    if constexpr (!ALIGN_EPI) { if (wr == 0) PG8_BAR; }
    PG8_BAR;
    if constexpr (Epi::AFTER_DRAIN) { E.fused(acc, cur, wr, wc, fr, fq, lds, wid, lane); S.done(cur); }
#undef PG8_SA
#undef PG8_SB
#undef PG8_STAGE
#undef PG8_LDA
#undef PG8_LDB
#undef PG8_MMA
#undef PG8_WAIT_V
#undef PG8_WAIT_L
#undef PG8_BAR
#undef PG8_SCHED
}
}
using pg8::bf16_t; using pg8::bf16x8; using pg8::f32x4; using pg8::u32x4; using pg8::Unit; using pg8::cvt_pk_bf16;
typedef float f32x16 __attribute__((ext_vector_type(16)));
typedef unsigned u32x2 __attribute__((ext_vector_type(2)));
#define LAS __attribute__((address_space(3)))

constexpr int DM = 1024, SEQ = 2048, DSEQ = 64;
constexpr int MP = 16 * 2048, MS = 32 * 64, MT = MP + MS;
constexpr int DFF = 2816, LDP = 2880;
constexpr int KSA_ROWS = 576, KSB_ROWS = 2112;
constexpr float EPS = 1e-6f, LOG2E = 1.4426950408889634f, QSCALE = 0.125f * 1.4426950408889634f;
constexpr int NPHASE = 15;
#ifndef DOWN_WGM
#define DOWN_WGM 8
#endif
constexpr size_t MiB = 1u << 20;
constexpr size_t WS_CTL = 0, WS_BAR = 65536, WS_SSQ = 1 * MiB, WS_ROPE = 2 * MiB, WS_W = 4 * MiB;
constexpr size_t W_GU1 = 0, W_D1 = 11 * MiB, W_IN = 17 * MiB, W_OUT = 23 * MiB, W_GU2 = 25 * MiB, W_D2 = 36 * MiB, W_LAYER = 42 * MiB;
constexpr size_t WS_XB = 88 * MiB, WS_A = 156 * MiB, WS_QA = WS_A, WS_QB = WS_A + 34 * MiB, WS_O = WS_A + 68 * MiB;
constexpr size_t WS_KAP = 352 * MiB, WS_KBP = 384 * MiB, WS_VAP = 416 * MiB, WS_VBP = 448 * MiB;
constexpr size_t WS_KSA = 480 * MiB, WS_VSA = 516 * MiB, WS_KSB = 552 * MiB, WS_VSB = 684 * MiB, WS_END = 816 * MiB;
static_assert(W_D2 + (size_t)1024 * LDP * 2 <= W_LAYER && WS_W + 2 * W_LAYER <= WS_XB && WS_A + (size_t)MT * LDP * 2 <= WS_KAP, "d_ws map");
constexpr size_t OUT_YP = 0, OUT_YS = 33554432, OUT_PAK = 35651584, OUT_PAV = 44040192, OUT_PBK = 52428800, OUT_PBV = 85983232,
                 OUT_SAK = 119537664, OUT_SAV = 121634816, OUT_SBK = 123731968, OUT_SBV = 125829120;
constexpr int LDS_BYTES = 147456;

struct Args { const float* in[27]; float* out; unsigned char* ws; int ph_lo, ph_hi, coop, pad; };
typedef const __attribute__((address_space(4))) Args* KArgP;

__device__ const double ROPE_INV[32] = {1.0, 0.7498942093324559, 0.5623413251903491, 0.4216965034285822, 0.31622776601683794, 0.23713737056616552, 0.1778279410038923, 0.1333521432163324, 0.1, 0.07498942093324558, 0.05623413251903491, 0.042169650342858224, 0.03162277660168379, 0.023713737056616554, 0.01778279410038923, 0.01333521432163324, 0.01, 0.007498942093324558, 0.005623413251903491, 0.004216965034285823, 0.0031622776601683794, 0.0023713737056616554, 0.0017782794100389228, 0.001333521432163324, 0.001, 0.0007498942093324559, 0.0005623413251903491, 0.00042169650342858224, 0.00031622776601683794, 0.00023713737056616554, 0.00017782794100389227, 0.0001333521432163324};

__device__ __forceinline__ float shx(float v, int lane, int m) { return __builtin_bit_cast(float, __builtin_amdgcn_ds_bpermute((lane ^ m) << 2, __builtin_bit_cast(int, v))); }
__device__ __forceinline__ float wave_sum(float v, int lane) {
#pragma unroll
    for (int o = 1; o < 64; o <<= 1) v += shx(v, lane, o);
    return v;
}
__device__ __forceinline__ float wave_max(float v, int lane) {
#pragma unroll
    for (int o = 1; o < 64; o <<= 1) v = fmaxf(v, shx(v, lane, o));
    return v;
}
__device__ __forceinline__ float fast_rcp(float x) { return __builtin_amdgcn_rcpf(x); }
__device__ __forceinline__ float fast_exp2(float x) { return __builtin_amdgcn_exp2f(x); }

struct EpiSwiGLU {
    static constexpr bool PERM = true, AFTER_DRAIN = false;
    bf16_t* O; const float* ssq;
    __device__ __forceinline__ void operator()(const f32x4 (&acc)[2][2][4][2], const Unit& u, int wr, int wc, int fr, int fq) const {
        const int row0 = u.pm * 256 + wr * 64 + fr, col0 = u.pn * 128 + wc * 32 + 8 * fq;
        float sq[2][4];
#pragma unroll
        for (int ai = 0; ai < 2; ++ai)
#pragma unroll
            for (int m = 0; m < 4; ++m) sq[ai][m] = ssq[row0 + ai * 128 + m * 16];
#pragma unroll
        for (int ai = 0; ai < 2; ++ai)
#pragma unroll
            for (int m = 0; m < 4; ++m) {
                if (!((u.hm >> ai) & 1)) continue;
                const int row = row0 + ai * 128 + m * 16;
                const float rstd = rsqrtf(sq[ai][m] * (1.0f / DM) + EPS);
                float o[8];
#pragma unroll
                for (int n = 0; n < 2; ++n)
#pragma unroll
                    for (int i = 0; i < 4; ++i) {
                        const float g = acc[ai][0][m][n][i] * rstd, up = acc[ai][1][m][n][i] * rstd;
                        const float sg = g * fast_rcp(1.0f + fast_exp2(-g * LOG2E));
                        o[n * 4 + i] = sg * up;
                    }
                u32x4 w; w.x = cvt_pk_bf16(o[0], o[1]); w.y = cvt_pk_bf16(o[2], o[3]); w.z = cvt_pk_bf16(o[4], o[5]); w.w = cvt_pk_bf16(o[6], o[7]);
                *(u32x4*)((char*)O + (((size_t)(row >> 8) * (DFF / 64) + (col0 >> 6)) * 2 + ((row >> 7) & 1)) * 16384 + pg8::lds_byte(row & 127, col0 & 63)) = w;
            }
    }
};
struct EpiResid {
    static constexpr bool PERM = false, AFTER_DRAIN = false;
    const float* xin_p; const float* xin_s; float* xout; bf16_t* xb; float* ssq; float scale; int res_bf16, write_f32;
    __device__ __forceinline__ void operator()(const f32x4 (&acc)[2][2][4][2], const Unit& u, int wr, int wc, int fr, int fq) const {
        const int col0 = u.pn * 256 + wc * 32 + 4 * fq;
#pragma unroll
        for (int ai = 0; ai < 2; ++ai) {
            if (!((u.hm >> ai) & 1)) continue;
            const int rowb = u.pm * 256 + ai * 128 + wr * 64 + fr;
            f32x4 pre[4][2][2];
            if (res_bf16) {
                u32x2 pw[4][2][2];
#pragma unroll
                for (int m = 0; m < 4; ++m)
#pragma unroll
                    for (int bj = 0; bj < 2; ++bj)
#pragma unroll
                        for (int n = 0; n < 2; ++n) pw[m][bj][n] = *(const u32x2*)(xb + (size_t)(rowb + m * 16) * DM + col0 + bj * 128 + n * 16);
#pragma unroll
                for (int m = 0; m < 4; ++m)
#pragma unroll
                    for (int bj = 0; bj < 2; ++bj)
#pragma unroll
                        for (int n = 0; n < 2; ++n) { const u32x2 w = pw[m][bj][n]; f32x4 p;
                            p[0] = __builtin_bit_cast(float, w.x << 16); p[1] = __builtin_bit_cast(float, w.x & 0xffff0000u);
                            p[2] = __builtin_bit_cast(float, w.y << 16); p[3] = __builtin_bit_cast(float, w.y & 0xffff0000u); pre[m][bj][n] = p; }
            } else {
                const float* xi = (rowb < MP) ? xin_p + (size_t)rowb * DM : xin_s + (size_t)(rowb - MP) * DM;
#pragma unroll
                for (int m = 0; m < 4; ++m)
#pragma unroll
                    for (int bj = 0; bj < 2; ++bj)
#pragma unroll
                        for (int n = 0; n < 2; ++n) pre[m][bj][n] = *(const f32x4*)(xi + (size_t)m * 16 * DM + col0 + bj * 128 + n * 16);
            }
#pragma unroll
            for (int m = 0; m < 4; ++m) {
                const int row = rowb + m * 16;
                float sq = 0.f;
#pragma unroll
                for (int bj = 0; bj < 2; ++bj)
#pragma unroll
                    for (int n = 0; n < 2; ++n) {
                        const int c = col0 + bj * 128 + n * 16;
                        const f32x4 v = pre[m][bj][n] + acc[ai][bj][m][n] * scale;
                        if (write_f32) *(f32x4*)(xout + (size_t)row * DM + c) = v;
                        u32x2 w; w.x = cvt_pk_bf16(v[0], v[1]); w.y = cvt_pk_bf16(v[2], v[3]);
                        *(u32x2*)(xb + (size_t)row * DM + c) = w;
                        sq += (v[0] * v[0] + v[1] * v[1]) + (v[2] * v[2] + v[3] * v[3]);
                    }
                sq += shx(sq, fr + 16 * fq, 16); sq += shx(sq, fr + 16 * fq, 32);
                if (fq == 0) atomicAdd(ssq + row, sq);
            }
        }
    }
};
struct EpiQK {
    static constexpr bool PERM = true, AFTER_DRAIN = false;
    const float* ssq; unsigned char* ws; float* out; KArgP kap; int l;
    __device__ __forceinline__ void operator()(const f32x4 (&acc)[2][2][4][2], const Unit& u, int wr, int wc, int fr, int fq) const {
        const int sec = u.pn >> 1, hd = 4 * (u.pn & 1) + wc;
        const float* gp = kap->in[12 + sec] + l * 64;
        const float* rope = (const float*)(ws + WS_ROPE);
        bf16_t* QA = (bf16_t*)(ws + WS_QA); bf16_t* QB = (bf16_t*)(ws + WS_QB); bf16_t* KAP = (bf16_t*)(ws + WS_KAP); bf16_t* KBP = (bf16_t*)(ws + WS_KBP);
        bf16_t* KSA = (bf16_t*)(ws + WS_KSA) + (size_t)l * 32 * KSA_ROWS * 512; bf16_t* KSB = (bf16_t*)(ws + WS_KSB) + (size_t)l * 32 * KSB_ROWS * 512;
        float* oPAK = out + OUT_PAK + (size_t)l * 16 * 512 * 512; float* oPBK = out + OUT_PBK + (size_t)l * MP * 512;
        float* oSAK = out + OUT_SAK + (size_t)l * MS * 512; float* oSBK = out + OUT_SBK + (size_t)l * MS * 512;
        f32x4 gl[2], gh[2];
#pragma unroll
        for (int n = 0; n < 2; ++n) { gl[n] = *(const f32x4*)(gp + 8 * fq + 4 * n); gh[n] = *(const f32x4*)(gp + 32 + 8 * fq + 4 * n); }
        const int cbase = hd * 64 + 8 * fq;
        float sqr[2][4];
#pragma unroll
        for (int ai = 0; ai < 2; ++ai)
#pragma unroll
            for (int m = 0; m < 4; ++m) sqr[ai][m] = ssq[u.pm * 256 + ai * 128 + wr * 64 + m * 16 + fr];
#pragma unroll
        for (int ai = 0; ai < 2; ++ai)
#pragma unroll
            for (int m = 0; m < 4; ++m) {
                if (!((u.hm >> ai) & 1)) continue;
                const int row = u.pm * 256 + ai * 128 + wr * 64 + m * 16 + fr;
                const float rstd = rsqrtf(sqr[ai][m] * (1.0f / DM) + EPS);
                f32x4 y[2][2]; float ss = 0.f;
#pragma unroll
                for (int bj = 0; bj < 2; ++bj)
#pragma unroll
                    for (int n = 0; n < 2; ++n) { const f32x4 v = acc[ai][bj][m][n] * rstd; y[bj][n] = v; ss += (v[0] * v[0] + v[1] * v[1]) + (v[2] * v[2] + v[3] * v[3]); }
                ss += shx(ss, fr + 16 * fq, 16); ss += shx(ss, fr + 16 * fq, 32);
                const float rr = rsqrtf(ss * (1.0f / 64.0f) + EPS);
#pragma unroll
                for (int n = 0; n < 2; ++n) { y[0][n] = y[0][n] * rr * gl[n]; y[1][n] = y[1][n] * rr * gh[n]; }
                const bool prompt = row < MP;
                const int sp = row & 2047, bp = row >> 11, ts = (row - MP) & 63, bs = (row - MP) >> 6;
                if (sec >= 2) {
                    const int pos = prompt ? sp : 2048 + ts;
                    const float* cs = rope + (size_t)pos * 64 + 8 * fq;
#pragma unroll
                    for (int n = 0; n < 2; ++n) {
                        const f32x4 c = *(const f32x4*)(cs + 4 * n), s = *(const f32x4*)(cs + 32 + 4 * n);
                        const f32x4 x1 = y[0][n], x2 = y[1][n];
                        y[0][n] = x1 * c - x2 * s; y[1][n] = x2 * c + x1 * s;
                    }
                }
                if (sec == 0 || sec == 2) {
                    bf16_t* dst = (sec == 0 ? QA : QB) + (size_t)row * 512 + cbase;
#pragma unroll
                    for (int bj = 0; bj < 2; ++bj) {
                        const f32x4 a = y[bj][0] * QSCALE, b = y[bj][1] * QSCALE;
                        u32x4 w; w.x = cvt_pk_bf16(a[0], a[1]); w.y = cvt_pk_bf16(a[2], a[3]); w.z = cvt_pk_bf16(b[0], b[1]); w.w = cvt_pk_bf16(b[2], b[3]);
                        *(u32x4*)(dst + 32 * bj) = w;
                    }
                } else {
                    bf16_t* dst; float* fo = nullptr;
                    if (sec == 1) {
                        if (prompt) { dst = KAP + (size_t)row * 512; if (sp >= 1536) fo = oPAK + (size_t)(bp * 512 + sp - 1536) * 512; }
                        else { dst = KSA + (size_t)(bs * KSA_ROWS + 512 + ts) * 512; fo = oSAK + (size_t)(row - MP) * 512; }
                    } else {
                        if (prompt) { dst = KBP + (size_t)row * 512; fo = oPBK + (size_t)row * 512; }
                        else { dst = KSB + (size_t)(bs * KSB_ROWS + 2048 + ts) * 512; fo = oSBK + (size_t)(row - MP) * 512; }
                    }
#pragma unroll
                    for (int bj = 0; bj < 2; ++bj) {
                        const f32x4 a = y[bj][0], b = y[bj][1];
                        u32x4 w; w.x = cvt_pk_bf16(a[0], a[1]); w.y = cvt_pk_bf16(a[2], a[3]); w.z = cvt_pk_bf16(b[0], b[1]); w.w = cvt_pk_bf16(b[2], b[3]);
                        *(u32x4*)(dst + cbase + 32 * bj) = w;
                        if (fo) { *(f32x4*)(fo + cbase + 32 * bj) = a; *(f32x4*)(fo + cbase + 32 * bj + 4) = b; }
                    }
                }
            }
    }
};
struct EpiVt {
    static constexpr bool PERM = true, AFTER_DRAIN = false;
    const float* ssq; unsigned char* ws; float* out; int l;
    __device__ __forceinline__ void operator()(const f32x4 (&acc)[2][2][4][2], const Unit& u, int wr, int wc, int fr, int fq) const {
        bf16_t* VAP = (bf16_t*)(ws + WS_VAP); bf16_t* VBP = (bf16_t*)(ws + WS_VBP);
        bf16_t* VSA = (bf16_t*)(ws + WS_VSA) + (size_t)l * 32 * 512 * KSA_ROWS; bf16_t* VSB = (bf16_t*)(ws + WS_VSB) + (size_t)l * 32 * 512 * KSB_ROWS;
        float* oPAV = out + OUT_PAV + (size_t)l * 16 * 512 * 512; float* oPBV = out + OUT_PBV + (size_t)l * MP * 512;
        float* oSAV = out + OUT_SAV + (size_t)l * MS * 512; float* oSBV = out + OUT_SBV + (size_t)l * MS * 512;
        const int grp = u.pm >> 1;
        const bool prompt = u.pn < (MP / 256);
        f32x4 rs[2][2];
#pragma unroll
        for (int bj = 0; bj < 2; ++bj)
#pragma unroll
            for (int n = 0; n < 2; ++n) {
                const f32x4 q = *(const f32x4*)(ssq + u.pn * 256 + bj * 128 + wc * 32 + 8 * fq + 4 * n);
                f32x4 r; r[0] = rsqrtf(q[0] * (1.0f / DM) + EPS); r[1] = rsqrtf(q[1] * (1.0f / DM) + EPS); r[2] = rsqrtf(q[2] * (1.0f / DM) + EPS); r[3] = rsqrtf(q[3] * (1.0f / DM) + EPS);
                rs[bj][n] = r;
            }
#pragma unroll
        for (int bj = 0; bj < 2; ++bj) {
            const int tok = u.pn * 256 + bj * 128 + wc * 32 + 8 * fq;
            const int bp = tok >> 11, sp = tok & 2047, tt = tok - MP, bs = tt >> 6, ts = tt & 63;
            bf16_t* vdst; size_t vld; float* fo = nullptr;
            if (prompt) { vdst = (grp == 0 ? VAP : VBP) + (size_t)bp * 512 * 2048 + sp; vld = 2048;
                if (grp == 0) { if (sp >= 1536) fo = oPAV + (size_t)(bp * 512 + sp - 1536) * 512; } else fo = oPBV + (size_t)tok * 512; }
            else { if (grp == 0) { vdst = VSA + (size_t)bs * 512 * KSA_ROWS + 512 + ts; vld = KSA_ROWS; fo = oSAV + (size_t)tt * 512; }
                   else { vdst = VSB + (size_t)bs * 512 * KSB_ROWS + 2048 + ts; vld = KSB_ROWS; fo = oSBV + (size_t)tt * 512; } }
#pragma unroll
            for (int ai = 0; ai < 2; ++ai)
#pragma unroll
                for (int m = 0; m < 4; ++m) {
                    if (!((u.hm >> ai) & 1)) continue;
                    const int hrow = (ai * 128 + wr * 64 + m * 16 + fr) + (u.pm & 1) * 256;
                    const f32x4 a = acc[ai][bj][m][0] * rs[bj][0], b = acc[ai][bj][m][1] * rs[bj][1];
                    u32x4 w; w.x = cvt_pk_bf16(a[0], a[1]); w.y = cvt_pk_bf16(a[2], a[3]); w.z = cvt_pk_bf16(b[0], b[1]); w.w = cvt_pk_bf16(b[2], b[3]);
                    *(u32x4*)(vdst + (size_t)hrow * vld) = w;
                    if (fo) {
#pragma unroll
                        for (int i = 0; i < 4; ++i) { fo[(size_t)i * 512 + hrow] = a[i]; fo[(size_t)(4 + i) * 512 + hrow] = b[i]; }
                    }
                }
        }
    }
};
#define XB_TMO      128
#define XB_XCNT(j)  (256  + 64 * (j))
#define XB_XSUB(j)  (1280 + 64 * (j))
#define XB_XGEN(j)  (2304 + 64 * (j))
#define XB_TOP      3328
#define XB_TOPGEN   3392
#define XCD_BAR_WORDS 3456
#define XB_SPIN_CAP (1u << 18)

__device__ __forceinline__ unsigned xb_ld(unsigned* p)              { return __hip_atomic_load(p, __ATOMIC_RELAXED, __HIP_MEMORY_SCOPE_AGENT); }
__device__ __forceinline__ unsigned xb_add(unsigned* p, unsigned v) { return __hip_atomic_fetch_add(p, v, __ATOMIC_RELAXED, __HIP_MEMORY_SCOPE_AGENT); }
__device__ __forceinline__ unsigned xb_xcc_id() { return (unsigned)__builtin_amdgcn_s_getreg((3 << 11) | 20) & 0xFu; }
#define XB_SPIN(cond, bar) do { unsigned _sp = 0; while (cond) { __builtin_amdgcn_s_sleep(1); \
    if ((++_sp & 255u) == 0u) { if (xb_ld(&(bar)[XB_TMO])) break; if (_sp > XB_SPIN_CAP) { atomicAdd(&(bar)[XB_TMO], 1u); break; } } } } while (0)

struct XcdBarrier {
    unsigned* bar; unsigned x;
    volatile LAS unsigned* st;
};

__device__ __forceinline__ XcdBarrier xcd_barrier_post(unsigned* bar, volatile LAS unsigned* st) {
    XcdBarrier b; b.bar = bar; b.x = xb_xcc_id(); b.st = st;
    if (threadIdx.x == 0) (void)xb_add(&bar[XB_XCNT(b.x)], 1u);
    return b;
}
__device__ __forceinline__ void xcd_barrier_complete(unsigned* bar, unsigned x, unsigned& nloc, unsigned& nx) {
    const unsigned G = gridDim.x * gridDim.y * gridDim.z;
    unsigned sum, cnt, mine, sp = 0u;
    for (;;) {
        sum = 0u; cnt = 0u; mine = 0u;
#pragma unroll
        for (unsigned j = 0; j < 16; ++j) { const unsigned c = xb_ld(&bar[XB_XCNT(j)]); sum += c; cnt += (c > 0u) ? 1u : 0u; mine = (j == x) ? c : mine; }
        if (sum == G) break;
        __builtin_amdgcn_s_sleep(1);
        if ((++sp & 255u) == 0u) { if (xb_ld(&bar[XB_TMO])) break; if (sp > XB_SPIN_CAP) { atomicAdd(&bar[XB_TMO], 1u); break; } }
    }
    nloc = mine > 0u ? mine : 1u; nx = cnt > 0u ? cnt : 1u;
}

__device__ __forceinline__ void xcd_barrier(const XcdBarrier& b) {
    asm volatile("s_waitcnt vmcnt(0)" ::: "memory");
    __syncthreads();
    if (threadIdx.x == 0) {
        unsigned* bar = b.bar;
        __builtin_amdgcn_s_waitcnt(0);
        unsigned nloc = b.st[0], nx = b.st[1];
        if (nloc == 0u) { xcd_barrier_complete(bar, b.x, nloc, nx); b.st[0] = nloc; b.st[1] = nx; }
        const unsigned old = xb_add(&bar[XB_XSUB(b.x)], 1u);
        const unsigned gen = old / nloc;
        if (old + 1u == (gen + 1u) * nloc) {
            __builtin_amdgcn_fence(__ATOMIC_RELEASE, "agent");
            asm volatile("s_waitcnt vmcnt(0)" ::: "memory");
            const unsigned og = xb_add(&bar[XB_TOP], 1u);
            const unsigned tg = og / nx;
            if (og + 1u == (tg + 1u) * nx) xb_add(&bar[XB_TOPGEN], 1u);
            else XB_SPIN(xb_ld(&bar[XB_TOPGEN]) == tg, bar);
            __builtin_amdgcn_fence(__ATOMIC_ACQUIRE, "agent");
            xb_add(&bar[XB_XGEN(b.x)], 1u);
            asm volatile("s_waitcnt vmcnt(0)" ::: "memory");
        } else {
            XB_SPIN(xb_ld(&bar[XB_XGEN(b.x)]) == gen, bar);
            __builtin_amdgcn_fence(__ATOMIC_ACQUIRE, "agent");
            asm volatile("s_waitcnt vmcnt(0)" ::: "memory");
        }
    }
    __syncthreads();
}
__device__ __forceinline__ int map_row(int kind, int n) {
    if (kind == 0) return n;
    if (kind == 1) return 256 * (n >> 7) + (n & 127);
    if (kind == 2) return 256 * (n >> 7) + 128 + (n & 127);
    const int sec = n >> 9, w = n & 511;
    if (sec == 2) return 2048 + w;
    if (sec == 5) return 2560 + w;
    const int qsec = sec == 0 ? 0 : sec == 1 ? 1 : sec == 3 ? 2 : 3;
    const int c = qsec * 512 + w, pn = c >> 8, ww = c & 255, hw = ww >> 6, d = ww & 63;
    return 256 * pn + 128 * (d >> 5) + 32 * hw + (d & 31);
}
__device__ __forceinline__ void transpose_item(const float* src, int ld_src, int k0, int n0, const float* gain, bf16_t* dst, size_t ld_dst, int kind, LAS float* scr, int lane) {
    float tv[32];
#pragma unroll
    for (int i = 0; i < 32; ++i) tv[i] = src[(size_t)(k0 + 2 * i + (lane >> 5)) * ld_src + n0 + (lane & 31)];
    if (gain) {
#pragma unroll
        for (int i = 0; i < 32; ++i) tv[i] *= gain[k0 + 2 * i + (lane >> 5)];
    }
#pragma unroll
    for (int i = 0; i < 32; ++i) scr[(2 * i + (lane >> 5)) * 33 + (lane & 31)] = tv[i];
    asm volatile("s_waitcnt lgkmcnt(0)" ::: "memory");
    const int c = lane & 7;
#pragma unroll
    for (int j = 0; j < 4; ++j) {
        const int n = (lane >> 3) + 8 * j; const LAS float* s = scr + (8 * c) * 33 + n;
        u32x4 o; o.x = cvt_pk_bf16(s[0 * 33], s[1 * 33]); o.y = cvt_pk_bf16(s[2 * 33], s[3 * 33]); o.z = cvt_pk_bf16(s[4 * 33], s[5 * 33]); o.w = cvt_pk_bf16(s[6 * 33], s[7 * 33]);
        if (kind == 4) { const int row = n0 + n; *(u32x4*)((char*)dst + (((size_t)(row >> 8) * (DFF / 64) + (k0 >> 6)) * 2 + ((row >> 7) & 1)) * 16384 + pg8::lds_byte(row & 127, 8 * c)) = o; }
        else *(u32x4*)(dst + (size_t)map_row(kind, n0 + n) * ld_dst + k0 + 8 * c) = o;
    }
    asm volatile("s_waitcnt lgkmcnt(0)" ::: "memory");
}
__device__ __forceinline__ void do_job(const float* src, int R, int C, const float* gain, bf16_t* dst, size_t ld_dst, int kind, int item, LAS float* scr, int lane) {
    const int nblk = C >> 5, kb = item / nblk, nb = item - kb * nblk;
    (void)R;
    transpose_item(src, C, 64 * kb, 32 * nb, gain, dst, ld_dst, kind, scr, lane);
}

__device__ __forceinline__ void convert_caches(KArgP A, LAS unsigned char* lds, int l, int gw, int NGW, int wave) {
    int lane_l = lane_id_fresh(); asm volatile("" : "+v"(lane_l)); const int lane = lane_l;
    unsigned char* ws = A->ws;
    LAS float* scr = (LAS float*)(lds + wave * 16384);
    constexpr int I_CAV = 32 * 128;
    for (int it = gw; it < I_CAV; it += NGW) {
        {
            const int lb = l * 32 + (it >> 7), item = it & 127;
            do_job(A->in[3] + (size_t)lb * 512 * 512, 512, 512, nullptr, (bf16_t*)(ws + WS_VSA) + (size_t)lb * 512 * KSA_ROWS, KSA_ROWS, 0, item, scr, lane);
        }
    }
    for (int r = gw; r < 32 * 512; r += NGW) {
        const float* s; bf16_t* d;
        if (r < 32 * 512) { const int lb = l * 32 + (r >> 9), key = r & 511; s = A->in[2] + ((size_t)lb * 512 + key) * 512; d = (bf16_t*)(ws + WS_KSA) + (size_t)(lb * KSA_ROWS + key) * 512; }
        else { const int q = r - 32 * 512, lb = l * 32 + (q >> 11), key = q & 2047; s = A->in[4] + ((size_t)lb * 2048 + key) * 512; d = (bf16_t*)(ws + WS_KSB) + (size_t)(lb * KSB_ROWS + key) * 512; }
        const f32x4 a = *(const f32x4*)(s + 8 * lane), b = *(const f32x4*)(s + 8 * lane + 4);
        u32x4 w; w.x = cvt_pk_bf16(a[0], a[1]); w.y = cvt_pk_bf16(a[2], a[3]); w.z = cvt_pk_bf16(b[0], b[1]); w.w = cvt_pk_bf16(b[2], b[3]);
        *(u32x4*)(d + 8 * lane) = w;
    }
}

__device__ __forceinline__ void prologue(KArgP A, LAS unsigned char* lds, int gw, int NGW, int wave) {
    int lane_l = lane_id_fresh(); asm volatile("" : "+v"(lane_l)); const int lane = lane_l;
    unsigned char* ws = A->ws;
    LAS float* scr = (LAS float*)(lds + wave * 16384);
    constexpr int I_GU = 16 * 88, I_D = 44 * 32, I_IN = 16 * 96, I_O = 16 * 32;
    constexpr int I_LAYER = 4 * I_GU + 2 * I_D + I_IN + I_O;
    constexpr int I_W = 2 * I_LAYER;
    for (int it = gw; it < I_W; it += NGW) {
        {
            const int l = it / I_LAYER; int r = it - l * I_LAYER;
            unsigned char* wl = ws + WS_W + (size_t)l * W_LAYER;
            const float* gf1 = A->in[6] + l * DM; const float* gmx = A->in[10] + l * DM; const float* gf2 = A->in[23] + l * DM;
            if (r < I_GU) { do_job(A->in[7] + (size_t)l * DM * DFF, DM, DFF, gf1, (bf16_t*)(wl + W_GU1), DM, 1, r, scr, lane); continue; } r -= I_GU;
            if (r < I_GU) { do_job(A->in[8] + (size_t)l * DM * DFF, DM, DFF, gf1, (bf16_t*)(wl + W_GU1), DM, 2, r, scr, lane); continue; } r -= I_GU;
            if (r < I_D)  { do_job(A->in[9] + (size_t)l * DM * DFF, DFF, DM, nullptr, (bf16_t*)(wl + W_D1), LDP, 4, r, scr, lane); continue; } r -= I_D;
            if (r < I_IN) { do_job(A->in[11] + (size_t)l * DM * 3072, DM, 3072, gmx, (bf16_t*)(wl + W_IN), DM, 3, r, scr, lane); continue; } r -= I_IN;
            if (r < I_O)  { do_job(A->in[22] + (size_t)l * DM * DM, DM, DM, nullptr, (bf16_t*)(wl + W_OUT), DM, 0, r, scr, lane); continue; } r -= I_O;
            if (r < I_GU) { do_job(A->in[24] + (size_t)l * DM * DFF, DM, DFF, gf2, (bf16_t*)(wl + W_GU2), DM, 1, r, scr, lane); continue; } r -= I_GU;
            if (r < I_GU) { do_job(A->in[25] + (size_t)l * DM * DFF, DM, DFF, gf2, (bf16_t*)(wl + W_GU2), DM, 2, r, scr, lane); continue; } r -= I_GU;
            do_job(A->in[26] + (size_t)l * DM * DFF, DFF, DM, nullptr, (bf16_t*)(wl + W_D2), LDP, 4, r, scr, lane);
        }
    }
    convert_caches(A, lds, 0, gw, NGW, wave);
    convert_caches(A, lds, 1, gw, NGW, wave);
    float* ssq = (float*)(ws + WS_SSQ);
    bf16_t* xb = (bf16_t*)(ws + WS_XB);
    for (int r0 = gw; r0 < MT; r0 += 2 * NGW) {
        const int r1 = r0 + NGW; const bool has1 = r1 < MT;
        const float* xa = (r0 < MP) ? A->in[0] + (size_t)r0 * DM : A->in[1] + (size_t)(r0 - MP) * DM;
        const float* xc = !has1 ? xa : (r1 < MP) ? A->in[0] + (size_t)r1 * DM : A->in[1] + (size_t)(r1 - MP) * DM;
        f32x4 va[4], vc[4];
#pragma unroll
        for (int j = 0; j < 4; ++j) { va[j] = *(const f32x4*)(xa + 256 * j + 4 * lane); vc[j] = *(const f32x4*)(xc + 256 * j + 4 * lane); }
        float sa = 0.f, sc = 0.f;
#pragma unroll
        for (int j = 0; j < 4; ++j) {
            sa += (va[j][0] * va[j][0] + va[j][1] * va[j][1]) + (va[j][2] * va[j][2] + va[j][3] * va[j][3]);
            sc += (vc[j][0] * vc[j][0] + vc[j][1] * vc[j][1]) + (vc[j][2] * vc[j][2] + vc[j][3] * vc[j][3]);
            u32x2 w; w.x = cvt_pk_bf16(va[j][0], va[j][1]); w.y = cvt_pk_bf16(va[j][2], va[j][3]);
            *(u32x2*)(xb + (size_t)r0 * DM + 256 * j + 4 * lane) = w;
            if (has1) { u32x2 w2; w2.x = cvt_pk_bf16(vc[j][0], vc[j][1]); w2.y = cvt_pk_bf16(vc[j][2], vc[j][3]); *(u32x2*)(xb + (size_t)r1 * DM + 256 * j + 4 * lane) = w2; }
        }
        sa = wave_sum(sa, lane); sc = wave_sum(sc, lane);
        if (lane == 0) { ssq[r0] = sa; if (has1) ssq[r1] = sc; }
    }
    for (int i = gw * 64 + lane; i < 6 * MT; i += NGW * 64) ssq[MT + i] = 0.f;
    float* rope = (float*)(ws + WS_ROPE);
    for (int i = gw * 64 + lane; i < 2112 * 32; i += NGW * 64) {
        const int pos = i >> 5, j = i & 31;
        const double a = (double)((float)pos * (float)ROPE_INV[j]);
        const double kq = __builtin_rint(a * 0.63661977236758134308);
        const double rr = (a - kq * 1.5707963267948966192) - kq * 6.123233995736766e-17;
        const double r2 = rr * rr;
        const double sn = rr * (1.0 + r2 * (-1.0 / 6 + r2 * (1.0 / 120 + r2 * (-1.0 / 5040 + r2 * (1.0 / 362880 + r2 * (-1.0 / 39916800 + r2 * (1.0 / 6227020800.0)))))));
        const double cn = 1.0 + r2 * (-0.5 + r2 * (1.0 / 24 + r2 * (-1.0 / 720 + r2 * (1.0 / 40320 + r2 * (-1.0 / 3628800 + r2 * (1.0 / 479001600 + r2 * (-1.0 / 87178291200.0)))))));
        const int q = ((int)kq) & 3;
        const double c = q == 0 ? cn : q == 1 ? -sn : q == 2 ? -cn : sn;
        const double s = q == 0 ? sn : q == 1 ? cn : q == 2 ? -sn : -cn;
        rope[(size_t)pos * 64 + j] = (float)c; rope[(size_t)pos * 64 + 32 + j] = (float)s;
    }
    if (gw == 0) {
        unsigned* ctl = (unsigned*)(ws + WS_CTL);
        float* cst = (float*)(ws + WS_CTL + 4096);
        if (lane < 16) ctl[lane] = 0u;
        for (int i = lane; i < XCD_BAR_WORDS; i += 64) ((unsigned*)(ws + WS_BAR))[i] = 0u;
        for (int l = 0; l < 2; ++l) {
            const float mqa = wave_max(fabsf(A->in[12][l * 64 + lane]), lane), mka = wave_max(fabsf(A->in[13][l * 64 + lane]), lane);
            const float mqb = wave_max(fabsf(A->in[14][l * 64 + lane]), lane), mkb = wave_max(fabsf(A->in[15][l * 64 + lane]), lane);
            float mb = 0.f;
            for (int i = lane; i < 8 * 257; i += 64) mb = fmaxf(mb, fabsf(A->in[16][l * 8 * 257 + i]));
            mb = wave_max(mb, lane);
            const float d1 = wave_sum(A->in[17][l * 64 + lane] * A->in[18][l * 64 + lane], lane), d2 = wave_sum(A->in[19][l * 64 + lane] * A->in[20][l * 64 + lane], lane);
            const float lam_init = l == 0 ? 0.2f : 0.35550906759096934f;
            if (lane == 0) {
                cst[l * 8 + 0] = LOG2E * (8.0f * mqa * mka + mb);
                cst[l * 8 + 1] = LOG2E * (8.0f * mqb * mkb);
                cst[l * 8 + 2] = expf(d1) - expf(d2) + lam_init;
                cst[l * 8 + 3] = 1.0f - lam_init;
            }
        }
    }
}

__device__ __forceinline__ int swap23(int r) { return (r & 19) | ((r & 4) << 1) | ((r & 8) >> 1); }
__device__ __forceinline__ f32x16 mfma32(bf16x8 a, bf16x8 b, f32x16 c) { return __builtin_amdgcn_mfma_f32_32x32x16_bf16(a, b, c, 0, 0, 0); }
__device__ __forceinline__ bf16x8 pack8(const f32x16& p, int s) {
    u32x4 w; w.x = cvt_pk_bf16(p[8 * s + 0], p[8 * s + 1]); w.y = cvt_pk_bf16(p[8 * s + 2], p[8 * s + 3]); w.z = cvt_pk_bf16(p[8 * s + 4], p[8 * s + 5]); w.w = cvt_pk_bf16(p[8 * s + 6], p[8 * s + 7]);
    return __builtin_bit_cast(bf16x8, w);
}
constexpr int ATT_BUF = 32768, ATT_WAVE = 65536, ATT_BW = 131072 + 64;

__device__ __forceinline__ void attn_a_block(const bf16_t* Qw, const bf16_t* Kb, const bf16_t* Vtb, int ldv, int T, int t_lo, int t_hi, int t_self, int qoff,
                                             bf16_t* Outw, LAS unsigned char* lds, int wave, int lane_in) {
    int lane = lane_in; asm volatile("" : "+v"(lane));
    const int r32 = lane & 31, hi = lane >> 5;
    const bool active = t_lo <= t_hi;
    const LAS float* E = (const LAS float*)(lds + ATT_WAVE + wave * 8192);
    bf16x8 qf[4];
#pragma unroll
    for (int d0 = 0; d0 < 4; ++d0) qf[d0] = active ? *(const bf16x8*)(Qw + (size_t)r32 * 512 + 16 * d0 + 8 * hi) : (bf16x8){0, 0, 0, 0, 0, 0, 0, 0};
    f32x16 o0, o1;
#pragma unroll
    for (int r = 0; r < 16; ++r) { o0[r] = 0.f; o1[r] = 0.f; }
    float l = 0.f;
    const float cfar = E[192];
    const int key_l = 8 * wave + (lane & 7), c8 = lane >> 3;
    const bf16_t* kg = Kb + (size_t)key_l * 512 + 8 * c8;
    const bf16_t* vg = Vtb + (size_t)key_l * ldv + 8 * c8;
    const int koff = ((key_l >> 5) * 4 + (c8 >> 1)) * 1024 + (swap23(key_l & 31) + 32 * (c8 & 1)) * 16;
    const int voff = 8192 + (((c8 >> 2) * 2 + (key_l >> 5)) * 2 + ((c8 >> 1) & 1)) * 1024 + ((key_l & 31) + 32 * (c8 & 1)) * 16;
    constexpr int ABUF = 16384;
    u32x4 skA = *(const u32x4*)kg, svA = *(const u32x4*)vg, skB = skA, svB = svA;
    if (T > 1) { skB = *(const u32x4*)(kg + (size_t)64 * 512); svB = *(const u32x4*)(vg + 64); }
    *(LAS u32x4*)(lds + koff) = skA; *(LAS u32x4*)(lds + voff) = svA;
    __syncthreads();
    int cb = 0;
#define A_STEP(t, LK, LV, WK, WV) do { \
        if ((t) + 2 < T) { LK = *(const u32x4*)(kg + (size_t)((t) + 2) * 64 * 512); LV = *(const u32x4*)(vg + ((t) + 2) * 64); } \
        if ((t) >= t_lo && (t) <= t_hi) { \
            const LAS bf16x8* KF = (const LAS bf16x8*)(lds + cb * ABUF); \
            const LAS bf16x8* VF = KF + 512; \
            _Pragma("unroll") for (int j = 0; j < 2; ++j) { \
                f32x16 sa; \
                const int relbase = 64 * (t_self - (t)) - 32 * j + qoff; \
                if (relbase - 31 >= 128) { _Pragma("unroll") for (int r = 0; r < 16; ++r) sa[r] = cfar; } \
                else { const int bi = relbase + 64 + r32 - 8 * hi - 23; _Pragma("unroll") for (int r = 0; r < 16; ++r) sa[r] = E[bi + 23 - (r & 7) - 16 * (r >> 3)]; } \
                _Pragma("unroll") for (int d0 = 0; d0 < 4; ++d0) sa = mfma32(KF[(j * 4 + d0) * 64 + lane], qf[d0], sa); \
                float ps = 0.f; \
                _Pragma("unroll") for (int r = 0; r < 16; ++r) { sa[r] = fast_exp2(sa[r]); ps += sa[r]; } \
                l += ps; \
                const bf16x8 p0 = pack8(sa, 0), p1 = pack8(sa, 1); \
                o0 = mfma32(VF[((j * 2 + 0) * 2 + 0) * 64 + lane], p0, o0); o0 = mfma32(VF[((j * 2 + 0) * 2 + 1) * 64 + lane], p1, o0); \
                o1 = mfma32(VF[((j * 2 + 1) * 2 + 0) * 64 + lane], p0, o1); o1 = mfma32(VF[((j * 2 + 1) * 2 + 1) * 64 + lane], p1, o1); \
            } \
        } \
        const int nb = cb == 2 ? 0 : cb + 1; \
        if ((t) + 1 < T) { *(LAS u32x4*)(lds + nb * ABUF + koff) = WK; *(LAS u32x4*)(lds + nb * ABUF + voff) = WV; } \
        cb = nb; \
        __syncthreads(); \
    } while (0)
    for (int t = 0; t < T; t += 2) {
        A_STEP(t, skA, svA, skB, svB);
        if (t + 1 < T) A_STEP(t + 1, skB, svB, skA, svA);
    }
#undef A_STEP
    if (active) {
        const int le = lane_id_fresh(), r32e = le & 31, hie = le >> 5;
        l += shx(l, le, 32);
        const float inv = 1.0f / l;
#pragma unroll
        for (int g = 0; g < 4; ++g) {
            u32x2 w0, w1;
            w0.x = cvt_pk_bf16(o0[4 * g] * inv, o0[4 * g + 1] * inv); w0.y = cvt_pk_bf16(o0[4 * g + 2] * inv, o0[4 * g + 3] * inv);
            w1.x = cvt_pk_bf16(o1[4 * g] * inv, o1[4 * g + 1] * inv); w1.y = cvt_pk_bf16(o1[4 * g + 2] * inv, o1[4 * g + 3] * inv);
            *(u32x2*)(Outw + (size_t)r32e * DM + 8 * g + 4 * hie) = w0;
            *(u32x2*)(Outw + (size_t)r32e * DM + 32 + 8 * g + 4 * hie) = w1;
        }
    }
}
__device__ __forceinline__ void attn_b_block(const bf16_t* Qw, const bf16_t* Kb, const bf16_t* Vtb, int ldv, int T, int tlim, float nshift, float lam, float post, const float* gsub,
                                             bf16_t* Outw, LAS unsigned char* lds, int wave, int lane_in) {
    int lane = lane_in; asm volatile("" : "+v"(lane));
    const int r32 = lane & 31, hi = lane >> 5;
    LAS bf16x8* Qs = (LAS bf16x8*)(lds + ATT_WAVE + wave * 8192);
    if (tlim > 0) {
#pragma unroll
        for (int m = 0; m < 2; ++m)
#pragma unroll
            for (int d0 = 0; d0 < 4; ++d0) Qs[(m * 4 + d0) * 64 + lane] = *(const bf16x8*)(Qw + (size_t)r32 * 512 + 64 * m + 16 * d0 + 8 * hi);
    }
    f32x16 o1[4], o2[4];
#pragma unroll
    for (int db = 0; db < 4; ++db)
#pragma unroll
        for (int r = 0; r < 16; ++r) { o1[db][r] = 0.f; o2[db][r] = 0.f; }
    float l1 = 0.f, l2 = 0.f;
    const int key_l = 8 * wave + (lane & 7), c8 = lane >> 3;
    const bf16_t* kg = Kb + (size_t)key_l * 512 + 8 * c8;
    const int koff = ((key_l >> 5) * 8 + (c8 >> 1)) * 1024 + (swap23(key_l & 31) + 32 * (c8 & 1)) * 16;
    const int d_l = 16 * wave + (lane & 7);
    const bf16_t* vg = Vtb + (size_t)d_l * ldv + 8 * c8;
    const int voff = 16384 + (((c8 >> 2) * 4 + (d_l >> 5)) * 2 + ((c8 >> 1) & 1)) * 1024 + ((d_l & 31) + 32 * (c8 & 1)) * 16;
    u32x4 sk0 = *(const u32x4*)kg, sk1 = *(const u32x4*)(kg + 64), sv0 = *(const u32x4*)vg, sv1 = *(const u32x4*)(vg + (size_t)8 * ldv);
    *(LAS u32x4*)(lds + koff) = sk0; *(LAS u32x4*)(lds + koff + 4096) = sk1; *(LAS u32x4*)(lds + voff) = sv0; *(LAS u32x4*)(lds + voff + 128) = sv1;
    __syncthreads();
    for (int t = 0; t < T; ++t) {
        const bool more = t + 1 < T;
        if (more) {
            const bf16_t* kn = kg + (size_t)(t + 1) * 64 * 512; const bf16_t* vn = vg + (t + 1) * 64;
            sk0 = *(const u32x4*)kn; sk1 = *(const u32x4*)(kn + 64); sv0 = *(const u32x4*)vn; sv1 = *(const u32x4*)(vn + (size_t)8 * ldv);
        }
        if (t < tlim) {
            const LAS bf16x8* KF = (const LAS bf16x8*)(lds + (t & 1) * ATT_BUF);
            const LAS bf16x8* VF = KF + 1024;
#pragma unroll
            for (int j = 0; j < 2; ++j) {
                bf16x8 pa[2], pb[2];
                {
                    f32x16 sa;
#pragma unroll
                    for (int r = 0; r < 16; ++r) sa[r] = nshift;
#pragma unroll
                    for (int d0 = 0; d0 < 4; ++d0) sa = mfma32(KF[((j * 2 + 0) * 4 + d0) * 64 + lane], Qs[d0 * 64 + lane], sa);
                    float ps = 0.f;
#pragma unroll
                    for (int r = 0; r < 16; ++r) { sa[r] = fast_exp2(sa[r]); ps += sa[r]; }
                    l1 += ps; pa[0] = pack8(sa, 0); pa[1] = pack8(sa, 1);
                }
                {
                    f32x16 sa;
#pragma unroll
                    for (int r = 0; r < 16; ++r) sa[r] = nshift;
#pragma unroll
                    for (int d0 = 0; d0 < 4; ++d0) sa = mfma32(KF[((j * 2 + 1) * 4 + d0) * 64 + lane], Qs[(4 + d0) * 64 + lane], sa);
                    float ps = 0.f;
#pragma unroll
                    for (int r = 0; r < 16; ++r) { sa[r] = fast_exp2(sa[r]); ps += sa[r]; }
                    l2 += ps; pb[0] = pack8(sa, 0); pb[1] = pack8(sa, 1);
                }
#pragma unroll
                for (int db = 0; db < 4; ++db)
#pragma unroll
                    for (int s = 0; s < 2; ++s) {
                        const bf16x8 vf = VF[((j * 4 + db) * 2 + s) * 64 + lane];
                        o1[db] = mfma32(vf, pa[s], o1[db]); o2[db] = mfma32(vf, pb[s], o2[db]);
                    }
            }
        }
        if (more) {
            LAS unsigned char* nb = lds + ((t + 1) & 1) * ATT_BUF;
            *(LAS u32x4*)(nb + koff) = sk0; *(LAS u32x4*)(nb + koff + 4096) = sk1; *(LAS u32x4*)(nb + voff) = sv0; *(LAS u32x4*)(nb + voff + 128) = sv1;
        }
        __syncthreads();
    }
    if (tlim > 0) {
        const int le = lane_id_fresh(), r32e = le & 31, hie = le >> 5;
        l1 += shx(l1, le, 32); l2 += shx(l2, le, 32);
        const float i1 = 1.0f / l1, i2 = lam / l2;
        float ss = 0.f;
#pragma unroll
        for (int db = 0; db < 4; ++db)
#pragma unroll
            for (int r = 0; r < 16; ++r) { const float v = o1[db][r] * i1 - o2[db][r] * i2; o1[db][r] = v; ss += v * v; }
        ss += shx(ss, le, 32);
        const float rr = rsqrtf(ss * (1.0f / 128.0f) + EPS) * post;
#pragma unroll
        for (int db = 0; db < 4; ++db)
#pragma unroll
            for (int g = 0; g < 4; ++g) {
                const int d = 32 * db + 8 * g + 4 * hie;
                const f32x4 gs = *(const f32x4*)(gsub + d);
                u32x2 w; w.x = cvt_pk_bf16(o1[db][4 * g] * rr * gs[0], o1[db][4 * g + 1] * rr * gs[1]); w.y = cvt_pk_bf16(o1[db][4 * g + 2] * rr * gs[2], o1[db][4 * g + 3] * rr * gs[3]);
                *(u32x2*)(Outw + (size_t)r32e * DM + d) = w;
            }
    }
}
__device__ __forceinline__ void attn_bs_block(KArgP A, int l, int b, int h, float nshift, float lam, float post, const float* gsub, LAS unsigned char* lds, int wave, int lane_in) {
    int lane = lane_in; asm volatile("" : "+v"(lane));
    unsigned char* ws = A->ws;
    const int lb = l * 32 + b;
    constexpr int T = 33;
    const float* ck = A->in[4] + (size_t)lb * 2048 * 512 + h * 128;
    const float* cv = A->in[5] + (size_t)lb * 2048 * 512 + h * 128;
    const bf16_t* nk = (const bf16_t*)(ws + WS_KSB) + ((size_t)lb * KSB_ROWS + 2048) * 512 + h * 128;
    const bf16_t* nv = (const bf16_t*)(ws + WS_VSB) + ((size_t)lb * 512 + h * 128) * KSB_ROWS + 2048;
    const int li = (wave - 2) * 64 + lane;
#define BS_FILL(t) do { \
        LAS unsigned char* fb = lds + ((t) & 1) * ATT_BUF; \
        if ((t) < 32) { \
            _Pragma("unroll") for (int i = 0; i < 3; ++i) { const int ci = li + 384 * i; \
                if (ci < 1024) { const int key = ci >> 4, c16 = ci & 15, c8 = c16 & 7; \
                    const float* src = ck + (size_t)(64 * (t) + key) * 512 + 8 * c16; \
                    const f32x4 a = *(const f32x4*)src, c = *(const f32x4*)(src + 4); \
                    u32x4 w; w.x = cvt_pk_bf16(a[0], a[1]); w.y = cvt_pk_bf16(a[2], a[3]); w.z = cvt_pk_bf16(c[0], c[1]); w.w = cvt_pk_bf16(c[2], c[3]); \
                    *(LAS u32x4*)(fb + ((key >> 5) * 8 + (c16 >> 3) * 4 + (c8 >> 1)) * 1024 + (swap23(key & 31) + 32 * (c8 & 1)) * 16) = w; } } \
            if (li < 256) { const int g = li >> 5, d4 = li & 31; \
                f32x4 r[8]; \
                _Pragma("unroll") for (int kk = 0; kk < 8; ++kk) r[kk] = *(const f32x4*)(cv + (size_t)(64 * (t) + 8 * g + kk) * 512 + 4 * d4); \
                _Pragma("unroll") for (int i = 0; i < 4; ++i) { const int d = 4 * d4 + i; \
                    u32x4 w; w.x = cvt_pk_bf16(r[0][i], r[1][i]); w.y = cvt_pk_bf16(r[2][i], r[3][i]); w.z = cvt_pk_bf16(r[4][i], r[5][i]); w.w = cvt_pk_bf16(r[6][i], r[7][i]); \
                    *(LAS u32x4*)(fb + 16384 + (((g >> 2) * 4 + (d >> 5)) * 2 + ((g >> 1) & 1)) * 1024 + ((d & 31) + 32 * (g & 1)) * 16) = w; } } \
        } else { \
            _Pragma("unroll") for (int i = 0; i < 3; ++i) { const int ci = li + 384 * i; \
                if (ci < 1024) { const int key = ci >> 4, c16 = ci & 15, c8 = c16 & 7; \
                    const u32x4 w = *(const u32x4*)(nk + (size_t)key * 512 + 8 * c16); \
                    *(LAS u32x4*)(fb + ((key >> 5) * 8 + (c16 >> 3) * 4 + (c8 >> 1)) * 1024 + (swap23(key & 31) + 32 * (c8 & 1)) * 16) = w; \
                    const int d = ci >> 3, g = ci & 7; \
                    const u32x4 v = *(const u32x4*)(nv + (size_t)d * KSB_ROWS + 8 * g); \
                    *(LAS u32x4*)(fb + 16384 + (((g >> 2) * 4 + (d >> 5)) * 2 + ((g >> 1) & 1)) * 1024 + ((d & 31) + 32 * (g & 1)) * 16) = v; } } \
        } \
    } while (0)
    if (wave >= 2) {
        BS_FILL(0);
        __syncthreads();
        for (int t = 0; t < T; ++t) {
            if (t + 1 < T) BS_FILL(t + 1);
            __syncthreads();
        }
    } else {
        const int r32 = lane & 31, hi = lane >> 5;
        const int row0 = MP + b * 64 + 32 * wave;
        const bf16_t* Qw = (const bf16_t*)(ws + WS_QB) + (size_t)row0 * 512 + h * 128;
        LAS bf16x8* Qs = (LAS bf16x8*)(lds + ATT_WAVE + wave * 8192);
#pragma unroll
        for (int m = 0; m < 2; ++m)
#pragma unroll
            for (int d0 = 0; d0 < 4; ++d0) Qs[(m * 4 + d0) * 64 + lane] = *(const bf16x8*)(Qw + (size_t)r32 * 512 + 64 * m + 16 * d0 + 8 * hi);
        f32x16 o1[4], o2[4];
#pragma unroll
        for (int db = 0; db < 4; ++db)
#pragma unroll
            for (int r = 0; r < 16; ++r) { o1[db][r] = 0.f; o2[db][r] = 0.f; }
        float l1 = 0.f, l2 = 0.f;
        __syncthreads();
        for (int t = 0; t < T; ++t) {
            const LAS bf16x8* KF = (const LAS bf16x8*)(lds + (t & 1) * ATT_BUF);
            const LAS bf16x8* VF = KF + 1024;
#pragma unroll
            for (int j = 0; j < 2; ++j) {
                bf16x8 pa[2], pb[2];
                {
                    f32x16 sa;
#pragma unroll
                    for (int r = 0; r < 16; ++r) sa[r] = nshift;
#pragma unroll
                    for (int d0 = 0; d0 < 4; ++d0) sa = mfma32(KF[((j * 2 + 0) * 4 + d0) * 64 + lane], Qs[d0 * 64 + lane], sa);
                    float ps = 0.f;
#pragma unroll
                    for (int r = 0; r < 16; ++r) { sa[r] = fast_exp2(sa[r]); ps += sa[r]; }
                    l1 += ps; pa[0] = pack8(sa, 0); pa[1] = pack8(sa, 1);
                }
                {
                    f32x16 sa;
#pragma unroll
                    for (int r = 0; r < 16; ++r) sa[r] = nshift;
#pragma unroll
                    for (int d0 = 0; d0 < 4; ++d0) sa = mfma32(KF[((j * 2 + 1) * 4 + d0) * 64 + lane], Qs[(4 + d0) * 64 + lane], sa);
                    float ps = 0.f;
#pragma unroll
                    for (int r = 0; r < 16; ++r) { sa[r] = fast_exp2(sa[r]); ps += sa[r]; }
                    l2 += ps; pb[0] = pack8(sa, 0); pb[1] = pack8(sa, 1);
                }
#pragma unroll
                for (int db = 0; db < 4; ++db)
#pragma unroll
                    for (int s = 0; s < 2; ++s) {
                        const bf16x8 vf = VF[((j * 4 + db) * 2 + s) * 64 + lane];
                        o1[db] = mfma32(vf, pa[s], o1[db]); o2[db] = mfma32(vf, pb[s], o2[db]);
                    }
            }
            __syncthreads();
        }
        const int le = lane_id_fresh(), r32e = le & 31, hie = le >> 5;
        l1 += shx(l1, le, 32); l2 += shx(l2, le, 32);
        const float i1 = 1.0f / l1, i2 = lam / l2;
        float ss = 0.f;
#pragma unroll
        for (int db = 0; db < 4; ++db)
#pragma unroll
            for (int r = 0; r < 16; ++r) { const float v = o1[db][r] * i1 - o2[db][r] * i2; o1[db][r] = v; ss += v * v; }
        ss += shx(ss, le, 32);
        const float rr = rsqrtf(ss * (1.0f / 128.0f) + EPS) * post;
        bf16_t* Outw = (bf16_t*)(ws + WS_O) + (size_t)row0 * DM + 512 + h * 128;
#pragma unroll
        for (int db = 0; db < 4; ++db)
#pragma unroll
            for (int g = 0; g < 4; ++g) {
                const int d = 32 * db + 8 * g + 4 * hie;
                const f32x4 gs = *(const f32x4*)(gsub + d);
                u32x2 w; w.x = cvt_pk_bf16(o1[db][4 * g] * rr * gs[0], o1[db][4 * g + 1] * rr * gs[1]); w.y = cvt_pk_bf16(o1[db][4 * g + 2] * rr * gs[2], o1[db][4 * g + 3] * rr * gs[3]);
                *(u32x2*)(Outw + (size_t)r32e * DM + d) = w;
            }
    }
#undef BS_FILL
}
constexpr int U_BS = 128, U_BP = 512, U_AP = 1024, U_AS = 256, U_B = U_BS + U_BP, U_ALL = U_B + U_AP + U_AS;
__device__ __forceinline__ void attn_phase(KArgP A, int l, LAS unsigned char* lds, int wave, int cidx) {
    unsigned char* ws = A->ws;
    unsigned* ctr = (unsigned*)(ws + WS_CTL) + cidx;
    const float* cst = (const float*)(ws + WS_CTL + 4096) + l * 8;
#define SGPR_F(x) __builtin_bit_cast(float, __builtin_amdgcn_readfirstlane(__builtin_bit_cast(int, (x))))
    const float shA = SGPR_F(cst[0]), shB = SGPR_F(cst[1]), lam = SGPR_F(cst[2]), post = SGPR_F(cst[3]);
#undef SGPR_F
    volatile LAS int* bw = (volatile LAS int*)(lds + ATT_BW);
    const bf16_t* QA = (const bf16_t*)(ws + WS_QA); const bf16_t* QB = (const bf16_t*)(ws + WS_QB);
    bf16_t* O = (bf16_t*)(ws + WS_O);
    const float* bias = A->in[16] + (size_t)l * 8 * 257;
    const float* gsub = A->in[21] + l * 128;
    for (;;) {
        int lane_l = lane_id_fresh(); asm volatile("" : "+v"(lane_l)); const int lane = lane_l;
        __syncthreads();
        if (wave == 0 && lane == 0) bw[0] = (int)atomicAdd(ctr, 1u);
        __syncthreads();
        const int uid = __builtin_amdgcn_readfirstlane(bw[0]);
        if (uid >= U_ALL) break;
        if (uid < U_BS) {
            attn_bs_block(A, l, uid >> 2, uid & 3, -shB, lam, post, gsub, lds, wave, lane);
        } else if (uid < U_B) {
            int b, h, T, tlim, row0, ldv; const bf16_t* K; const bf16_t* Vt;
            if (uid < U_BS) { b = uid >> 2; h = uid & 3; T = 33; tlim = wave < 2 ? 33 : 0; row0 = MP + b * 64 + 32 * (wave & 1); ldv = KSB_ROWS;
                K = (const bf16_t*)(ws + WS_KSB) + (size_t)(l * 32 + b) * KSB_ROWS * 512 + h * 128;
                Vt = (const bf16_t*)(ws + WS_VSB) + ((size_t)(l * 32 + b) * 512 + h * 128) * KSB_ROWS; }
            else { const int v = uid - U_BS, qb = 7 - (v >> 6), w = v & 63; b = w >> 2; h = w & 3; T = 4 * qb + 4; tlim = 4 * qb + (wave >> 1) + 1; row0 = b * 2048 + 256 * qb + 32 * wave; ldv = 2048;
                K = (const bf16_t*)(ws + WS_KBP) + (size_t)b * 2048 * 512 + h * 128;
                Vt = (const bf16_t*)(ws + WS_VBP) + ((size_t)b * 512 + h * 128) * 2048; }
            attn_b_block(QB + (size_t)row0 * 512 + h * 128, K, Vt, ldv, T, tlim, -shB, lam, post, gsub, O + (size_t)row0 * DM + 512 + h * 128, lds, wave, lane);
        } else {
            int b, h, T, t_lo, t_hi, t_self, row0, ldv; const bf16_t* K; const bf16_t* Vt;
            if (uid < U_B + U_AP) { const int v = uid - U_B, cq = 7 - (v >> 7), w = v & 127; b = w >> 3; h = w & 7;
                const int kc0 = cq >= 2 ? 4 * cq - 8 : 0, cw = 4 * cq + (wave >> 1);
                T = 4 * cq + 4 - kc0; t_self = cw - kc0; t_hi = t_self; t_lo = cw - 8 - kc0 > 0 ? cw - 8 - kc0 : 0; row0 = b * 2048 + 256 * cq + 32 * wave; ldv = 2048;
                K = (const bf16_t*)(ws + WS_KAP) + ((size_t)b * 2048 + 64 * kc0) * 512 + h * 64;
                Vt = (const bf16_t*)(ws + WS_VAP) + ((size_t)b * 512 + h * 64) * 2048 + 64 * kc0; }
            else { const int v = uid - U_B - U_AP; b = v >> 3; h = v & 7; T = 9; t_self = 8; t_lo = wave < 2 ? 0 : 1; t_hi = wave < 2 ? 8 : 0; row0 = MP + b * 64 + 32 * (wave & 1); ldv = KSA_ROWS;
                K = (const bf16_t*)(ws + WS_KSA) + (size_t)(l * 32 + b) * KSA_ROWS * 512 + h * 64;
                Vt = (const bf16_t*)(ws + WS_VSA) + ((size_t)(l * 32 + b) * 512 + h * 64) * KSA_ROWS; }
            LAS float* E = (LAS float*)(lds + ATT_WAVE + wave * 8192);
#pragma unroll
            for (int j = 0; j < 5; ++j) { const int i = lane + 64 * j; int rel = i - 64; rel = rel < -128 ? -128 : (rel > 128 ? 128 : rel); E[i] = LOG2E * bias[h * 257 + rel + 128] - shA; }
            attn_a_block(QA + (size_t)row0 * 512 + h * 64, K, Vt, ldv, T, t_lo, t_hi, t_self, 32 * (wave & 1), O + (size_t)row0 * DM + h * 64, lds, wave, lane);
        }
    }
}

__device__ __forceinline__ bool in_phase(int p) { KArgP k = (KArgP)__builtin_amdgcn_kernarg_segment_ptr(); asm volatile("" : "+s"(k)); return k->ph_lo <= p && p < k->ph_hi; }
__global__ void __launch_bounds__(512, 2) mega_fwd(Args KA) {
    extern __shared__ __attribute__((aligned(16))) unsigned char lds_raw[];
    LAS unsigned char* lds = (LAS unsigned char*)lds_raw;
    const int tid = threadIdx.x, wave = __builtin_amdgcn_readfirstlane(tid >> 6);
    const int G = gridDim.x, bx = blockIdx.x;
    const int vcu = (G % 8 == 0) ? (bx % 8) * (G / 8) + bx / 8 : bx;
    (void)KA;
    if (tid == 0) { ((volatile LAS unsigned*)(lds + ATT_BW + 64))[0] = 0u; ((volatile LAS unsigned*)(lds + ATT_BW + 64))[1] = 0u; ((volatile LAS unsigned*)(lds + ATT_BW + 64))[2] = (unsigned)bx; }
    __syncthreads();
#define FRESH_KAP(name) KArgP name = (KArgP)__builtin_amdgcn_kernarg_segment_ptr(); asm volatile("" : "+s"(name))
#define IN_PH(p) in_phase(p)
#define SEAM(p) do { FRESH_KAP(ks_); if (ks_->coop && (p) + 1 < ks_->ph_hi) { XcdBarrier xb_; xb_.bar = (unsigned*)(ks_->ws + WS_BAR); xb_.x = xb_xcc_id(); xb_.st = (volatile LAS unsigned*)(lds + ATT_BW + 64); xcd_barrier(xb_); } } while (0)
#define KARGS() KArgP kap = (KArgP)__builtin_amdgcn_kernarg_segment_ptr(); asm volatile("" : "+s"(kap)); unsigned char* ws = kap->ws; float* out = kap->out; \
    float* ssq = (float*)(ws + WS_SSQ); bf16_t* xb = (bf16_t*)(ws + WS_XB); bf16_t* ab = (bf16_t*)(ws + WS_A); unsigned char* wl = ws + WS_W + (size_t)l * W_LAYER; (void)ssq; (void)xb; (void)ab; (void)wl; (void)out; \
    const int cx = __builtin_amdgcn_readfirstlane((int)((volatile LAS unsigned*)(lds + ATT_BW + 64))[2])
    if (IN_PH(0)) {
        KArgP kap = (KArgP)__builtin_amdgcn_kernarg_segment_ptr(); asm volatile("" : "+s"(kap));
        prologue(kap, lds, vcu * 8 + wave, G * 8, wave);
#ifdef PROBE_PRO2
        prologue(kap, lds, vcu * 8 + wave, G * 8, wave);
#endif
        { FRESH_KAP(ks_); if (ks_->coop && 1 < ks_->ph_hi) { cg::this_grid().sync();
            if (tid == 0) { unsigned* bar_ = (unsigned*)(ks_->ws + WS_BAR); const unsigned x_ = xb_xcc_id(); const unsigned r_ = xb_add(&bar_[XB_XCNT(x_)], 1u);
                if (G == 256 && r_ < 32u && x_ < 8u) ((volatile LAS unsigned*)(lds + ATT_BW + 64))[2] = r_ * 8u + x_; }
            __syncthreads(); } }
    }
#pragma unroll 1
    for (int l = 0; l < 2; ++l) {
        const int p0 = 1 + 7 * l;
        if (IN_PH(p0 + 0)) {
            KARGS();
            pg8::Gemm g{xb, (const bf16_t*)(wl + W_GU1), MT, 2 * DFF, DM, DM, 0};
            pg8::StaticOrder S; S.init(MT, 2 * DFF, G, cx);
            EpiSwiGLU E{ab, ssq + (size_t)(3 * l) * MT};
            pg8::gemm_phase<EpiSwiGLU, pg8::StaticOrder, true, true>(lds, g, S, E, wave);
#ifdef PROBE_UP2
            pg8::gemm_phase<EpiSwiGLU, pg8::StaticOrder, true, true>(lds, g, S, E, wave);
#endif
            SEAM(p0 + 0);
        }
        if (IN_PH(p0 + 1)) {
            KARGS();
            pg8::Gemm g{ab, (const bf16_t*)(wl + W_D1), MT, DM, DFF, LDP, 2};
            pg8::TailSplitOrder S; S.init(MT, DM, G, cx, 0, DOWN_WGM);
            EpiResid E{kap->in[0], kap->in[1], out, xb, ssq + (size_t)(3 * l + 1) * MT, 0.5f, 1, 0};
            pg8::gemm_phase<EpiResid, pg8::TailSplitOrder, true, true>(lds, g, S, E, wave);
            SEAM(p0 + 1);
        }
        if (IN_PH(p0 + 2)) {
            {
                KARGS();
                pg8::Gemm g{xb, (const bf16_t*)(wl + W_IN), MT, 2048, DM, DM, 0};
                pg8::TailSplitOrder S; S.init(MT, 2048, G, cx);
                EpiQK E{ssq + (size_t)(3 * l + 1) * MT, ws, out, kap, l};
                pg8::gemm_phase<EpiQK, pg8::TailSplitOrder, true, true>(lds, g, S, E, wave);
#ifdef PROBE_QK2
                pg8::gemm_phase<EpiQK, pg8::TailSplitOrder, true, true>(lds, g, S, E, wave);
#endif
            }
            {
                KARGS();
                pg8::Gemm g{(const bf16_t*)(wl + W_IN) + (size_t)2048 * DM, xb, 1024, MT, DM, DM, 0};
                pg8::TailSplitOrder S; S.init(1024, MT, G, cx);
                EpiVt E{ssq + (size_t)(3 * l + 1) * MT, ws, out, l};
                pg8::gemm_phase<EpiVt, pg8::TailSplitOrder, true, true>(lds, g, S, E, wave);
#ifdef PROBE_VT2
                pg8::gemm_phase<EpiVt, pg8::TailSplitOrder, true, true>(lds, g, S, E, wave);
#endif
            }
            SEAM(p0 + 2);
        }
        if (IN_PH(p0 + 3)) {
            KArgP kap = (KArgP)__builtin_amdgcn_kernarg_segment_ptr(); asm volatile("" : "+s"(kap));
            attn_phase(kap, l, lds, wave, l);
#ifdef PROBE_ATTN2
            attn_phase(kap, l, lds, wave, 2 + l);
#endif
            SEAM(p0 + 3);
        }
        if (IN_PH(p0 + 4)) {
            KARGS();
            pg8::Gemm g{(const bf16_t*)(ws + WS_O), (const bf16_t*)(wl + W_OUT), MT, DM, DM, DM, 0};
            pg8::TailSplitOrder S; S.init(MT, DM, G, cx);
            EpiResid E{out, out + (size_t)MP * DM, out, xb, ssq + (size_t)(3 * l + 2) * MT, 1.0f, 1, 0};
            pg8::gemm_phase<EpiResid, pg8::TailSplitOrder, true, true>(lds, g, S, E, wave);
            SEAM(p0 + 4);
        }
        if (IN_PH(p0 + 5)) {
            KARGS();
            pg8::Gemm g{xb, (const bf16_t*)(wl + W_GU2), MT, 2 * DFF, DM, DM, 0};
            pg8::StaticOrder S; S.init(MT, 2 * DFF, G, cx);
            EpiSwiGLU E{ab, ssq + (size_t)(3 * l + 2) * MT};
            pg8::gemm_phase<EpiSwiGLU, pg8::StaticOrder, true, true>(lds, g, S, E, wave);
            SEAM(p0 + 5);
        }
        if (IN_PH(p0 + 6)) {
            KARGS();
            pg8::Gemm g{ab, (const bf16_t*)(wl + W_D2), MT, DM, DFF, LDP, 2};
            pg8::TailSplitOrder S; S.init(MT, DM, G, cx, 0, DOWN_WGM);
            EpiResid E{out, out + (size_t)MP * DM, out, xb, ssq + (size_t)(3 * l + 3) * MT, 0.5f, 1, l == 1 ? 1 : 0};
            pg8::gemm_phase<EpiResid, pg8::TailSplitOrder, true, true>(lds, g, S, E, wave);
            SEAM(p0 + 6);
        }
    }
}

#ifndef N_LAUNCH_MODE_GUARD_
#define N_LAUNCH_MODE_GUARD_
#endif
#ifndef N_LAUNCH_MODE
#define N_LAUNCH_MODE 0
#endif
extern "C" void kernel_launch(void* const* d_in, const int* in_sizes, int n_in, void* d_out, int out_size, void* d_ws, size_t ws_size, hipStream_t stream) {
    static int grid = 0;
    if (grid == 0) {
        if (n_in != 27 || ws_size < WS_END) { fprintf(stderr, "kernel_launch: unexpected inputs (n_in %d, ws %zu)\n", n_in, ws_size); grid = -1; return; }
        int dev = 0, cus = 0, per_cu = 0;
        hipGetDevice(&dev);
        hipDeviceGetAttribute(&cus, hipDeviceAttributeMultiprocessorCount, dev);
        hipFuncSetAttribute((const void*)mega_fwd, hipFuncAttributeMaxDynamicSharedMemorySize, LDS_BYTES);
        hipOccupancyMaxActiveBlocksPerMultiprocessor(&per_cu, (const void*)mega_fwd, 512, LDS_BYTES);
        (void)hipGetLastError();
        if (per_cu < 1) per_cu = 1;
        grid = cus;
        if (grid != 256) fprintf(stderr, "kernel_launch: note: %d CUs\n", grid);
    }
    if (grid < 0) return;
    Args a{};
    for (int i = 0; i < 27; ++i) a.in[i] = (const float*)d_in[i];
    a.out = (float*)d_out; a.ws = (unsigned char*)d_ws;
#if N_LAUNCH_MODE == 1
    for (int ph = 0; ph < NPHASE; ++ph) {
        a.ph_lo = ph; a.ph_hi = ph + 1; a.coop = 0;
        hipLaunchKernelGGL(mega_fwd, dim3(grid), dim3(512), LDS_BYTES, stream, a);
    }
#else
    a.ph_lo = 0; a.ph_hi = NPHASE; a.coop = 1;
    void* args[] = {&a};
    hipError_t e = hipLaunchCooperativeKernel((const void*)mega_fwd, dim3(grid), dim3(512), args, LDS_BYTES, stream);
    if (e != hipSuccess) fprintf(stderr, "cooperative launch failed: %s (grid %d)\n", hipGetErrorString(e), grid);
#endif
}
```

```cpp
#include <hip/hip_runtime.h>
#include <hip/hip_cooperative_groups.h>
#include <cstdio>
#include <cstdint>
#include <cstddef>
namespace cg = cooperative_groups;
__device__ __forceinline__ int lane_id_fresh() { int l; asm volatile("v_mbcnt_lo_u32_b32 %0, -1, 0\n\tv_mbcnt_hi_u32_b32 %0, -1, %0" : "=v"(l)); return l; }
#ifndef PG8_PFD
#define PG8_PFD 4
#endif
namespace pg8 {
#define PG8_LAS __attribute__((address_space(3)))
typedef unsigned short bf16_t;
typedef short bf16x8 __attribute__((ext_vector_type(8)));
typedef float f32x4 __attribute__((ext_vector_type(4)));
typedef unsigned u32x4 __attribute__((ext_vector_type(4)));
constexpr int BM = 256, BK = 64, HALF = 128, HTB = HALF * BK * 2  , STAGE_BYTES = 8 * HTB, NXCD = 8, WGM = 8;

__host__ __device__ __forceinline__ int lds_byte(int r, int c) { const int st = (r >> 4) * 2 + (c >> 5), rr = r & 15, cc = c & 31, ob = rr * 64 + cc * 2; return st * 1024 + (ob ^ (((ob >> 9) & 1) << 5)); }
__host__ __device__ __forceinline__ void stage_rc(int b, int& R, int& C) { const int st = b / 1024, sb = b % 1024, swz = sb ^ (((sb >> 9) & 1) << 5); R = (st >> 1) * 16 + swz / 64; C = (st & 1) * 32 + (swz % 64) / 2; }
__host__ __device__ __forceinline__ int perm32(int rho) { const int n = rho >> 4, i = rho & 15; return 8 * (i >> 2) + 4 * n + (i & 3); }

struct Unit { int pm, pn, hm; };
struct Gemm { const bf16_t* A; const bf16_t* Bt; int M, N, K, ld; int blocked; };

struct StaticOrder {
    int nM, nN, nwg, G, c, rev, wgm;
    __host__ __device__ void init(int M, int N, int G_, int c_, int rev_ = 0, int wgm_ = WGM) { nM = M / BM; nN = N / BM; nwg = nM * nN; G = G_; c = c_; rev = rev_; wgm = wgm_; }
    __host__ __device__ __forceinline__ void tile(int wgid, Unit& u) const {
        { const int q = nwg / NXCD, r = nwg % NXCD, xcd = wgid % NXCD, off = wgid / NXCD; wgid = (xcd < r ? xcd * (q + 1) : r * (q + 1) + (xcd - r) * q) + off; }
        const int nig = wgm * nN, gid = wgid / nig, fm = gid * wgm, gsz = (nM - fm) < wgm ? (nM - fm) : wgm;
        u.pm = fm + ((wgid % nig) % gsz); u.pn = (wgid % nig) / gsz; u.hm = 3;
        if (rev) u.pm = nM - 1 - u.pm;
    }
    __host__ __device__ bool next(int i, Unit& u) const {
        const long L = (long)i * G + c; if (L >= nwg) return false;
        tile((int)L, u); return true;
    }
    __device__ __forceinline__ void a_ready(const Unit&) const {}
    __device__ __forceinline__ void done(const Unit&) const {}
};
struct TailSplitOrder : StaticOrder {
    __host__ __device__ bool next(int i, Unit& u) const {
        const int nfull = (nwg / G) * G, L = i * G + c;
        if (L < nfull) { tile(L, u); return true; }
        const int idx = L - nfull;
        if (idx >= 2 * (nwg - nfull)) return false;
        tile(nfull + (idx >> 1), u); u.hm = 1 << (idx & 1); return true;
    }
};

__device__ __forceinline__ unsigned cvt_pk_bf16(float lo, float hi) { unsigned r; asm volatile("v_cvt_pk_bf16_f32 %0, %1, %2" : "=v"(r) : "v"(lo), "v"(hi)); return r; }
typedef float f32x2 __attribute__((ext_vector_type(2)));
template <class Epi, class Sched, bool ALIGN_EPI = false, bool SP2 = false>
__device__ __forceinline__ void gemm_phase(PG8_LAS unsigned char* lds, const Gemm g, const Sched& S, const Epi& E, int wave_in) {
    int tid_l = wave_in * 64 + lane_id_fresh(); asm volatile("" : "+v"(tid_l));
    const int tid = tid_l, wid = __builtin_amdgcn_readfirstlane(tid >> 6), lane = tid & 63, wr = wid >> 2, wc = wid & 3, fr = lane & 15, fq = lane >> 4;
    const int nt = g.K / BK, K = g.blocked ? BK : g.ld;
    unsigned voffA[2], voffB[2];
#pragma unroll
    for (int i = 0; i < 2; ++i) { int R, C; stage_rc(tid * 16 + i * 8192, R, C); const int Rb = Epi::PERM ? ((R & ~31) + perm32(R & 31)) : R;
        voffA[i] = (unsigned)(R * K + C) * 2u; voffB[i] = (unsigned)(Rb * K + C) * 2u;
        if (g.blocked == 2) { voffA[i] = (unsigned)(tid * 16 + i * 8192); voffB[i] = voffA[i]; } }
    const size_t kstep = g.blocked ? (size_t)(BM * BK * 2) : (size_t)(BK * 2);
    const size_t hstep = (size_t)HALF * K * 2;
    const size_t tstep = g.blocked ? (size_t)nt * (BM * BK * 2) : 2 * hstep;
    const unsigned ldsw = (unsigned)wid * 1024u;
    const int aoff = lds_byte(wr * 64 + fr, fq * 8), boff = lds_byte(wc * 32 + fr, fq * 8);
#define PG8_SA(b, h) (((b) * 2 + (h)) * HTB)
#define PG8_SB(b, h) ((4 + (b) * 2 + (h)) * HTB)
#define PG8_STAGE(bufoff, gbase, voff) do { _Pragma("unroll") for (int _i = 0; _i < 2; ++_i) \
        __builtin_amdgcn_global_load_lds((const unsigned*)((const char*)(gbase) + (voff)[_i]), (PG8_LAS unsigned*)(lds + (bufoff) + ldsw + _i * 8192), 16, 0, 0); } while (0)
#define PG8_LDA(dst, b, h) do { _Pragma("unroll") for (int m = 0; m < 4; ++m) _Pragma("unroll") for (int k = 0; k < 2; ++k) dst[m][k] = *(const PG8_LAS bf16x8*)(lds + PG8_SA(b, h) + aoff + m * 2048 + k * 1024); } while (0)
#define PG8_LDB(dst, b, h) do { _Pragma("unroll") for (int n = 0; n < 2; ++n) _Pragma("unroll") for (int k = 0; k < 2; ++k) dst[n][k] = *(const PG8_LAS bf16x8*)(lds + PG8_SB(b, h) + boff + n * 2048 + k * 1024); } while (0)
#define PG8_MMA(ai, bj, At, Bt) do { __builtin_amdgcn_s_setprio(1); _Pragma("unroll") for (int m = 0; m < 4; ++m) _Pragma("unroll") for (int n = 0; n < 2; ++n) _Pragma("unroll") for (int k = 0; k < 2; ++k) \
        acc[ai][bj][m][n] = __builtin_amdgcn_mfma_f32_16x16x32_bf16(Bt[n][k], At[m][k], acc[ai][bj][m][n], 0, 0, 0); __builtin_amdgcn_s_setprio(0); } while (0)
#define PG8_WAIT_V(n) asm volatile("s_waitcnt vmcnt(" #n ")" ::: "memory")
#define PG8_WAIT_L(n) asm volatile("s_waitcnt lgkmcnt(" #n ")" ::: "memory")
#define PG8_BAR __builtin_amdgcn_s_barrier()
#define PG8_SCHED __builtin_amdgcn_sched_barrier(0)
    Unit cur, nxt; int ui = 0;
    if (!S.next(0, cur)) return;
    f32x4 acc[2][2][4][2];
#pragma unroll
    for (int a = 0; a < 2; ++a)
#pragma unroll
        for (int b = 0; b < 2; ++b)
#pragma unroll
            for (int m = 0; m < 4; ++m)
#pragma unroll
                for (int n = 0; n < 2; ++n) acc[a][b][m][n] = (f32x4){0.f, 0.f, 0.f, 0.f};
    bf16x8 At[4][2], B0[2][2], B1[2][2];
    const char* cA = (const char*)g.A + (size_t)cur.pm * tstep; const char* cB = (const char*)g.Bt + (size_t)cur.pn * tstep;
    S.a_ready(cur);
    if constexpr (SP2) {
        PG8_STAGE(PG8_SB(0, 0), cB, voffB); PG8_STAGE(PG8_SB(0, 1), cB + hstep, voffB); PG8_STAGE(PG8_SA(0, 0), cA, voffA); PG8_STAGE(PG8_SA(0, 1), cA + hstep, voffA);
        if (wr == 1) PG8_BAR;
        PG8_WAIT_V(2); PG8_BAR;
        PG8_STAGE(PG8_SB(1, 0), cB + kstep, voffB); PG8_STAGE(PG8_SA(1, 0), cA + kstep, voffA); PG8_STAGE(PG8_SB(1, 1), cB + hstep + kstep, voffB);
        PG8_WAIT_V(6); PG8_BAR;
    } else {
        PG8_STAGE(PG8_SB(0, 0), cB, voffB); PG8_STAGE(PG8_SA(0, 0), cA, voffA); PG8_STAGE(PG8_SB(0, 1), cB + hstep, voffB); PG8_STAGE(PG8_SA(0, 1), cA + hstep, voffA);
        if (wr == 1) PG8_BAR;
        PG8_WAIT_V(4); PG8_BAR;
        PG8_STAGE(PG8_SB(1, 0), cB + kstep, voffB); PG8_STAGE(PG8_SA(1, 0), cA + kstep, voffA); PG8_STAGE(PG8_SB(1, 1), cB + hstep + kstep, voffB);
        PG8_WAIT_V(6); PG8_BAR;
    }
    for (;;) {
        const bool has_next = S.next(ui + 1, nxt);
        const char* nA = has_next ? (const char*)g.A + (size_t)nxt.pm * tstep : cA; const char* nB = has_next ? (const char*)g.Bt + (size_t)nxt.pn * tstep : cB;
        for (int t = 0; t < nt; t += 2) {
            const bool last = (t == nt - 2);
            const char* a1 = cA + (size_t)(t + 1) * kstep;
            const char* a2 = last ? nA : cA + (size_t)(t + 2) * kstep; const char* b2 = last ? nB : cB + (size_t)(t + 2) * kstep;
            const char* a3 = a2 + kstep; const char* b3 = b2 + kstep;
            if (last && has_next) S.a_ready(nxt);
            if constexpr (SP2) {
            PG8_LDB(B0, 0, 0); PG8_LDB(B1, 0, 1); PG8_SCHED; PG8_LDA(At, 0, 0); PG8_STAGE(PG8_SA(1, 1), a1 + hstep, voffA);
            PG8_WAIT_V(8); PG8_WAIT_L(0); PG8_BAR; if (cur.hm & 1) { PG8_MMA(0, 0, At, B0); PG8_MMA(0, 1, At, B1); } PG8_BAR; PG8_SCHED;
            PG8_LDA(At, 0, 1); PG8_STAGE(PG8_SB(0, 0), b2, voffB); PG8_STAGE(PG8_SB(0, 1), b2 + hstep, voffB); PG8_STAGE(PG8_SA(0, 0), a2, voffA);
            PG8_WAIT_V(8); PG8_WAIT_L(0); PG8_BAR; if (cur.hm & 2) { PG8_MMA(1, 0, At, B0); PG8_MMA(1, 1, At, B1); } PG8_BAR; PG8_SCHED;
            PG8_LDB(B0, 1, 0); PG8_LDB(B1, 1, 1); PG8_SCHED; PG8_LDA(At, 1, 0); PG8_STAGE(PG8_SA(0, 1), a2 + hstep, voffA);
            PG8_WAIT_V(8); PG8_WAIT_L(0); PG8_BAR; if (cur.hm & 1) { PG8_MMA(0, 0, At, B0); PG8_MMA(0, 1, At, B1); } PG8_BAR; PG8_SCHED;
            PG8_LDA(At, 1, 1); PG8_STAGE(PG8_SB(1, 0), b3, voffB); PG8_STAGE(PG8_SB(1, 1), b3 + hstep, voffB); PG8_STAGE(PG8_SA(1, 0), a3, voffA);
            PG8_WAIT_V(8); PG8_WAIT_L(0); PG8_BAR; if (cur.hm & 2) { PG8_MMA(1, 0, At, B0); PG8_MMA(1, 1, At, B1); } PG8_BAR; PG8_SCHED;
            } else {
            PG8_LDB(B0, 0, 0); PG8_SCHED; PG8_LDA(At, 0, 0); PG8_STAGE(PG8_SA(1, 1), a1 + hstep, voffA);
            PG8_WAIT_L(8); PG8_BAR; PG8_WAIT_L(0); PG8_MMA(0, 0, At, B0); PG8_BAR; PG8_SCHED;
            PG8_LDB(B1, 0, 1); PG8_STAGE(PG8_SB(0, 0), b2, voffB);
            PG8_BAR; PG8_WAIT_L(0); PG8_MMA(0, 1, At, B1); PG8_BAR;
            PG8_LDA(At, 0, 1); PG8_STAGE(PG8_SA(0, 0), a2, voffA);
            PG8_BAR; PG8_WAIT_L(0); PG8_MMA(1, 0, At, B0); PG8_BAR; PG8_SCHED;
            PG8_STAGE(PG8_SB(0, 1), b2 + hstep, voffB);
            PG8_WAIT_V(6); PG8_BAR; PG8_MMA(1, 1, At, B1); PG8_BAR;
            PG8_LDB(B0, 1, 0); PG8_SCHED; PG8_LDA(At, 1, 0); PG8_STAGE(PG8_SA(0, 1), a2 + hstep, voffA);
            PG8_WAIT_L(8); PG8_BAR; PG8_WAIT_L(0); PG8_MMA(0, 0, At, B0); PG8_BAR; PG8_SCHED;
            PG8_LDB(B1, 1, 1); PG8_STAGE(PG8_SB(1, 0), b3, voffB);
            PG8_BAR; PG8_WAIT_L(0); PG8_MMA(0, 1, At, B1); PG8_BAR;
            PG8_LDA(At, 1, 1); PG8_STAGE(PG8_SA(1, 0), a3, voffA);
            PG8_BAR; PG8_WAIT_L(0); PG8_MMA(1, 0, At, B0); PG8_BAR; PG8_SCHED;
            PG8_STAGE(PG8_SB(1, 1), b3 + hstep, voffB);
            PG8_WAIT_V(6); PG8_BAR; PG8_MMA(1, 1, At, B1); PG8_BAR;
            }
        }
        if constexpr (ALIGN_EPI) { if (wr == 0) PG8_BAR; }
        if constexpr (!Epi::AFTER_DRAIN) { E(acc, cur, wr, wc, fr, fq); S.done(cur); }
        if (!has_next) break;
#pragma unroll
        for (int a = 0; a < 2; ++a)
#pragma unroll
            for (int b = 0; b < 2; ++b)
#pragma unroll
                for (int m = 0; m < 4; ++m)
#pragma unroll
                    for (int n = 0; n < 2; ++n) acc[a][b][m][n] = (f32x4){0.f, 0.f, 0.f, 0.f};
        cur = nxt; cA = nA; cB = nB; ++ui;
        if constexpr (ALIGN_EPI) { if (wr == 1) PG8_BAR; }
    }
    PG8_WAIT_V(0);
    if constexpr (!ALIGN_EPI) { if (wr == 0) PG8_BAR; }
    PG8_BAR;
    if constexpr (Epi::AFTER_DRAIN) { E.fused(acc, cur, wr, wc, fr, fq, lds, wid, lane); S.done(cur); }
#undef PG8_SA
#undef PG8_SB
#undef PG8_STAGE
#undef PG8_LDA
#undef PG8_LDB
#undef PG8_MMA
#undef PG8_WAIT_V
#undef PG8_WAIT_L
#undef PG8_BAR
#undef PG8_SCHED
}
}
using pg8::bf16_t; using pg8::bf16x8; using pg8::f32x4; using pg8::u32x4; using pg8::Unit; using pg8::cvt_pk_bf16;
typedef float f32x16 __attribute__((ext_vector_type(16)));
typedef unsigned u32x2 __attribute__((ext_vector_type(2)));
#define LAS __attribute__((address_space(3)))

constexpr int DM = 1024, SEQ = 2048, DSEQ = 64;
constexpr int MP = 16 * 2048, MS = 32 * 64, MT = MP + MS;
constexpr int DFF = 2816, LDP = 2880;
constexpr int KSA_ROWS = 576, KSB_ROWS = 2112;
constexpr float EPS = 1e-6f, LOG2E = 1.4426950408889634f, QSCALE = 0.125f * 1.4426950408889634f;
constexpr int NPHASE = 15;
#ifndef DOWN_WGM
#define DOWN_WGM 8
#endif
constexpr size_t MiB = 1u << 20;
constexpr size_t WS_CTL = 0, WS_BAR = 65536, WS_SSQ = 1 * MiB, WS_ROPE = 2 * MiB, WS_W = 4 * MiB;
constexpr size_t W_GU1 = 0, W_D1 = 11 * MiB, W_IN = 17 * MiB, W_OUT = 23 * MiB, W_GU2 = 25 * MiB, W_D2 = 36 * MiB, W_LAYER = 42 * MiB;
constexpr size_t WS_XB = 88 * MiB, WS_A = 156 * MiB, WS_QA = WS_A, WS_QB = WS_A + 34 * MiB, WS_O = WS_A + 68 * MiB;
constexpr size_t WS_KAP = 352 * MiB, WS_KBP = 384 * MiB, WS_VAP = 416 * MiB, WS_VBP = 448 * MiB;
constexpr size_t WS_KSA = 480 * MiB, WS_VSA = 516 * MiB, WS_KSB = 552 * MiB, WS_VSB = 684 * MiB, WS_END = 816 * MiB;
static_assert(W_D2 + (size_t)1024 * LDP * 2 <= W_LAYER && WS_W + 2 * W_LAYER <= WS_XB && WS_A + (size_t)MT * LDP * 2 <= WS_KAP, "d_ws map");
constexpr size_t OUT_YP = 0, OUT_YS = 33554432, OUT_PAK = 35651584, OUT_PAV = 44040192, OUT_PBK = 52428800, OUT_PBV = 85983232,
                 OUT_SAK = 119537664, OUT_SAV = 121634816, OUT_SBK = 123731968, OUT_SBV = 125829120;
constexpr int LDS_BYTES = 147456;

struct Args { const float* in[27]; float* out; unsigned char* ws; int ph_lo, ph_hi, coop, pad; };
typedef const __attribute__((address_space(4))) Args* KArgP;

__device__ const double ROPE_INV[32] = {1.0, 0.7498942093324559, 0.5623413251903491, 0.4216965034285822, 0.31622776601683794, 0.23713737056616552, 0.1778279410038923, 0.1333521432163324, 0.1, 0.07498942093324558, 0.05623413251903491, 0.042169650342858224, 0.03162277660168379, 0.023713737056616554, 0.01778279410038923, 0.01333521432163324, 0.01, 0.007498942093324558, 0.005623413251903491, 0.004216965034285823, 0.0031622776601683794, 0.0023713737056616554, 0.0017782794100389228, 0.001333521432163324, 0.001, 0.0007498942093324559, 0.0005623413251903491, 0.00042169650342858224, 0.00031622776601683794, 0.00023713737056616554, 0.00017782794100389227, 0.0001333521432163324};

__device__ __forceinline__ float shx(float v, int lane, int m) { return __builtin_bit_cast(float, __builtin_amdgcn_ds_bpermute((lane ^ m) << 2, __builtin_bit_cast(int, v))); }
__device__ __forceinline__ float wave_sum(float v, int lane) {
#pragma unroll
    for (int o = 1; o < 64; o <<= 1) v += shx(v, lane, o);
    return v;
}
__device__ __forceinline__ float wave_max(float v, int lane) {
#pragma unroll
    for (int o = 1; o < 64; o <<= 1) v = fmaxf(v, shx(v, lane, o));
    return v;
}
__device__ __forceinline__ float fast_rcp(float x) { return __builtin_amdgcn_rcpf(x); }
__device__ __forceinline__ float fast_exp2(float x) { return __builtin_amdgcn_exp2f(x); }

struct EpiSwiGLU {
    static constexpr bool PERM = true, AFTER_DRAIN = false;
    bf16_t* O; const float* ssq;
    __device__ __forceinline__ void operator()(const f32x4 (&acc)[2][2][4][2], const Unit& u, int wr, int wc, int fr, int fq) const {
        const int row0 = u.pm * 256 + wr * 64 + fr, col0 = u.pn * 128 + wc * 32 + 8 * fq;
        float sq[2][4];
#pragma unroll
        for (int ai = 0; ai < 2; ++ai)
#pragma unroll
            for (int m = 0; m < 4; ++m) sq[ai][m] = ssq[row0 + ai * 128 + m * 16];
#pragma unroll
        for (int ai = 0; ai < 2; ++ai)
#pragma unroll
            for (int m = 0; m < 4; ++m) {
                if (!((u.hm >> ai) & 1)) continue;
                const int row = row0 + ai * 128 + m * 16;
                const float rstd = rsqrtf(sq[ai][m] * (1.0f / DM) + EPS);
                float o[8];
#pragma unroll
                for (int n = 0; n < 2; ++n)
#pragma unroll
                    for (int i = 0; i < 4; ++i) {
                        const float g = acc[ai][0][m][n][i] * rstd, up = acc[ai][1][m][n][i] * rstd;
                        const float sg = g * fast_rcp(1.0f + fast_exp2(-g * LOG2E));
                        o[n * 4 + i] = sg * up;
                    }
                u32x4 w; w.x = cvt_pk_bf16(o[0], o[1]); w.y = cvt_pk_bf16(o[2], o[3]); w.z = cvt_pk_bf16(o[4], o[5]); w.w = cvt_pk_bf16(o[6], o[7]);
                *(u32x4*)((char*)O + (((size_t)(row >> 8) * (DFF / 64) + (col0 >> 6)) * 2 + ((row >> 7) & 1)) * 16384 + pg8::lds_byte(row & 127, col0 & 63)) = w;
            }
    }
};
struct EpiResid {
    static constexpr bool PERM = false, AFTER_DRAIN = false;
    const float* xin_p; const float* xin_s; float* xout; bf16_t* xb; float* ssq; float scale; int res_bf16, write_f32;
    __device__ __forceinline__ void operator()(const f32x4 (&acc)[2][2][4][2], const Unit& u, int wr, int wc, int fr, int fq) const {
        const int col0 = u.pn * 256 + wc * 32 + 4 * fq;
#pragma unroll
        for (int ai = 0; ai < 2; ++ai) {
            if (!((u.hm >> ai) & 1)) continue;
            const int rowb = u.pm * 256 + ai * 128 + wr * 64 + fr;
            f32x4 pre[4][2][2];
            if (res_bf16) {
                u32x2 pw[4][2][2];
#pragma unroll
                for (int m = 0; m < 4; ++m)
#pragma unroll
                    for (int bj = 0; bj < 2; ++bj)
#pragma unroll
                        for (int n = 0; n < 2; ++n) pw[m][bj][n] = *(const u32x2*)(xb + (size_t)(rowb + m * 16) * DM + col0 + bj * 128 + n * 16);
#pragma unroll
                for (int m = 0; m < 4; ++m)
#pragma unroll
                    for (int bj = 0; bj < 2; ++bj)
#pragma unroll
                        for (int n = 0; n < 2; ++n) { const u32x2 w = pw[m][bj][n]; f32x4 p;
                            p[0] = __builtin_bit_cast(float, w.x << 16); p[1] = __builtin_bit_cast(float, w.x & 0xffff0000u);
                            p[2] = __builtin_bit_cast(float, w.y << 16); p[3] = __builtin_bit_cast(float, w.y & 0xffff0000u); pre[m][bj][n] = p; }
            } else {
                const float* xi = (rowb < MP) ? xin_p + (size_t)rowb * DM : xin_s + (size_t)(rowb - MP) * DM;
#pragma unroll
                for (int m = 0; m < 4; ++m)
#pragma unroll
                    for (int bj = 0; bj < 2; ++bj)
#pragma unroll
                        for (int n = 0; n < 2; ++n) pre[m][bj][n] = *(const f32x4*)(xi + (size_t)m * 16 * DM + col0 + bj * 128 + n * 16);
            }
#pragma unroll
            for (int m = 0; m < 4; ++m) {
                const int row = rowb + m * 16;
                float sq = 0.f;
#pragma unroll
                for (int bj = 0; bj < 2; ++bj)
#pragma unroll
                    for (int n = 0; n < 2; ++n) {
                        const int c = col0 + bj * 128 + n * 16;
                        const f32x4 v = pre[m][bj][n] + acc[ai][bj][m][n] * scale;
                        if (write_f32) *(f32x4*)(xout + (size_t)row * DM + c) = v;
                        else { u32x2 w; w.x = cvt_pk_bf16(v[0], v[1]); w.y = cvt_pk_bf16(v[2], v[3]); *(u32x2*)(xb + (size_t)row * DM + c) = w; }
                        sq += (v[0] * v[0] + v[1] * v[1]) + (v[2] * v[2] + v[3] * v[3]);
                    }
                sq += shx(sq, fr + 16 * fq, 16); sq += shx(sq, fr + 16 * fq, 32);
                if (fq == 0 && !write_f32) atomicAdd(ssq + row, sq);
            }
        }
    }
};
struct EpiQK {
    static constexpr bool PERM = true, AFTER_DRAIN = false;
    const float* ssq; unsigned char* ws; float* out; KArgP kap; int l;
    __device__ __forceinline__ void operator()(const f32x4 (&acc)[2][2][4][2], const Unit& u, int wr, int wc, int fr, int fq) const {
        const int sec = u.pn >> 1, hd = 4 * (u.pn & 1) + wc;
        const float* gp = kap->in[12 + sec] + l * 64;
        const float* rope = (const float*)(ws + WS_ROPE);
        bf16_t* QA = (bf16_t*)(ws + WS_QA); bf16_t* QB = (bf16_t*)(ws + WS_QB); bf16_t* KAP = (bf16_t*)(ws + WS_KAP); bf16_t* KBP = (bf16_t*)(ws + WS_KBP);
        bf16_t* KSA = (bf16_t*)(ws + WS_KSA) + (size_t)l * 32 * KSA_ROWS * 512; bf16_t* KSB = (bf16_t*)(ws + WS_KSB) + (size_t)l * 32 * KSB_ROWS * 512;
        float* oPAK = out + OUT_PAK + (size_t)l * 16 * 512 * 512; float* oPBK = out + OUT_PBK + (size_t)l * MP * 512;
        float* oSAK = out + OUT_SAK + (size_t)l * MS * 512; float* oSBK = out + OUT_SBK + (size_t)l * MS * 512;
        f32x4 gl[2], gh[2];
#pragma unroll
        for (int n = 0; n < 2; ++n) { gl[n] = *(const f32x4*)(gp + 8 * fq + 4 * n); gh[n] = *(const f32x4*)(gp + 32 + 8 * fq + 4 * n); }
        const int cbase = hd * 64 + 8 * fq;
        float sqr[2][4];
#pragma unroll
        for (int ai = 0; ai < 2; ++ai)
#pragma unroll
            for (int m = 0; m < 4; ++m) sqr[ai][m] = ssq[u.pm * 256 + ai * 128 + wr * 64 + m * 16 + fr];
#pragma unroll
        for (int ai = 0; ai < 2; ++ai)
#pragma unroll
            for (int m = 0; m < 4; ++m) {
                if (!((u.hm >> ai) & 1)) continue;
                const int row = u.pm * 256 + ai * 128 + wr * 64 + m * 16 + fr;
                const float rstd = rsqrtf(sqr[ai][m] * (1.0f / DM) + EPS);
                f32x4 y[2][2]; float ss = 0.f;
#pragma unroll
                for (int bj = 0; bj < 2; ++bj)
#pragma unroll
                    for (int n = 0; n < 2; ++n) { const f32x4 v = acc[ai][bj][m][n] * rstd; y[bj][n] = v; ss += (v[0] * v[0] + v[1] * v[1]) + (v[2] * v[2] + v[3] * v[3]); }
                ss += shx(ss, fr + 16 * fq, 16); ss += shx(ss, fr + 16 * fq, 32);
                const float rr = rsqrtf(ss * (1.0f / 64.0f) + EPS);
#pragma unroll
                for (int n = 0; n < 2; ++n) { y[0][n] = y[0][n] * rr * gl[n]; y[1][n] = y[1][n] * rr * gh[n]; }
                const bool prompt = row < MP;
                const int sp = row & 2047, bp = row >> 11, ts = (row - MP) & 63, bs = (row - MP) >> 6;
                if (sec >= 2) {
                    const int pos = prompt ? sp : 2048 + ts;
                    const float* cs = rope + (size_t)pos * 64 + 8 * fq;
#pragma unroll
                    for (int n = 0; n < 2; ++n) {
                        const f32x4 c = *(const f32x4*)(cs + 4 * n), s = *(const f32x4*)(cs + 32 + 4 * n);
                        const f32x4 x1 = y[0][n], x2 = y[1][n];
                        y[0][n] = x1 * c - x2 * s; y[1][n] = x2 * c + x1 * s;
                    }
                }
                if (sec == 0 || sec == 2) {
                    bf16_t* dst = (sec == 0 ? QA : QB) + (size_t)row * 512 + cbase;
#pragma unroll
                    for (int bj = 0; bj < 2; ++bj) {
                        const f32x4 a = y[bj][0] * QSCALE, b = y[bj][1] * QSCALE;
                        u32x4 w; w.x = cvt_pk_bf16(a[0], a[1]); w.y = cvt_pk_bf16(a[2], a[3]); w.z = cvt_pk_bf16(b[0], b[1]); w.w = cvt_pk_bf16(b[2], b[3]);
                        *(u32x4*)(dst + 32 * bj) = w;
                    }
                } else {
                    bf16_t* dst; float* fo = nullptr;
                    if (sec == 1) {
                        if (prompt) { dst = KAP + (size_t)row * 512; if (sp >= 1536) fo = oPAK + (size_t)(bp * 512 + sp - 1536) * 512; }
                        else { dst = KSA + (size_t)(bs * KSA_ROWS + 512 + ts) * 512; fo = oSAK + (size_t)(row - MP) * 512; }
                    } else {
                        if (prompt) { dst = KBP + (size_t)row * 512; fo = oPBK + (size_t)row * 512; }
                        else { dst = KSB + (size_t)(bs * KSB_ROWS + 2048 + ts) * 512; fo = oSBK + (size_t)(row - MP) * 512; }
                    }
#pragma unroll
                    for (int bj = 0; bj < 2; ++bj) {
                        const f32x4 a = y[bj][0], b = y[bj][1];
                        u32x4 w; w.x = cvt_pk_bf16(a[0], a[1]); w.y = cvt_pk_bf16(a[2], a[3]); w.z = cvt_pk_bf16(b[0], b[1]); w.w = cvt_pk_bf16(b[2], b[3]);
                        *(u32x4*)(dst + cbase + 32 * bj) = w;
                        if (fo) { *(f32x4*)(fo + cbase + 32 * bj) = a; *(f32x4*)(fo + cbase + 32 * bj + 4) = b; }
                    }
                }
            }
    }
};
struct EpiVt {
    static constexpr bool PERM = true, AFTER_DRAIN = false;
    const float* ssq; unsigned char* ws; float* out; int l;
    __device__ __forceinline__ void operator()(const f32x4 (&acc)[2][2][4][2], const Unit& u, int wr, int wc, int fr, int fq) const {
        bf16_t* VAP = (bf16_t*)(ws + WS_VAP); bf16_t* VBP = (bf16_t*)(ws + WS_VBP);
        bf16_t* VSA = (bf16_t*)(ws + WS_VSA) + (size_t)l * 32 * 512 * KSA_ROWS; bf16_t* VSB = (bf16_t*)(ws + WS_VSB) + (size_t)l * 32 * 512 * KSB_ROWS;
        float* oPAV = out + OUT_PAV + (size_t)l * 16 * 512 * 512; float* oPBV = out + OUT_PBV + (size_t)l * MP * 512;
        float* oSAV = out + OUT_SAV + (size_t)l * MS * 512; float* oSBV = out + OUT_SBV + (size_t)l * MS * 512;
        const int grp = u.pm >> 1;
        const bool prompt = u.pn < (MP / 256);
        f32x4 rs[2][2];
#pragma unroll
        for (int bj = 0; bj < 2; ++bj)
#pragma unroll
            for (int n = 0; n < 2; ++n) {
                const f32x4 q = *(const f32x4*)(ssq + u.pn * 256 + bj * 128 + wc * 32 + 8 * fq + 4 * n);
                f32x4 r; r[0] = rsqrtf(q[0] * (1.0f / DM) + EPS); r[1] = rsqrtf(q[1] * (1.0f / DM) + EPS); r[2] = rsqrtf(q[2] * (1.0f / DM) + EPS); r[3] = rsqrtf(q[3] * (1.0f / DM) + EPS);
                rs[bj][n] = r;
            }
#pragma unroll
        for (int bj = 0; bj < 2; ++bj) {
            const int tok = u.pn * 256 + bj * 128 + wc * 32 + 8 * fq;
            const int bp = tok >> 11, sp = tok & 2047, tt = tok - MP, bs = tt >> 6, ts = tt & 63;
            bf16_t* vdst; size_t vld; float* fo = nullptr;
            if (prompt) { vdst = (grp == 0 ? VAP : VBP) + (size_t)bp * 512 * 2048 + sp; vld = 2048;
                if (grp == 0) { if (sp >= 1536) fo = oPAV + (size_t)(bp * 512 + sp - 1536) * 512; } else fo = oPBV + (size_t)tok * 512; }
            else { if (grp == 0) { vdst = VSA + (size_t)bs * 512 * KSA_ROWS + 512 + ts; vld = KSA_ROWS; fo = oSAV + (size_t)tt * 512; }
                   else { vdst = VSB + (size_t)bs * 512 * KSB_ROWS + 2048 + ts; vld = KSB_ROWS; fo = oSBV + (size_t)tt * 512; } }
#pragma unroll
            for (int ai = 0; ai < 2; ++ai)
#pragma unroll
                for (int m = 0; m < 4; ++m) {
                    if (!((u.hm >> ai) & 1)) continue;
                    const int hrow = (ai * 128 + wr * 64 + m * 16 + fr) + (u.pm & 1) * 256;
                    const f32x4 a = acc[ai][bj][m][0] * rs[bj][0], b = acc[ai][bj][m][1] * rs[bj][1];
                    u32x4 w; w.x = cvt_pk_bf16(a[0], a[1]); w.y = cvt_pk_bf16(a[2], a[3]); w.z = cvt_pk_bf16(b[0], b[1]); w.w = cvt_pk_bf16(b[2], b[3]);
                    *(u32x4*)(vdst + (size_t)hrow * vld) = w;
                    if (fo) {
#pragma unroll
                        for (int i = 0; i < 4; ++i) { fo[(size_t)i * 512 + hrow] = a[i]; fo[(size_t)(4 + i) * 512 + hrow] = b[i]; }
                    }
                }
        }
    }
};
#define XB_TMO      128
#define XB_XCNT(j)  (256  + 64 * (j))
#define XB_XSUB(j)  (1280 + 64 * (j))
#define XB_XGEN(j)  (2304 + 64 * (j))
#define XB_TOP      3328
#define XB_TOPGEN   3392
#define XCD_BAR_WORDS 3456
#define XB_SPIN_CAP (1u << 18)

__device__ __forceinline__ unsigned xb_ld(unsigned* p)              { return __hip_atomic_load(p, __ATOMIC_RELAXED, __HIP_MEMORY_SCOPE_AGENT); }
__device__ __forceinline__ unsigned xb_add(unsigned* p, unsigned v) { return __hip_atomic_fetch_add(p, v, __ATOMIC_RELAXED, __HIP_MEMORY_SCOPE_AGENT); }
__device__ __forceinline__ unsigned xb_xcc_id() { return (unsigned)__builtin_amdgcn_s_getreg((3 << 11) | 20) & 0xFu; }
#define XB_SPIN(cond, bar) do { unsigned _sp = 0; while (cond) { __builtin_amdgcn_s_sleep(1); \
    if ((++_sp & 255u) == 0u) { if (xb_ld(&(bar)[XB_TMO])) break; if (_sp > XB_SPIN_CAP) { atomicAdd(&(bar)[XB_TMO], 1u); break; } } } } while (0)

struct XcdBarrier {
    unsigned* bar; unsigned x;
    volatile LAS unsigned* st;
};

__device__ __forceinline__ XcdBarrier xcd_barrier_post(unsigned* bar, volatile LAS unsigned* st) {
    XcdBarrier b; b.bar = bar; b.x = xb_xcc_id(); b.st = st;
    if (threadIdx.x == 0) (void)xb_add(&bar[XB_XCNT(b.x)], 1u);
    return b;
}
__device__ __forceinline__ void xcd_barrier_complete(unsigned* bar, unsigned x, unsigned& nloc, unsigned& nx) {
    const unsigned G = gridDim.x * gridDim.y * gridDim.z;
    unsigned sum, cnt, mine, sp = 0u;
    for (;;) {
        sum = 0u; cnt = 0u; mine = 0u;
#pragma unroll
        for (unsigned j = 0; j < 16; ++j) { const unsigned c = xb_ld(&bar[XB_XCNT(j)]); sum += c; cnt += (c > 0u) ? 1u : 0u; mine = (j == x) ? c : mine; }
        if (sum == G) break;
        __builtin_amdgcn_s_sleep(1);
        if ((++sp & 255u) == 0u) { if (xb_ld(&bar[XB_TMO])) break; if (sp > XB_SPIN_CAP) { atomicAdd(&bar[XB_TMO], 1u); break; } }
    }
    nloc = mine > 0u ? mine : 1u; nx = cnt > 0u ? cnt : 1u;
}

__device__ __forceinline__ void xcd_barrier(const XcdBarrier& b) {
    asm volatile("s_waitcnt vmcnt(0)" ::: "memory");
    __syncthreads();
    if (threadIdx.x == 0) {
        unsigned* bar = b.bar;
        __builtin_amdgcn_s_waitcnt(0);
        unsigned nloc = b.st[0], nx = b.st[1];
        if (nloc == 0u) { xcd_barrier_complete(bar, b.x, nloc, nx); b.st[0] = nloc; b.st[1] = nx; }
        const unsigned old = xb_add(&bar[XB_XSUB(b.x)], 1u);
        const unsigned gen = old / nloc;
        if (old + 1u == (gen + 1u) * nloc) {
            __builtin_amdgcn_fence(__ATOMIC_RELEASE, "agent");
            asm volatile("s_waitcnt vmcnt(0)" ::: "memory");
            const unsigned og = xb_add(&bar[XB_TOP], 1u);
            const unsigned tg = og / nx;
            if (og + 1u == (tg + 1u) * nx) xb_add(&bar[XB_TOPGEN], 1u);
            else XB_SPIN(xb_ld(&bar[XB_TOPGEN]) == tg, bar);
            __builtin_amdgcn_fence(__ATOMIC_ACQUIRE, "agent");
            xb_add(&bar[XB_XGEN(b.x)], 1u);
            asm volatile("s_waitcnt vmcnt(0)" ::: "memory");
        } else {
            XB_SPIN(xb_ld(&bar[XB_XGEN(b.x)]) == gen, bar);
            __builtin_amdgcn_fence(__ATOMIC_ACQUIRE, "agent");
            asm volatile("s_waitcnt vmcnt(0)" ::: "memory");
        }
    }
    __syncthreads();
}
__device__ __forceinline__ int map_row(int kind, int n) {
    if (kind == 0) return n;
    if (kind == 1) return 256 * (n >> 7) + (n & 127);
    if (kind == 2) return 256 * (n >> 7) + 128 + (n & 127);
    const int sec = n >> 9, w = n & 511;
    if (sec == 2) return 2048 + w;
    if (sec == 5) return 2560 + w;
    const int qsec = sec == 0 ? 0 : sec == 1 ? 1 : sec == 3 ? 2 : 3;
    const int c = qsec * 512 + w, pn = c >> 8, ww = c & 255, hw = ww >> 6, d = ww & 63;
    return 256 * pn + 128 * (d >> 5) + 32 * hw + (d & 31);
}
__device__ __forceinline__ void transpose_item(const float* src, int ld_src, int k0, int n0, const float* gain, bf16_t* dst, size_t ld_dst, int kind, LAS float* scr, int lane) {
    float tv[32];
#pragma unroll
    for (int i = 0; i < 32; ++i) tv[i] = src[(size_t)(k0 + 2 * i + (lane >> 5)) * ld_src + n0 + (lane & 31)];
    if (gain) {
#pragma unroll
        for (int i = 0; i < 32; ++i) tv[i] *= gain[k0 + 2 * i + (lane >> 5)];
    }
#pragma unroll
    for (int i = 0; i < 32; ++i) scr[(2 * i + (lane >> 5)) * 33 + (lane & 31)] = tv[i];
    asm volatile("s_waitcnt lgkmcnt(0)" ::: "memory");
    const int c = lane & 7;
#pragma unroll
    for (int j = 0; j < 4; ++j) {
        const int n = (lane >> 3) + 8 * j; const LAS float* s = scr + (8 * c) * 33 + n;
        u32x4 o; o.x = cvt_pk_bf16(s[0 * 33], s[1 * 33]); o.y = cvt_pk_bf16(s[2 * 33], s[3 * 33]); o.z = cvt_pk_bf16(s[4 * 33], s[5 * 33]); o.w = cvt_pk_bf16(s[6 * 33], s[7 * 33]);
        if (kind == 4) { const int row = n0 + n; *(u32x4*)((char*)dst + (((size_t)(row >> 8) * (DFF / 64) + (k0 >> 6)) * 2 + ((row >> 7) & 1)) * 16384 + pg8::lds_byte(row & 127, 8 * c)) = o; }
        else *(u32x4*)(dst + (size_t)map_row(kind, n0 + n) * ld_dst + k0 + 8 * c) = o;
    }
    asm volatile("s_waitcnt lgkmcnt(0)" ::: "memory");
}
__device__ __forceinline__ void do_job(const float* src, int R, int C, const float* gain, bf16_t* dst, size_t ld_dst, int kind, int item, LAS float* scr, int lane) {
    const int nblk = C >> 5, kb = item / nblk, nb = item - kb * nblk;
    (void)R;
    transpose_item(src, C, 64 * kb, 32 * nb, gain, dst, ld_dst, kind, scr, lane);
}

__device__ __forceinline__ void convert_caches(KArgP A, LAS unsigned char* lds, int l, int gw, int NGW, int wave) {
    int lane_l = lane_id_fresh(); asm volatile("" : "+v"(lane_l)); const int lane = lane_l;
    unsigned char* ws = A->ws;
    LAS float* scr = (LAS float*)(lds + wave * 16384);
    constexpr int I_CAV = 32 * 128;
    for (int it = gw; it < I_CAV; it += NGW) {
        {
            const int lb = l * 32 + (it >> 7), item = it & 127;
            do_job(A->in[3] + (size_t)lb * 512 * 512, 512, 512, nullptr, (bf16_t*)(ws + WS_VSA) + (size_t)lb * 512 * KSA_ROWS, KSA_ROWS, 0, item, scr, lane);
        }
    }
    for (int r = gw; r < 32 * 512; r += NGW) {
        const float* s; bf16_t* d;
        if (r < 32 * 512) { const int lb = l * 32 + (r >> 9), key = r & 511; s = A->in[2] + ((size_t)lb * 512 + key) * 512; d = (bf16_t*)(ws + WS_KSA) + (size_t)(lb * KSA_ROWS + key) * 512; }
        else { const int q = r - 32 * 512, lb = l * 32 + (q >> 11), key = q & 2047; s = A->in[4] + ((size_t)lb * 2048 + key) * 512; d = (bf16_t*)(ws + WS_KSB) + (size_t)(lb * KSB_ROWS + key) * 512; }
        const f32x4 a = *(const f32x4*)(s + 8 * lane), b = *(const f32x4*)(s + 8 * lane + 4);
        u32x4 w; w.x = cvt_pk_bf16(a[0], a[1]); w.y = cvt_pk_bf16(a[2], a[3]); w.z = cvt_pk_bf16(b[0], b[1]); w.w = cvt_pk_bf16(b[2], b[3]);
        *(u32x4*)(d + 8 * lane) = w;
    }
}

__device__ __forceinline__ void prologue(KArgP A, LAS unsigned char* lds, int gw, int NGW, int wave) {
    int lane_l = lane_id_fresh(); asm volatile("" : "+v"(lane_l)); const int lane = lane_l;
    unsigned char* ws = A->ws;
    LAS float* scr = (LAS float*)(lds + wave * 16384);
    constexpr int I_GU = 16 * 88, I_D = 44 * 32, I_IN = 16 * 96, I_O = 16 * 32;
    constexpr int I_LAYER = 4 * I_GU + 2 * I_D + I_IN + I_O;
    constexpr int I_W = 2 * I_LAYER;
    for (int it = gw; it < I_W; it += NGW) {
        {
            const int l = it / I_LAYER; int r = it - l * I_LAYER;
            unsigned char* wl = ws + WS_W + (size_t)l * W_LAYER;
            const float* gf1 = A->in[6] + l * DM; const float* gmx = A->in[10] + l * DM; const float* gf2 = A->in[23] + l * DM;
            if (r < I_GU) { do_job(A->in[7] + (size_t)l * DM * DFF, DM, DFF, gf1, (bf16_t*)(wl + W_GU1), DM, 1, r, scr, lane); continue; } r -= I_GU;
            if (r < I_GU) { do_job(A->in[8] + (size_t)l * DM * DFF, DM, DFF, gf1, (bf16_t*)(wl + W_GU1), DM, 2, r, scr, lane); continue; } r -= I_GU;
            if (r < I_D)  { do_job(A->in[9] + (size_t)l * DM * DFF, DFF, DM, nullptr, (bf16_t*)(wl + W_D1), LDP, 4, r, scr, lane); continue; } r -= I_D;
            if (r < I_IN) { do_job(A->in[11] + (size_t)l * DM * 3072, DM, 3072, gmx, (bf16_t*)(wl + W_IN), DM, 3, r, scr, lane); continue; } r -= I_IN;
            if (r < I_O)  { do_job(A->in[22] + (size_t)l * DM * DM, DM, DM, nullptr, (bf16_t*)(wl + W_OUT), DM, 0, r, scr, lane); continue; } r -= I_O;
            if (r < I_GU) { do_job(A->in[24] + (size_t)l * DM * DFF, DM, DFF, gf2, (bf16_t*)(wl + W_GU2), DM, 1, r, scr, lane); continue; } r -= I_GU;
            if (r < I_GU) { do_job(A->in[25] + (size_t)l * DM * DFF, DM, DFF, gf2, (bf16_t*)(wl + W_GU2), DM, 2, r, scr, lane); continue; } r -= I_GU;
            do_job(A->in[26] + (size_t)l * DM * DFF, DFF, DM, nullptr, (bf16_t*)(wl + W_D2), LDP, 4, r, scr, lane);
        }
    }
    convert_caches(A, lds, 0, gw, NGW, wave);
    convert_caches(A, lds, 1, gw, NGW, wave);
    float* ssq = (float*)(ws + WS_SSQ);
    bf16_t* xb = (bf16_t*)(ws + WS_XB);
    for (int r0 = gw; r0 < MT; r0 += 2 * NGW) {
        const int r1 = r0 + NGW; const bool has1 = r1 < MT;
        const float* xa = (r0 < MP) ? A->in[0] + (size_t)r0 * DM : A->in[1] + (size_t)(r0 - MP) * DM;
        const float* xc = !has1 ? xa : (r1 < MP) ? A->in[0] + (size_t)r1 * DM : A->in[1] + (size_t)(r1 - MP) * DM;
        f32x4 va[4], vc[4];
#pragma unroll
        for (int j = 0; j < 4; ++j) { va[j] = *(const f32x4*)(xa + 256 * j + 4 * lane); vc[j] = *(const f32x4*)(xc + 256 * j + 4 * lane); }
        float sa = 0.f, sc = 0.f;
#pragma unroll
        for (int j = 0; j < 4; ++j) {
            sa += (va[j][0] * va[j][0] + va[j][1] * va[j][1]) + (va[j][2] * va[j][2] + va[j][3] * va[j][3]);
            sc += (vc[j][0] * vc[j][0] + vc[j][1] * vc[j][1]) + (vc[j][2] * vc[j][2] + vc[j][3] * vc[j][3]);
            u32x2 w; w.x = cvt_pk_bf16(va[j][0], va[j][1]); w.y = cvt_pk_bf16(va[j][2], va[j][3]);
            *(u32x2*)(xb + (size_t)r0 * DM + 256 * j + 4 * lane) = w;
            if (has1) { u32x2 w2; w2.x = cvt_pk_bf16(vc[j][0], vc[j][1]); w2.y = cvt_pk_bf16(vc[j][2], vc[j][3]); *(u32x2*)(xb + (size_t)r1 * DM + 256 * j + 4 * lane) = w2; }
        }
        sa = wave_sum(sa, lane); sc = wave_sum(sc, lane);
        if (lane == 0) { ssq[r0] = sa; if (has1) ssq[r1] = sc; }
    }
    for (int i = gw * 64 + lane; i < 6 * MT; i += NGW * 64) ssq[MT + i] = 0.f;
    float* rope = (float*)(ws + WS_ROPE);
    for (int i = gw * 64 + lane; i < 2112 * 32; i += NGW * 64) {
        const int pos = i >> 5, j = i & 31;
        const double a = (double)((float)pos * (float)ROPE_INV[j]);
        const double kq = __builtin_rint(a * 0.63661977236758134308);
        const double rr = (a - kq * 1.5707963267948966192) - kq * 6.123233995736766e-17;
        const double r2 = rr * rr;
        const double sn = rr * (1.0 + r2 * (-1.0 / 6 + r2 * (1.0 / 120 + r2 * (-1.0 / 5040 + r2 * (1.0 / 362880 + r2 * (-1.0 / 39916800 + r2 * (1.0 / 6227020800.0)))))));
        const double cn = 1.0 + r2 * (-0.5 + r2 * (1.0 / 24 + r2 * (-1.0 / 720 + r2 * (1.0 / 40320 + r2 * (-1.0 / 3628800 + r2 * (1.0 / 479001600 + r2 * (-1.0 / 87178291200.0)))))));
        const int q = ((int)kq) & 3;
        const double c = q == 0 ? cn : q == 1 ? -sn : q == 2 ? -cn : sn;
        const double s = q == 0 ? sn : q == 1 ? cn : q == 2 ? -sn : -cn;
        rope[(size_t)pos * 64 + j] = (float)c; rope[(size_t)pos * 64 + 32 + j] = (float)s;
    }
    if (gw == 0) {
        unsigned* ctl = (unsigned*)(ws + WS_CTL);
        float* cst = (float*)(ws + WS_CTL + 4096);
        if (lane < 16) ctl[lane] = 0u;
        for (int i = lane; i < XCD_BAR_WORDS; i += 64) ((unsigned*)(ws + WS_BAR))[i] = 0u;
        for (int l = 0; l < 2; ++l) {
            const float mqa = wave_max(fabsf(A->in[12][l * 64 + lane]), lane), mka = wave_max(fabsf(A->in[13][l * 64 + lane]), lane);
            const float mqb = wave_max(fabsf(A->in[14][l * 64 + lane]), lane), mkb = wave_max(fabsf(A->in[15][l * 64 + lane]), lane);
            float mb = 0.f;
            for (int i = lane; i < 8 * 257; i += 64) mb = fmaxf(mb, fabsf(A->in[16][l * 8 * 257 + i]));
            mb = wave_max(mb, lane);
            const float d1 = wave_sum(A->in[17][l * 64 + lane] * A->in[18][l * 64 + lane], lane), d2 = wave_sum(A->in[19][l * 64 + lane] * A->in[20][l * 64 + lane], lane);
            const float lam_init = l == 0 ? 0.2f : 0.35550906759096934f;
            if (lane == 0) {
                cst[l * 8 + 0] = LOG2E * (8.0f * mqa * mka + mb);
                cst[l * 8 + 1] = LOG2E * (8.0f * mqb * mkb);
                cst[l * 8 + 2] = expf(d1) - expf(d2) + lam_init;
                cst[l * 8 + 3] = 1.0f - lam_init;
            }
        }
    }
}

__device__ __forceinline__ int swap23(int r) { return (r & 19) | ((r & 4) << 1) | ((r & 8) >> 1); }
__device__ __forceinline__ f32x16 mfma32(bf16x8 a, bf16x8 b, f32x16 c) { return __builtin_amdgcn_mfma_f32_32x32x16_bf16(a, b, c, 0, 0, 0); }
__device__ __forceinline__ bf16x8 pack8(const f32x16& p, int s) {
    u32x4 w; w.x = cvt_pk_bf16(p[8 * s + 0], p[8 * s + 1]); w.y = cvt_pk_bf16(p[8 * s + 2], p[8 * s + 3]); w.z = cvt_pk_bf16(p[8 * s + 4], p[8 * s + 5]); w.w = cvt_pk_bf16(p[8 * s + 6], p[8 * s + 7]);
    return __builtin_bit_cast(bf16x8, w);
}
constexpr int ATT_BUF = 32768, ATT_WAVE = 65536, ATT_BW = 131072 + 64;

__device__ __forceinline__ void attn_a_block(const bf16_t* Qw, const bf16_t* Kb, const bf16_t* Vtb, int ldv, int T, int t_lo, int t_hi, int t_self, int qoff,
                                             bf16_t* Outw, LAS unsigned char* lds, int wave, int lane_in) {
    int lane = lane_in; asm volatile("" : "+v"(lane));
    const int r32 = lane & 31, hi = lane >> 5;
    const bool active = t_lo <= t_hi;
    const LAS float* E = (const LAS float*)(lds + ATT_WAVE + wave * 8192);
    bf16x8 qf[4];
#pragma unroll
    for (int d0 = 0; d0 < 4; ++d0) qf[d0] = active ? *(const bf16x8*)(Qw + (size_t)r32 * 512 + 16 * d0 + 8 * hi) : (bf16x8){0, 0, 0, 0, 0, 0, 0, 0};
    f32x16 o0, o1;
#pragma unroll
    for (int r = 0; r < 16; ++r) { o0[r] = 0.f; o1[r] = 0.f; }
    float l = 0.f;
    const float cfar = E[192];
    const int key_l = 8 * wave + (lane & 7), c8 = lane >> 3;
    const bf16_t* kg = Kb + (size_t)key_l * 512 + 8 * c8;
    const bf16_t* vg = Vtb + (size_t)key_l * ldv + 8 * c8;
    const int koff = ((key_l >> 5) * 4 + (c8 >> 1)) * 1024 + (swap23(key_l & 31) + 32 * (c8 & 1)) * 16;
    const int voff = 8192 + (((c8 >> 2) * 2 + (key_l >> 5)) * 2 + ((c8 >> 1) & 1)) * 1024 + ((key_l & 31) + 32 * (c8 & 1)) * 16;
    constexpr int ABUF = 16384;
    u32x4 skA = *(const u32x4*)kg, svA = *(const u32x4*)vg, skB = skA, svB = svA;
    if (T > 1) { skB = *(const u32x4*)(kg + (size_t)64 * 512); svB = *(const u32x4*)(vg + 64); }
    *(LAS u32x4*)(lds + koff) = skA; *(LAS u32x4*)(lds + voff) = svA;
    __syncthreads();
    int cb = 0;
#define A_STEP(t, LK, LV, WK, WV) do { \
        if ((t) + 2 < T) { LK = *(const u32x4*)(kg + (size_t)((t) + 2) * 64 * 512); LV = *(const u32x4*)(vg + ((t) + 2) * 64); } \
        if ((t) >= t_lo && (t) <= t_hi) { \
            const LAS bf16x8* KF = (const LAS bf16x8*)(lds + cb * ABUF); \
            const LAS bf16x8* VF = KF + 512; \
            _Pragma("unroll") for (int j = 0; j < 2; ++j) { \
                f32x16 sa; \
                const int relbase = 64 * (t_self - (t)) - 32 * j + qoff; \
                if (relbase - 31 >= 128) { _Pragma("unroll") for (int r = 0; r < 16; ++r) sa[r] = cfar; } \
                else { const int bi = relbase + 64 + r32 - 8 * hi - 23; _Pragma("unroll") for (int r = 0; r < 16; ++r) sa[r] = E[bi + 23 - (r & 7) - 16 * (r >> 3)]; } \
                _Pragma("unroll") for (int d0 = 0; d0 < 4; ++d0) sa = mfma32(KF[(j * 4 + d0) * 64 + lane], qf[d0], sa); \
                float ps = 0.f; \
                _Pragma("unroll") for (int r = 0; r < 16; ++r) { sa[r] = fast_exp2(sa[r]); ps += sa[r]; } \
                l += ps; \
                const bf16x8 p0 = pack8(sa, 0), p1 = pack8(sa, 1); \
                o0 = mfma32(VF[((j * 2 + 0) * 2 + 0) * 64 + lane], p0, o0); o0 = mfma32(VF[((j * 2 + 0) * 2 + 1) * 64 + lane], p1, o0); \
                o1 = mfma32(VF[((j * 2 + 1) * 2 + 0) * 64 + lane], p0, o1); o1 = mfma32(VF[((j * 2 + 1) * 2 + 1) * 64 + lane], p1, o1); \
            } \
        } \
        const int nb = cb == 2 ? 0 : cb + 1; \
        if ((t) + 1 < T) { *(LAS u32x4*)(lds + nb * ABUF + koff) = WK; *(LAS u32x4*)(lds + nb * ABUF + voff) = WV; } \
        cb = nb; \
        __syncthreads(); \
    } while (0)
    for (int t = 0; t < T; t += 2) {
        A_STEP(t, skA, svA, skB, svB);
        if (t + 1 < T) A_STEP(t + 1, skB, svB, skA, svA);
    }
#undef A_STEP
    if (active) {
        const int le = lane_id_fresh(), r32e = le & 31, hie = le >> 5;
        l += shx(l, le, 32);
        const float inv = 1.0f / l;
#pragma unroll
        for (int g = 0; g < 4; ++g) {
            u32x2 w0, w1;
            w0.x = cvt_pk_bf16(o0[4 * g] * inv, o0[4 * g + 1] * inv); w0.y = cvt_pk_bf16(o0[4 * g + 2] * inv, o0[4 * g + 3] * inv);
            w1.x = cvt_pk_bf16(o1[4 * g] * inv, o1[4 * g + 1] * inv); w1.y = cvt_pk_bf16(o1[4 * g + 2] * inv, o1[4 * g + 3] * inv);
            *(u32x2*)(Outw + (size_t)r32e * DM + 8 * g + 4 * hie) = w0;
            *(u32x2*)(Outw + (size_t)r32e * DM + 32 + 8 * g + 4 * hie) = w1;
        }
    }
}
__device__ __forceinline__ void attn_b_block(const bf16_t* Qw, const bf16_t* Kb, const bf16_t* Vtb, int ldv, int T, int tlim, float nshift, float lam, float post, const float* gsub,
                                             bf16_t* Outw, LAS unsigned char* lds, int wave, int lane_in) {
    int lane = lane_in; asm volatile("" : "+v"(lane));
    const int r32 = lane & 31, hi = lane >> 5;
    LAS bf16x8* Qs = (LAS bf16x8*)(lds + ATT_WAVE + wave * 8192);
    if (tlim > 0) {
#pragma unroll
        for (int m = 0; m < 2; ++m)
#pragma unroll
            for (int d0 = 0; d0 < 4; ++d0) Qs[(m * 4 + d0) * 64 + lane] = *(const bf16x8*)(Qw + (size_t)r32 * 512 + 64 * m + 16 * d0 + 8 * hi);
    }
    f32x16 o1[4], o2[4];
#pragma unroll
    for (int db = 0; db < 4; ++db)
#pragma unroll
        for (int r = 0; r < 16; ++r) { o1[db][r] = 0.f; o2[db][r] = 0.f; }
    float l1 = 0.f, l2 = 0.f;
    const int key_l = 8 * wave + (lane & 7), c8 = lane >> 3;
    const bf16_t* kg = Kb + (size_t)key_l * 512 + 8 * c8;
    const int koff = ((key_l >> 5) * 8 + (c8 >> 1)) * 1024 + (swap23(key_l & 31) + 32 * (c8 & 1)) * 16;
    const int d_l = 16 * wave + (lane & 7);
    const bf16_t* vg = Vtb + (size_t)d_l * ldv + 8 * c8;
    const int voff = 16384 + (((c8 >> 2) * 4 + (d_l >> 5)) * 2 + ((c8 >> 1) & 1)) * 1024 + ((d_l & 31) + 32 * (c8 & 1)) * 16;
    u32x4 sk0 = *(const u32x4*)kg, sk1 = *(const u32x4*)(kg + 64), sv0 = *(const u32x4*)vg, sv1 = *(const u32x4*)(vg + (size_t)8 * ldv);
    *(LAS u32x4*)(lds + koff) = sk0; *(LAS u32x4*)(lds + koff + 4096) = sk1; *(LAS u32x4*)(lds + voff) = sv0; *(LAS u32x4*)(lds + voff + 128) = sv1;
    __syncthreads();
    for (int t = 0; t < T; ++t) {
        const bool more = t + 1 < T;
        if (more) {
            const bf16_t* kn = kg + (size_t)(t + 1) * 64 * 512; const bf16_t* vn = vg + (t + 1) * 64;
            sk0 = *(const u32x4*)kn; sk1 = *(const u32x4*)(kn + 64); sv0 = *(const u32x4*)vn; sv1 = *(const u32x4*)(vn + (size_t)8 * ldv);
        }
        if (t < tlim) {
            const LAS bf16x8* KF = (const LAS bf16x8*)(lds + (t & 1) * ATT_BUF);
            const LAS bf16x8* VF = KF + 1024;
#pragma unroll
            for (int j = 0; j < 2; ++j) {
                bf16x8 pa[2], pb[2];
                {
                    f32x16 sa;
#pragma unroll
                    for (int r = 0; r < 16; ++r) sa[r] = nshift;
#pragma unroll
                    for (int d0 = 0; d0 < 4; ++d0) sa = mfma32(KF[((j * 2 + 0) * 4 + d0) * 64 + lane], Qs[d0 * 64 + lane], sa);
                    float ps = 0.f;
#pragma unroll
                    for (int r = 0; r < 16; ++r) { sa[r] = fast_exp2(sa[r]); ps += sa[r]; }
                    l1 += ps; pa[0] = pack8(sa, 0); pa[1] = pack8(sa, 1);
                }
                {
                    f32x16 sa;
#pragma unroll
                    for (int r = 0; r < 16; ++r) sa[r] = nshift;
#pragma unroll
                    for (int d0 = 0; d0 < 4; ++d0) sa = mfma32(KF[((j * 2 + 1) * 4 + d0) * 64 + lane], Qs[(4 + d0) * 64 + lane], sa);
                    float ps = 0.f;
#pragma unroll
                    for (int r = 0; r < 16; ++r) { sa[r] = fast_exp2(sa[r]); ps += sa[r]; }
                    l2 += ps; pb[0] = pack8(sa, 0); pb[1] = pack8(sa, 1);
                }
#pragma unroll
                for (int db = 0; db < 4; ++db)
#pragma unroll
                    for (int s = 0; s < 2; ++s) {
                        const bf16x8 vf = VF[((j * 4 + db) * 2 + s) * 64 + lane];
                        o1[db] = mfma32(vf, pa[s], o1[db]); o2[db] = mfma32(vf, pb[s], o2[db]);
                    }
            }
        }
        if (more) {
            LAS unsigned char* nb = lds + ((t + 1) & 1) * ATT_BUF;
            *(LAS u32x4*)(nb + koff) = sk0; *(LAS u32x4*)(nb + koff + 4096) = sk1; *(LAS u32x4*)(nb + voff) = sv0; *(LAS u32x4*)(nb + voff + 128) = sv1;
        }
        __syncthreads();
    }
    if (tlim > 0) {
        const int le = lane_id_fresh(), r32e = le & 31, hie = le >> 5;
        l1 += shx(l1, le, 32); l2 += shx(l2, le, 32);
        const float i1 = 1.0f / l1, i2 = lam / l2;
        float ss = 0.f;
#pragma unroll
        for (int db = 0; db < 4; ++db)
#pragma unroll
            for (int r = 0; r < 16; ++r) { const float v = o1[db][r] * i1 - o2[db][r] * i2; o1[db][r] = v; ss += v * v; }
        ss += shx(ss, le, 32);
        const float rr = rsqrtf(ss * (1.0f / 128.0f) + EPS) * post;
#pragma unroll
        for (int db = 0; db < 4; ++db)
#pragma unroll
            for (int g = 0; g < 4; ++g) {
                const int d = 32 * db + 8 * g + 4 * hie;
                const f32x4 gs = *(const f32x4*)(gsub + d);
                u32x2 w; w.x = cvt_pk_bf16(o1[db][4 * g] * rr * gs[0], o1[db][4 * g + 1] * rr * gs[1]); w.y = cvt_pk_bf16(o1[db][4 * g + 2] * rr * gs[2], o1[db][4 * g + 3] * rr * gs[3]);
                *(u32x2*)(Outw + (size_t)r32e * DM + d) = w;
            }
    }
}
__device__ __forceinline__ void attn_bs_block(KArgP A, int l, int b, int h, float nshift, float lam, float post, const float* gsub, LAS unsigned char* lds, int wave, int lane_in) {
    int lane = lane_in; asm volatile("" : "+v"(lane));
    unsigned char* ws = A->ws;
    const int lb = l * 32 + b;
    constexpr int T = 33;
    const float* ck = A->in[4] + (size_t)lb * 2048 * 512 + h * 128;
    const float* cv = A->in[5] + (size_t)lb * 2048 * 512 + h * 128;
    const bf16_t* nk = (const bf16_t*)(ws + WS_KSB) + ((size_t)lb * KSB_ROWS + 2048) * 512 + h * 128;
    const bf16_t* nv = (const bf16_t*)(ws + WS_VSB) + ((size_t)lb * 512 + h * 128) * KSB_ROWS + 2048;
    const int li = (wave - 2) * 64 + lane;
#define BS_FILL(t) do { \
        LAS unsigned char* fb = lds + ((t) & 1) * ATT_BUF; \
        if ((t) < 32) { \
            _Pragma("unroll") for (int i = 0; i < 3; ++i) { const int ci = li + 384 * i; \
                if (ci < 1024) { const int key = ci >> 4, c16 = ci & 15, c8 = c16 & 7; \
                    const float* src = ck + (size_t)(64 * (t) + key) * 512 + 8 * c16; \
                    const f32x4 a = *(const f32x4*)src, c = *(const f32x4*)(src + 4); \
                    u32x4 w; w.x = cvt_pk_bf16(a[0], a[1]); w.y = cvt_pk_bf16(a[2], a[3]); w.z = cvt_pk_bf16(c[0], c[1]); w.w = cvt_pk_bf16(c[2], c[3]); \
                    *(LAS u32x4*)(fb + ((key >> 5) * 8 + (c16 >> 3) * 4 + (c8 >> 1)) * 1024 + (swap23(key & 31) + 32 * (c8 & 1)) * 16) = w; } } \
            if (li < 256) { const int g = li >> 5, d4 = li & 31; \
                f32x4 r[8]; \
                _Pragma("unroll") for (int kk = 0; kk < 8; ++kk) r[kk] = *(const f32x4*)(cv + (size_t)(64 * (t) + 8 * g + kk) * 512 + 4 * d4); \
                _Pragma("unroll") for (int i = 0; i < 4; ++i) { const int d = 4 * d4 + i; \
                    u32x4 w; w.x = cvt_pk_bf16(r[0][i], r[1][i]); w.y = cvt_pk_bf16(r[2][i], r[3][i]); w.z = cvt_pk_bf16(r[4][i], r[5][i]); w.w = cvt_pk_bf16(r[6][i], r[7][i]); \
                    *(LAS u32x4*)(fb + 16384 + (((g >> 2) * 4 + (d >> 5)) * 2 + ((g >> 1) & 1)) * 1024 + ((d & 31) + 32 * (g & 1)) * 16) = w; } } \
        } else { \
            _Pragma("unroll") for (int i = 0; i < 3; ++i) { const int ci = li + 384 * i; \
                if (ci < 1024) { const int key = ci >> 4, c16 = ci & 15, c8 = c16 & 7; \
                    const u32x4 w = *(const u32x4*)(nk + (size_t)key * 512 + 8 * c16); \
                    *(LAS u32x4*)(fb + ((key >> 5) * 8 + (c16 >> 3) * 4 + (c8 >> 1)) * 1024 + (swap23(key & 31) + 32 * (c8 & 1)) * 16) = w; \
                    const int d = ci >> 3, g = ci & 7; \
                    const u32x4 v = *(const u32x4*)(nv + (size_t)d * KSB_ROWS + 8 * g); \
                    *(LAS u32x4*)(fb + 16384 + (((g >> 2) * 4 + (d >> 5)) * 2 + ((g >> 1) & 1)) * 1024 + ((d & 31) + 32 * (g & 1)) * 16) = v; } } \
        } \
    } while (0)
    if (wave >= 2) {
        BS_FILL(0);
        __syncthreads();
        for (int t = 0; t < T; ++t) {
            if (t + 1 < T) BS_FILL(t + 1);
            __syncthreads();
        }
    } else {
        const int r32 = lane & 31, hi = lane >> 5;
        const int row0 = MP + b * 64 + 32 * wave;
        const bf16_t* Qw = (const bf16_t*)(ws + WS_QB) + (size_t)row0 * 512 + h * 128;
        LAS bf16x8* Qs = (LAS bf16x8*)(lds + ATT_WAVE + wave * 8192);
#pragma unroll
        for (int m = 0; m < 2; ++m)
#pragma unroll
            for (int d0 = 0; d0 < 4; ++d0) Qs[(m * 4 + d0) * 64 + lane] = *(const bf16x8*)(Qw + (size_t)r32 * 512 + 64 * m + 16 * d0 + 8 * hi);
        f32x16 o1[4], o2[4];
#pragma unroll
        for (int db = 0; db < 4; ++db)
#pragma unroll
            for (int r = 0; r < 16; ++r) { o1[db][r] = 0.f; o2[db][r] = 0.f; }
        float l1 = 0.f, l2 = 0.f;
        __syncthreads();
        for (int t = 0; t < T; ++t) {
            const LAS bf16x8* KF = (const LAS bf16x8*)(lds + (t & 1) * ATT_BUF);
            const LAS bf16x8* VF = KF + 1024;
#pragma unroll
            for (int j = 0; j < 2; ++j) {
                bf16x8 pa[2], pb[2];
                {
                    f32x16 sa;
#pragma unroll
                    for (int r = 0; r < 16; ++r) sa[r] = nshift;
#pragma unroll
                    for (int d0 = 0; d0 < 4; ++d0) sa = mfma32(KF[((j * 2 + 0) * 4 + d0) * 64 + lane], Qs[d0 * 64 + lane], sa);
                    float ps = 0.f;
#pragma unroll
                    for (int r = 0; r < 16; ++r) { sa[r] = fast_exp2(sa[r]); ps += sa[r]; }
                    l1 += ps; pa[0] = pack8(sa, 0); pa[1] = pack8(sa, 1);
                }
                {
                    f32x16 sa;
#pragma unroll
                    for (int r = 0; r < 16; ++r) sa[r] = nshift;
#pragma unroll
                    for (int d0 = 0; d0 < 4; ++d0) sa = mfma32(KF[((j * 2 + 1) * 4 + d0) * 64 + lane], Qs[(4 + d0) * 64 + lane], sa);
                    float ps = 0.f;
#pragma unroll
                    for (int r = 0; r < 16; ++r) { sa[r] = fast_exp2(sa[r]); ps += sa[r]; }
                    l2 += ps; pb[0] = pack8(sa, 0); pb[1] = pack8(sa, 1);
                }
#pragma unroll
                for (int db = 0; db < 4; ++db)
#pragma unroll
                    for (int s = 0; s < 2; ++s) {
                        const bf16x8 vf = VF[((j * 4 + db) * 2 + s) * 64 + lane];
                        o1[db] = mfma32(vf, pa[s], o1[db]); o2[db] = mfma32(vf, pb[s], o2[db]);
                    }
            }
            __syncthreads();
        }
        const int le = lane_id_fresh(), r32e = le & 31, hie = le >> 5;
        l1 += shx(l1, le, 32); l2 += shx(l2, le, 32);
        const float i1 = 1.0f / l1, i2 = lam / l2;
        float ss = 0.f;
#pragma unroll
        for (int db = 0; db < 4; ++db)
#pragma unroll
            for (int r = 0; r < 16; ++r) { const float v = o1[db][r] * i1 - o2[db][r] * i2; o1[db][r] = v; ss += v * v; }
        ss += shx(ss, le, 32);
        const float rr = rsqrtf(ss * (1.0f / 128.0f) + EPS) * post;
        bf16_t* Outw = (bf16_t*)(ws + WS_O) + (size_t)row0 * DM + 512 + h * 128;
#pragma unroll
        for (int db = 0; db < 4; ++db)
#pragma unroll
            for (int g = 0; g < 4; ++g) {
                const int d = 32 * db + 8 * g + 4 * hie;
                const f32x4 gs = *(const f32x4*)(gsub + d);
                u32x2 w; w.x = cvt_pk_bf16(o1[db][4 * g] * rr * gs[0], o1[db][4 * g + 1] * rr * gs[1]); w.y = cvt_pk_bf16(o1[db][4 * g + 2] * rr * gs[2], o1[db][4 * g + 3] * rr * gs[3]);
                *(u32x2*)(Outw + (size_t)r32e * DM + d) = w;
            }
    }
#undef BS_FILL
}
constexpr int U_BS = 128, U_BP = 512, U_AP = 1024, U_AS = 256, U_B = U_BS + U_BP, U_ALL = U_B + U_AP + U_AS;
__device__ __forceinline__ void attn_phase(KArgP A, int l, LAS unsigned char* lds, int wave, int cidx) {
    unsigned char* ws = A->ws;
    unsigned* ctr = (unsigned*)(ws + WS_CTL) + cidx;
    const float* cst = (const float*)(ws + WS_CTL + 4096) + l * 8;
#define SGPR_F(x) __builtin_bit_cast(float, __builtin_amdgcn_readfirstlane(__builtin_bit_cast(int, (x))))
    const float shA = SGPR_F(cst[0]), shB = SGPR_F(cst[1]), lam = SGPR_F(cst[2]), post = SGPR_F(cst[3]);
#undef SGPR_F
    volatile LAS int* bw = (volatile LAS int*)(lds + ATT_BW);
    const bf16_t* QA = (const bf16_t*)(ws + WS_QA); const bf16_t* QB = (const bf16_t*)(ws + WS_QB);
    bf16_t* O = (bf16_t*)(ws + WS_O);
    const float* bias = A->in[16] + (size_t)l * 8 * 257;
    const float* gsub = A->in[21] + l * 128;
    for (;;) {
        int lane_l = lane_id_fresh(); asm volatile("" : "+v"(lane_l)); const int lane = lane_l;
        __syncthreads();
        if (wave == 0 && lane == 0) bw[0] = (int)atomicAdd(ctr, 1u);
        __syncthreads();
        const int uid = __builtin_amdgcn_readfirstlane(bw[0]);
        if (uid >= U_ALL) break;
        if (uid < U_BS) {
            attn_bs_block(A, l, uid >> 2, uid & 3, -shB, lam, post, gsub, lds, wave, lane);
        } else if (uid < U_B) {
            int b, h, T, tlim, row0, ldv; const bf16_t* K; const bf16_t* Vt;
            if (uid < U_BS) { b = uid >> 2; h = uid & 3; T = 33; tlim = wave < 2 ? 33 : 0; row0 = MP + b * 64 + 32 * (wave & 1); ldv = KSB_ROWS;
                K = (const bf16_t*)(ws + WS_KSB) + (size_t)(l * 32 + b) * KSB_ROWS * 512 + h * 128;
                Vt = (const bf16_t*)(ws + WS_VSB) + ((size_t)(l * 32 + b) * 512 + h * 128) * KSB_ROWS; }
            else { const int v = uid - U_BS, qb = 7 - (v >> 6), w = v & 63; b = w >> 2; h = w & 3; T = 4 * qb + 4; tlim = 4 * qb + (wave >> 1) + 1; row0 = b * 2048 + 256 * qb + 32 * wave; ldv = 2048;
                K = (const bf16_t*)(ws + WS_KBP) + (size_t)b * 2048 * 512 + h * 128;
                Vt = (const bf16_t*)(ws + WS_VBP) + ((size_t)b * 512 + h * 128) * 2048; }
            attn_b_block(QB + (size_t)row0 * 512 + h * 128, K, Vt, ldv, T, tlim, -shB, lam, post, gsub, O + (size_t)row0 * DM + 512 + h * 128, lds, wave, lane);
        } else {
            int b, h, T, t_lo, t_hi, t_self, row0, ldv; const bf16_t* K; const bf16_t* Vt;
            if (uid < U_B + U_AP) { const int v = uid - U_B, cq = 7 - (v >> 7), w = v & 127; b = w >> 3; h = w & 7;
                const int kc0 = cq >= 2 ? 4 * cq - 8 : 0, cw = 4 * cq + (wave >> 1);
                T = 4 * cq + 4 - kc0; t_self = cw - kc0; t_hi = t_self; t_lo = cw - 8 - kc0 > 0 ? cw - 8 - kc0 : 0; row0 = b * 2048 + 256 * cq + 32 * wave; ldv = 2048;
                K = (const bf16_t*)(ws + WS_KAP) + ((size_t)b * 2048 + 64 * kc0) * 512 + h * 64;
                Vt = (const bf16_t*)(ws + WS_VAP) + ((size_t)b * 512 + h * 64) * 2048 + 64 * kc0; }
            else { const int v = uid - U_B - U_AP; b = v >> 3; h = v & 7; T = 9; t_self = 8; t_lo = wave < 2 ? 0 : 1; t_hi = wave < 2 ? 8 : 0; row0 = MP + b * 64 + 32 * (wave & 1); ldv = KSA_ROWS;
                K = (const bf16_t*)(ws + WS_KSA) + (size_t)(l * 32 + b) * KSA_ROWS * 512 + h * 64;
                Vt = (const bf16_t*)(ws + WS_VSA) + ((size_t)(l * 32 + b) * 512 + h * 64) * KSA_ROWS; }
            LAS float* E = (LAS float*)(lds + ATT_WAVE + wave * 8192);
#pragma unroll
            for (int j = 0; j < 5; ++j) { const int i = lane + 64 * j; int rel = i - 64; rel = rel < -128 ? -128 : (rel > 128 ? 128 : rel); E[i] = LOG2E * bias[h * 257 + rel + 128] - shA; }
            attn_a_block(QA + (size_t)row0 * 512 + h * 64, K, Vt, ldv, T, t_lo, t_hi, t_self, 32 * (wave & 1), O + (size_t)row0 * DM + h * 64, lds, wave, lane);
        }
    }
}

__device__ __forceinline__ bool in_phase(int p) { KArgP k = (KArgP)__builtin_amdgcn_kernarg_segment_ptr(); asm volatile("" : "+s"(k)); return k->ph_lo <= p && p < k->ph_hi; }
__global__ void __launch_bounds__(512, 2) mega_fwd(Args KA) {
    extern __shared__ __attribute__((aligned(16))) unsigned char lds_raw[];
    LAS unsigned char* lds = (LAS unsigned char*)lds_raw;
    const int tid = threadIdx.x, wave = __builtin_amdgcn_readfirstlane(tid >> 6);
    const int G = gridDim.x, bx = blockIdx.x;
    const int vcu = (G % 8 == 0) ? (bx % 8) * (G / 8) + bx / 8 : bx;
    (void)KA;
    if (tid == 0) { ((volatile LAS unsigned*)(lds + ATT_BW + 64))[0] = 0u; ((volatile LAS unsigned*)(lds + ATT_BW + 64))[1] = 0u; ((volatile LAS unsigned*)(lds + ATT_BW + 64))[2] = (unsigned)bx; }
    __syncthreads();
#define FRESH_KAP(name) KArgP name = (KArgP)__builtin_amdgcn_kernarg_segment_ptr(); asm volatile("" : "+s"(name))
#define IN_PH(p) in_phase(p)
#define SEAM(p) do { FRESH_KAP(ks_); if (ks_->coop && (p) + 1 < ks_->ph_hi) { XcdBarrier xb_; xb_.bar = (unsigned*)(ks_->ws + WS_BAR); xb_.x = xb_xcc_id(); xb_.st = (volatile LAS unsigned*)(lds + ATT_BW + 64); xcd_barrier(xb_); } } while (0)
#define KARGS() KArgP kap = (KArgP)__builtin_amdgcn_kernarg_segment_ptr(); asm volatile("" : "+s"(kap)); unsigned char* ws = kap->ws; float* out = kap->out; \
    float* ssq = (float*)(ws + WS_SSQ); bf16_t* xb = (bf16_t*)(ws + WS_XB); bf16_t* ab = (bf16_t*)(ws + WS_A); unsigned char* wl = ws + WS_W + (size_t)l * W_LAYER; (void)ssq; (void)xb; (void)ab; (void)wl; (void)out; \
    const int cx = __builtin_amdgcn_readfirstlane((int)((volatile LAS unsigned*)(lds + ATT_BW + 64))[2])
    if (IN_PH(0)) {
        KArgP kap = (KArgP)__builtin_amdgcn_kernarg_segment_ptr(); asm volatile("" : "+s"(kap));
        prologue(kap, lds, vcu * 8 + wave, G * 8, wave);
#ifdef PROBE_PRO2
        prologue(kap, lds, vcu * 8 + wave, G * 8, wave);
#endif
        { FRESH_KAP(ks_); if (ks_->coop && 1 < ks_->ph_hi) { cg::this_grid().sync();
            if (tid == 0) { unsigned* bar_ = (unsigned*)(ks_->ws + WS_BAR); const unsigned x_ = xb_xcc_id(); const unsigned r_ = xb_add(&bar_[XB_XCNT(x_)], 1u);
                if (G == 256 && r_ < 32u && x_ < 8u) ((volatile LAS unsigned*)(lds + ATT_BW + 64))[2] = r_ * 8u + x_; }
            __syncthreads(); } }
    }
#pragma unroll 1
    for (int l = 0; l < 2; ++l) {
        const int p0 = 1 + 7 * l;
        if (IN_PH(p0 + 0)) {
            KARGS();
            pg8::Gemm g{xb, (const bf16_t*)(wl + W_GU1), MT, 2 * DFF, DM, DM, 0};
            pg8::StaticOrder S; S.init(MT, 2 * DFF, G, cx);
            EpiSwiGLU E{ab, ssq + (size_t)(3 * l) * MT};
            pg8::gemm_phase<EpiSwiGLU, pg8::StaticOrder, true, true>(lds, g, S, E, wave);
#ifdef PROBE_UP2
            pg8::gemm_phase<EpiSwiGLU, pg8::StaticOrder, true, true>(lds, g, S, E, wave);
#endif
            SEAM(p0 + 0);
        }
        if (IN_PH(p0 + 1)) {
            KARGS();
            pg8::Gemm g{ab, (const bf16_t*)(wl + W_D1), MT, DM, DFF, LDP, 2};
            pg8::TailSplitOrder S; S.init(MT, DM, G, cx, 0, DOWN_WGM);
            EpiResid E{kap->in[0], kap->in[1], out, xb, ssq + (size_t)(3 * l + 1) * MT, 0.5f, 1, 0};
            pg8::gemm_phase<EpiResid, pg8::TailSplitOrder, true, true>(lds, g, S, E, wave);
            SEAM(p0 + 1);
        }
        if (IN_PH(p0 + 2)) {
            {
                KARGS();
                pg8::Gemm g{xb, (const bf16_t*)(wl + W_IN), MT, 2048, DM, DM, 0};
                pg8::TailSplitOrder S; S.init(MT, 2048, G, cx);
                EpiQK E{ssq + (size_t)(3 * l + 1) * MT, ws, out, kap, l};
                pg8::gemm_phase<EpiQK, pg8::TailSplitOrder, true, true>(lds, g, S, E, wave);
#ifdef PROBE_QK2
                pg8::gemm_phase<EpiQK, pg8::TailSplitOrder, true, true>(lds, g, S, E, wave);
#endif
            }
            {
                KARGS();
                pg8::Gemm g{(const bf16_t*)(wl + W_IN) + (size_t)2048 * DM, xb, 1024, MT, DM, DM, 0};
                pg8::TailSplitOrder S; S.init(1024, MT, G, cx);
                EpiVt E{ssq + (size_t)(3 * l + 1) * MT, ws, out, l};
                pg8::gemm_phase<EpiVt, pg8::TailSplitOrder, true, true>(lds, g, S, E, wave);
#ifdef PROBE_VT2
                pg8::gemm_phase<EpiVt, pg8::TailSplitOrder, true, true>(lds, g, S, E, wave);
#endif
            }
            SEAM(p0 + 2);
        }
        if (IN_PH(p0 + 3)) {
            KArgP kap = (KArgP)__builtin_amdgcn_kernarg_segment_ptr(); asm volatile("" : "+s"(kap));
            attn_phase(kap, l, lds, wave, l);
#ifdef PROBE_ATTN2
            attn_phase(kap, l, lds, wave, 2 + l);
#endif
            SEAM(p0 + 3);
        }
        if (IN_PH(p0 + 4)) {
            KARGS();
            pg8::Gemm g{(const bf16_t*)(ws + WS_O), (const bf16_t*)(wl + W_OUT), MT, DM, DM, DM, 0};
            pg8::TailSplitOrder S; S.init(MT, DM, G, cx);
            EpiResid E{out, out + (size_t)MP * DM, out, xb, ssq + (size_t)(3 * l + 2) * MT, 1.0f, 1, 0};
            pg8::gemm_phase<EpiResid, pg8::TailSplitOrder, true, true>(lds, g, S, E, wave);
            SEAM(p0 + 4);
        }
        if (IN_PH(p0 + 5)) {
            KARGS();
            pg8::Gemm g{xb, (const bf16_t*)(wl + W_GU2), MT, 2 * DFF, DM, DM, 0};
            pg8::StaticOrder S; S.init(MT, 2 * DFF, G, cx);
            EpiSwiGLU E{ab, ssq + (size_t)(3 * l + 2) * MT};
            pg8::gemm_phase<EpiSwiGLU, pg8::StaticOrder, true, true>(lds, g, S, E, wave);
            SEAM(p0 + 5);
        }
        if (IN_PH(p0 + 6)) {
            KARGS();
            pg8::Gemm g{ab, (const bf16_t*)(wl + W_D2), MT, DM, DFF, LDP, 2};
            pg8::TailSplitOrder S; S.init(MT, DM, G, cx, 0, DOWN_WGM);
            EpiResid E{out, out + (size_t)MP * DM, out, xb, ssq + (size_t)(3 * l + 3) * MT, 0.5f, 1, l == 1 ? 1 : 0};
            pg8::gemm_phase<EpiResid, pg8::TailSplitOrder, true, true>(lds, g, S, E, wave);
            SEAM(p0 + 6);
        }
    }
}

#ifndef N_LAUNCH_MODE_GUARD_
#define N_LAUNCH_MODE_GUARD_
#endif
#ifndef N_LAUNCH_MODE
#define N_LAUNCH_MODE 0
#endif
extern "C" void kernel_launch(void* const* d_in, const int* in_sizes, int n_in, void* d_out, int out_size, void* d_ws, size_t ws_size, hipStream_t stream) {
    static int grid = 0;
    if (grid == 0) {
        if (n_in != 27 || ws_size < WS_END) { fprintf(stderr, "kernel_launch: unexpected inputs (n_in %d, ws %zu)\n", n_in, ws_size); grid = -1; return; }
        int dev = 0, cus = 0, per_cu = 0;
        hipGetDevice(&dev);
        hipDeviceGetAttribute(&cus, hipDeviceAttributeMultiprocessorCount, dev);
        hipFuncSetAttribute((const void*)mega_fwd, hipFuncAttributeMaxDynamicSharedMemorySize, LDS_BYTES);
        hipOccupancyMaxActiveBlocksPerMultiprocessor(&per_cu, (const void*)mega_fwd, 512, LDS_BYTES);
        (void)hipGetLastError();
        if (per_cu < 1) per_cu = 1;
        grid = cus;
        if (grid != 256) fprintf(stderr, "kernel_launch: note: %d CUs\n", grid);
    }
    if (grid < 0) return;
    Args a{};
    for (int i = 0; i < 27; ++i) a.in[i] = (const float*)d_in[i];
    a.out = (float*)d_out; a.ws = (unsigned char*)d_ws;
#if N_LAUNCH_MODE == 1
    for (int ph = 0; ph < NPHASE; ++ph) {
        a.ph_lo = ph; a.ph_hi = ph + 1; a.coop = 0;
        hipLaunchKernelGGL(mega_fwd, dim3(grid), dim3(512), LDS_BYTES, stream, a);
    }
#else
    a.ph_lo = 0; a.ph_hi = NPHASE; a.coop = 1;
    void* args[] = {&a};
    hipError_t e = hipLaunchCooperativeKernel((const void*)mega_fwd, dim3(grid), dim3(512), args, LDS_BYTES, stream);
    if (e != hipSuccess) fprintf(stderr, "cooperative launch failed: %s (grid %d)\n", hipGetErrorString(e), grid);
#endif
}
```

```cpp
#include <hip/hip_runtime.h>
#include <hip/hip_cooperative_groups.h>
#include <cstdio>
#include <cstdint>
#include <cstddef>
namespace cg = cooperative_groups;
__device__ __forceinline__ int lane_id_fresh() { int l; asm volatile("v_mbcnt_lo_u32_b32 %0, -1, 0\n\tv_mbcnt_hi_u32_b32 %0, -1, %0" : "=v"(l)); return l; }
#ifndef PG8_PFD
#define PG8_PFD 4
#endif
namespace pg8 {
#define PG8_LAS __attribute__((address_space(3)))
typedef unsigned short bf16_t;
typedef short bf16x8 __attribute__((ext_vector_type(8)));
typedef float f32x4 __attribute__((ext_vector_type(4)));
typedef unsigned u32x4 __attribute__((ext_vector_type(4)));
constexpr int BM = 256, BK = 64, HALF = 128, HTB = HALF * BK * 2  , STAGE_BYTES = 8 * HTB, NXCD = 8, WGM = 8;

__host__ __device__ __forceinline__ int lds_byte(int r, int c) { const int st = (r >> 4) * 2 + (c >> 5), rr = r & 15, cc = c & 31, ob = rr * 64 + cc * 2; return st * 1024 + (ob ^ (((ob >> 9) & 1) << 5)); }
__host__ __device__ __forceinline__ void stage_rc(int b, int& R, int& C) { const int st = b / 1024, sb = b % 1024, swz = sb ^ (((sb >> 9) & 1) << 5); R = (st >> 1) * 16 + swz / 64; C = (st & 1) * 32 + (swz % 64) / 2; }
__host__ __device__ __forceinline__ int perm32(int rho) { const int n = rho >> 4, i = rho & 15; return 8 * (i >> 2) + 4 * n + (i & 3); }

struct Unit { int pm, pn, hm; };
struct Gemm { const bf16_t* A; const bf16_t* Bt; int M, N, K, ld; int blocked; };

struct StaticOrder {
    int nM, nN, nwg, G, c, rev, wgm;
    __host__ __device__ void init(int M, int N, int G_, int c_, int rev_ = 0, int wgm_ = WGM) { nM = M / BM; nN = N / BM; nwg = nM * nN; G = G_; c = c_; rev = rev_; wgm = wgm_; }
    __host__ __device__ __forceinline__ void tile(int wgid, Unit& u) const {
        { const int q = nwg / NXCD, r = nwg % NXCD, xcd = wgid % NXCD, off = wgid / NXCD; wgid = (xcd < r ? xcd * (q + 1) : r * (q + 1) + (xcd - r) * q) + off; }
        const int nig = wgm * nN, gid = wgid / nig, fm = gid * wgm, gsz = (nM - fm) < wgm ? (nM - fm) : wgm;
        u.pm = fm + ((wgid % nig) % gsz); u.pn = (wgid % nig) / gsz; u.hm = 3;
        if (rev) u.pm = nM - 1 - u.pm;
    }
    __host__ __device__ bool next(int i, Unit& u) const {
        const long L = (long)i * G + c; if (L >= nwg) return false;
        tile((int)L, u); return true;
    }
    __device__ __forceinline__ void a_ready(const Unit&) const {}
    __device__ __forceinline__ void done(const Unit&) const {}
};
struct TailSplitOrder : StaticOrder {
    __host__ __device__ bool next(int i, Unit& u) const {
        const int nfull = (nwg / G) * G, L = i * G + c;
        if (L < nfull) { tile(L, u); return true; }
        const int idx = L - nfull;
        if (idx >= 2 * (nwg - nfull)) return false;
        tile(nfull + (idx >> 1), u); u.hm = 1 << (idx & 1); return true;
    }
};

__device__ __forceinline__ unsigned cvt_pk_bf16(float lo, float hi) { unsigned r; asm volatile("v_cvt_pk_bf16_f32 %0, %1, %2" : "=v"(r) : "v"(lo), "v"(hi)); return r; }
typedef float f32x2 __attribute__((ext_vector_type(2)));
template <class Epi, class Sched, bool ALIGN_EPI = false, bool SP2 = false>
__device__ __forceinline__ void gemm_phase(PG8_LAS unsigned char* lds, const Gemm g, const Sched& S, const Epi& E, int wave_in) {
    int tid_l = wave_in * 64 + lane_id_fresh(); asm volatile("" : "+v"(tid_l));
    const int tid = tid_l, wid = __builtin_amdgcn_readfirstlane(tid >> 6), lane = tid & 63, wr = wid >> 2, wc = wid & 3, fr = lane & 15, fq = lane >> 4;
    const int nt = g.K / BK, K = g.blocked ? BK : g.ld;
    unsigned voffA[2], voffB[2];
#pragma unroll
    for (int i = 0; i < 2; ++i) { int R, C; stage_rc(tid * 16 + i * 8192, R, C); const int Rb = Epi::PERM ? ((R & ~31) + perm32(R & 31)) : R;
        voffA[i] = (unsigned)(R * K + C) * 2u; voffB[i] = (unsigned)(Rb * K + C) * 2u;
        if (g.blocked == 2) { voffA[i] = (unsigned)(tid * 16 + i * 8192); voffB[i] = voffA[i]; } }
    const size_t kstep = g.blocked ? (size_t)(BM * BK * 2) : (size_t)(BK * 2);
    const size_t hstep = (size_t)HALF * K * 2;
    const size_t tstep = g.blocked ? (size_t)nt * (BM * BK * 2) : 2 * hstep;
    const unsigned ldsw = (unsigned)wid * 1024u;
    const int aoff = lds_byte(wr * 64 + fr, fq * 8), boff = lds_byte(wc * 32 + fr, fq * 8);
#define PG8_SA(b, h) (((b) * 2 + (h)) * HTB)
#define PG8_SB(b, h) ((4 + (b) * 2 + (h)) * HTB)
#define PG8_STAGE(bufoff, gbase, voff) do { _Pragma("unroll") for (int _i = 0; _i < 2; ++_i) \
        __builtin_amdgcn_global_load_lds((const unsigned*)((const char*)(gbase) + (voff)[_i]), (PG8_LAS unsigned*)(lds + (bufoff) + ldsw + _i * 8192), 16, 0, 0); } while (0)
#define PG8_LDA(dst, b, h) do { _Pragma("unroll") for (int m = 0; m < 4; ++m) _Pragma("unroll") for (int k = 0; k < 2; ++k) dst[m][k] = *(const PG8_LAS bf16x8*)(lds + PG8_SA(b, h) + aoff + m * 2048 + k * 1024); } while (0)
#define PG8_LDB(dst, b, h) do { _Pragma("unroll") for (int n = 0; n < 2; ++n) _Pragma("unroll") for (int k = 0; k < 2; ++k) dst[n][k] = *(const PG8_LAS bf16x8*)(lds + PG8_SB(b, h) + boff + n * 2048 + k * 1024); } while (0)
#define PG8_MMA(ai, bj, At, Bt) do { __builtin_amdgcn_s_setprio(1); _Pragma("unroll") for (int m = 0; m < 4; ++m) _Pragma("unroll") for (int n = 0; n < 2; ++n) _Pragma("unroll") for (int k = 0; k < 2; ++k) \
        acc[ai][bj][m][n] = __builtin_amdgcn_mfma_f32_16x16x32_bf16(Bt[n][k], At[m][k], acc[ai][bj][m][n], 0, 0, 0); __builtin_amdgcn_s_setprio(0); } while (0)
#define PG8_WAIT_V(n) asm volatile("s_waitcnt vmcnt(" #n ")" ::: "memory")
#define PG8_WAIT_L(n) asm volatile("s_waitcnt lgkmcnt(" #n ")" ::: "memory")
#define PG8_BAR __builtin_amdgcn_s_barrier()
#define PG8_SCHED __builtin_amdgcn_sched_barrier(0)
    Unit cur, nxt; int ui = 0;
    if (!S.next(0, cur)) return;
    f32x4 acc[2][2][4][2];
#pragma unroll
    for (int a = 0; a < 2; ++a)
#pragma unroll
        for (int b = 0; b < 2; ++b)
#pragma unroll
            for (int m = 0; m < 4; ++m)
#pragma unroll
                for (int n = 0; n < 2; ++n) acc[a][b][m][n] = (f32x4){0.f, 0.f, 0.f, 0.f};
    bf16x8 At[4][2], B0[2][2], B1[2][2];
    const char* cA = (const char*)g.A + (size_t)cur.pm * tstep; const char* cB = (const char*)g.Bt + (size_t)cur.pn * tstep;
    S.a_ready(cur);
    if constexpr (SP2) {
        PG8_STAGE(PG8_SB(0, 0), cB, voffB); PG8_STAGE(PG8_SB(0, 1), cB + hstep, voffB); PG8_STAGE(PG8_SA(0, 0), cA, voffA); PG8_STAGE(PG8_SA(0, 1), cA + hstep, voffA);
        if (wr == 1) PG8_BAR;
        PG8_WAIT_V(2); PG8_BAR;
        PG8_STAGE(PG8_SB(1, 0), cB + kstep, voffB); PG8_STAGE(PG8_SA(1, 0), cA + kstep, voffA); PG8_STAGE(PG8_SB(1, 1), cB + hstep + kstep, voffB);
        PG8_WAIT_V(6); PG8_BAR;
    } else {
        PG8_STAGE(PG8_SB(0, 0), cB, voffB); PG8_STAGE(PG8_SA(0, 0), cA, voffA); PG8_STAGE(PG8_SB(0, 1), cB + hstep, voffB); PG8_STAGE(PG8_SA(0, 1), cA + hstep, voffA);
        if (wr == 1) PG8_BAR;
        PG8_WAIT_V(4); PG8_BAR;
        PG8_STAGE(PG8_SB(1, 0), cB + kstep, voffB); PG8_STAGE(PG8_SA(1, 0), cA + kstep, voffA); PG8_STAGE(PG8_SB(1, 1), cB + hstep + kstep, voffB);
        PG8_WAIT_V(6); PG8_BAR;
    }
    for (;;) {
        const bool has_next = S.next(ui + 1, nxt);
        const char* nA = has_next ? (const char*)g.A + (size_t)nxt.pm * tstep : cA; const char* nB = has_next ? (const char*)g.Bt + (size_t)nxt.pn * tstep : cB;
        for (int t = 0; t < nt; t += 2) {
            const bool last = (t == nt - 2);
            const char* a1 = cA + (size_t)(t + 1) * kstep;
            const char* a2 = last ? nA : cA + (size_t)(t + 2) * kstep; const char* b2 = last ? nB : cB + (size_t)(t + 2) * kstep;
            const char* a3 = a2 + kstep; const char* b3 = b2 + kstep;
            if (last && has_next) S.a_ready(nxt);
            if constexpr (SP2) {
            PG8_LDB(B0, 0, 0); PG8_LDB(B1, 0, 1); PG8_SCHED; PG8_LDA(At, 0, 0); PG8_STAGE(PG8_SA(1, 1), a1 + hstep, voffA);
            PG8_WAIT_V(8); PG8_WAIT_L(0); PG8_BAR; if (cur.hm & 1) { PG8_MMA(0, 0, At, B0); PG8_MMA(0, 1, At, B1); } PG8_BAR; PG8_SCHED;
            PG8_LDA(At, 0, 1); PG8_STAGE(PG8_SB(0, 0), b2, voffB); PG8_STAGE(PG8_SB(0, 1), b2 + hstep, voffB); PG8_STAGE(PG8_SA(0, 0), a2, voffA);
            PG8_WAIT_V(8); PG8_WAIT_L(0); PG8_BAR; if (cur.hm & 2) { PG8_MMA(1, 0, At, B0); PG8_MMA(1, 1, At, B1); } PG8_BAR; PG8_SCHED;
            PG8_LDB(B0, 1, 0); PG8_LDB(B1, 1, 1); PG8_SCHED; PG8_LDA(At, 1, 0); PG8_STAGE(PG8_SA(0, 1), a2 + hstep, voffA);
            PG8_WAIT_V(8); PG8_WAIT_L(0); PG8_BAR; if (cur.hm & 1) { PG8_MMA(0, 0, At, B0); PG8_MMA(0, 1, At, B1); } PG8_BAR; PG8_SCHED;
            PG8_LDA(At, 1, 1); PG8_STAGE(PG8_SB(1, 0), b3, voffB); PG8_STAGE(PG8_SB(1, 1), b3 + hstep, voffB); PG8_STAGE(PG8_SA(1, 0), a3, voffA);
            PG8_WAIT_V(8); PG8_WAIT_L(0); PG8_BAR; if (cur.hm & 2) { PG8_MMA(1, 0, At, B0); PG8_MMA(1, 1, At, B1); } PG8_BAR; PG8_SCHED;
            } else {
            PG8_LDB(B0, 0, 0); PG8_SCHED; PG8_LDA(At, 0, 0); PG8_STAGE(PG8_SA(1, 1), a1 + hstep, voffA);
            PG8_WAIT_L(8); PG8_BAR; PG8_WAIT_L(0); PG8_MMA(0, 0, At, B0); PG8_BAR; PG8_SCHED;
            PG8_LDB(B1, 0, 1); PG8_STAGE(PG8_SB(0, 0), b2, voffB);
            PG8_BAR; PG8_WAIT_L(0); PG8_MMA(0, 1, At, B1); PG8_BAR;
            PG8_LDA(At, 0, 1); PG8_STAGE(PG8_SA(0, 0), a2, voffA);
            PG8_BAR; PG8_WAIT_L(0); PG8_MMA(1, 0, At, B0); PG8_BAR; PG8_SCHED;
            PG8_STAGE(PG8_SB(0, 1), b2 + hstep, voffB);
            PG8_WAIT_V(6); PG8_BAR; PG8_MMA(1, 1, At, B1); PG8_BAR;
            PG8_LDB(B0, 1, 0); PG8_SCHED; PG8_LDA(At, 1, 0); PG8_STAGE(PG8_SA(0, 1), a2 + hstep, voffA);
            PG8_WAIT_L(8); PG8_BAR; PG8_WAIT_L(0); PG8_MMA(0, 0, At, B0); PG8_BAR; PG8_SCHED;
            PG8_LDB(B1, 1, 1); PG8_STAGE(PG8_SB(1, 0), b3, voffB);
            PG8_BAR; PG8_WAIT_L(0); PG8_MMA(0, 1, At, B1); PG8_BAR;
            PG8_LDA(At, 1, 1); PG8_STAGE(PG8_SA(1, 0), a3, voffA);
            PG8_BAR; PG8_WAIT_L(0); PG8_MMA(1, 0, At, B0); PG8_BAR; PG8_SCHED;
            PG8_STAGE(PG8_SB(1, 1), b3 + hstep, voffB);
            PG8_WAIT_V(6); PG8_BAR; PG8_MMA(1, 1, At, B1); PG8_BAR;
            }
        }
        if constexpr (ALIGN_EPI) { if (wr == 0) PG8_BAR; }
        if constexpr (!Epi::AFTER_DRAIN) { E(acc, cur, wr, wc, fr, fq); S.done(cur); }
        if (!has_next) break;
#pragma unroll
        for (int a = 0; a < 2; ++a)
#pragma unroll
            for (int b = 0; b < 2; ++b)
#pragma unroll
                for (int m = 0; m < 4; ++m)
#pragma unroll
                    for (int n = 0; n < 2; ++n) acc[a][b][m][n] = (f32x4){0.f, 0.f, 0.f, 0.f};
        cur = nxt; cA = nA; cB = nB; ++ui;
        if constexpr (ALIGN_EPI) { if (wr == 1) PG8_BAR; }
    }
    PG8_WAIT_V(0);
    if constexpr (!ALIGN_EPI) { if (wr == 0) PG8_BAR; }
    PG8_BAR;
    if constexpr (Epi::AFTER_DRAIN) { E.fused(acc, cur, wr, wc, fr, fq, lds, wid, lane); S.done(cur); }
#undef PG8_SA
#undef PG8_SB
#undef PG8_STAGE
#undef PG8_LDA
#undef PG8_LDB
#undef PG8_MMA
#undef PG8_WAIT_V
#undef PG8_WAIT_L
#undef PG8_BAR
#undef PG8_SCHED
}
}
using pg8::bf16_t; using pg8::bf16x8; using pg8::f32x4; using pg8::u32x4; using pg8::Unit; using pg8::cvt_pk_bf16;
typedef float f32x16 __attribute__((ext_vector_type(16)));
typedef unsigned u32x2 __attribute__((ext_vector_type(2)));
#define LAS __attribute__((address_space(3)))

constexpr int DM = 1024, SEQ = 2048, DSEQ = 64;
constexpr int MP = 16 * 2048, MS = 32 * 64, MT = MP + MS;
constexpr int DFF = 2816, LDP = 2880;
constexpr int KSA_ROWS = 576, KSB_ROWS = 2112;
constexpr float EPS = 1e-6f, LOG2E = 1.4426950408889634f, QSCALE = 0.125f * 1.4426950408889634f;
constexpr int NPHASE = 15;
#ifndef DOWN_WGM
#define DOWN_WGM 8
#endif
constexpr size_t MiB = 1u << 20;
constexpr size_t WS_CTL = 0, WS_BAR = 65536, WS_SSQ = 1 * MiB, WS_ROPE = 2 * MiB, WS_W = 4 * MiB;
constexpr size_t W_GU1 = 0, W_D1 = 11 * MiB, W_IN = 17 * MiB, W_OUT = 23 * MiB, W_GU2 = 25 * MiB, W_D2 = 36 * MiB, W_LAYER = 42 * MiB;
constexpr size_t WS_XB = 88 * MiB, WS_A = 156 * MiB, WS_QA = WS_A, WS_QB = WS_A + 34 * MiB, WS_O = WS_A + 68 * MiB;
constexpr size_t WS_KAP = 352 * MiB, WS_KBP = 384 * MiB, WS_VAP = 416 * MiB, WS_VBP = 448 * MiB;
constexpr size_t WS_KSA = 480 * MiB, WS_VSA = 516 * MiB, WS_KSB = 552 * MiB, WS_VSB = 684 * MiB, WS_END = 816 * MiB;
static_assert(W_D2 + (size_t)1024 * LDP * 2 <= W_LAYER && WS_W + 2 * W_LAYER <= WS_XB && WS_A + (size_t)MT * LDP * 2 <= WS_KAP, "d_ws map");
constexpr size_t OUT_YP = 0, OUT_YS = 33554432, OUT_PAK = 35651584, OUT_PAV = 44040192, OUT_PBK = 52428800, OUT_PBV = 85983232,
                 OUT_SAK = 119537664, OUT_SAV = 121634816, OUT_SBK = 123731968, OUT_SBV = 125829120;
constexpr int LDS_BYTES = 147456;

struct Args { const float* in[27]; float* out; unsigned char* ws; int ph_lo, ph_hi, coop, pad; };
typedef const __attribute__((address_space(4))) Args* KArgP;

__device__ const double ROPE_INV[32] = {1.0, 0.7498942093324559, 0.5623413251903491, 0.4216965034285822, 0.31622776601683794, 0.23713737056616552, 0.1778279410038923, 0.1333521432163324, 0.1, 0.07498942093324558, 0.05623413251903491, 0.042169650342858224, 0.03162277660168379, 0.023713737056616554, 0.01778279410038923, 0.01333521432163324, 0.01, 0.007498942093324558, 0.005623413251903491, 0.004216965034285823, 0.0031622776601683794, 0.0023713737056616554, 0.0017782794100389228, 0.001333521432163324, 0.001, 0.0007498942093324559, 0.0005623413251903491, 0.00042169650342858224, 0.00031622776601683794, 0.00023713737056616554, 0.00017782794100389227, 0.0001333521432163324};

__device__ __forceinline__ float shx(float v, int lane, int m) { return __builtin_bit_cast(float, __builtin_amdgcn_ds_bpermute((lane ^ m) << 2, __builtin_bit_cast(int, v))); }
__device__ __forceinline__ float wave_sum(float v, int lane) {
#pragma unroll
    for (int o = 1; o < 64; o <<= 1) v += shx(v, lane, o);
    return v;
}
__device__ __forceinline__ float wave_max(float v, int lane) {
#pragma unroll
    for (int o = 1; o < 64; o <<= 1) v = fmaxf(v, shx(v, lane, o));
    return v;
}
__device__ __forceinline__ float fast_rcp(float x) { return __builtin_amdgcn_rcpf(x); }
__device__ __forceinline__ float fast_exp2(float x) { return __builtin_amdgcn_exp2f(x); }

struct EpiSwiGLU {
    static constexpr bool PERM = true, AFTER_DRAIN = false;
    bf16_t* O; const float* ssq;
    __device__ __forceinline__ void operator()(const f32x4 (&acc)[2][2][4][2], const Unit& u, int wr, int wc, int fr, int fq) const {
        const int row0 = u.pm * 256 + wr * 64 + fr, col0 = u.pn * 128 + wc * 32 + 8 * fq;
        float sq[2][4];
#pragma unroll
        for (int ai = 0; ai < 2; ++ai)
#pragma unroll
            for (int m = 0; m < 4; ++m) sq[ai][m] = ssq[row0 + ai * 128 + m * 16];
#pragma unroll
        for (int ai = 0; ai < 2; ++ai)
#pragma unroll
            for (int m = 0; m < 4; ++m) {
                if (!((u.hm >> ai) & 1)) continue;
                const int row = row0 + ai * 128 + m * 16;
                const float rstd = rsqrtf(sq[ai][m] * (1.0f / DM) + EPS);
                float o[8];
#pragma unroll
                for (int n = 0; n < 2; ++n)
#pragma unroll
                    for (int i = 0; i < 4; ++i) {
                        const float g = acc[ai][0][m][n][i] * rstd, up = acc[ai][1][m][n][i] * rstd;
                        const float sg = g * fast_rcp(1.0f + fast_exp2(-g * LOG2E));
                        o[n * 4 + i] = sg * up;
                    }
                u32x4 w; w.x = cvt_pk_bf16(o[0], o[1]); w.y = cvt_pk_bf16(o[2], o[3]); w.z = cvt_pk_bf16(o[4], o[5]); w.w = cvt_pk_bf16(o[6], o[7]);
                *(u32x4*)((char*)O + (((size_t)(row >> 8) * (DFF / 64) + (col0 >> 6)) * 2 + ((row >> 7) & 1)) * 16384 + pg8::lds_byte(row & 127, col0 & 63)) = w;
            }
    }
};
struct EpiResid {
    static constexpr bool PERM = false, AFTER_DRAIN = false;
    const float* xin_p; const float* xin_s; float* xout; bf16_t* xb; float* ssq; float scale; int res_bf16, write_f32;
    __device__ __forceinline__ void operator()(const f32x4 (&acc)[2][2][4][2], const Unit& u, int wr, int wc, int fr, int fq) const {
        const int col0 = u.pn * 256 + wc * 32 + 4 * fq;
#pragma unroll
        for (int ai = 0; ai < 2; ++ai) {
            if (!((u.hm >> ai) & 1)) continue;
            const int rowb = u.pm * 256 + ai * 128 + wr * 64 + fr;
            f32x4 pre[4][2][2];
            if (res_bf16) {
                u32x2 pw[4][2][2];
#pragma unroll
                for (int m = 0; m < 4; ++m)
#pragma unroll
                    for (int bj = 0; bj < 2; ++bj)
#pragma unroll
                        for (int n = 0; n < 2; ++n) pw[m][bj][n] = *(const u32x2*)(xb + (size_t)(rowb + m * 16) * DM + col0 + bj * 128 + n * 16);
#pragma unroll
                for (int m = 0; m < 4; ++m)
#pragma unroll
                    for (int bj = 0; bj < 2; ++bj)
#pragma unroll
                        for (int n = 0; n < 2; ++n) { const u32x2 w = pw[m][bj][n]; f32x4 p;
                            p[0] = __builtin_bit_cast(float, w.x << 16); p[1] = __builtin_bit_cast(float, w.x & 0xffff0000u);
                            p[2] = __builtin_bit_cast(float, w.y << 16); p[3] = __builtin_bit_cast(float, w.y & 0xffff0000u); pre[m][bj][n] = p; }
            } else {
                const float* xi = (rowb < MP) ? xin_p + (size_t)rowb * DM : xin_s + (size_t)(rowb - MP) * DM;
#pragma unroll
                for (int m = 0; m < 4; ++m)
#pragma unroll
                    for (int bj = 0; bj < 2; ++bj)
#pragma unroll
                        for (int n = 0; n < 2; ++n) pre[m][bj][n] = *(const f32x4*)(xi + (size_t)m * 16 * DM + col0 + bj * 128 + n * 16);
            }
#pragma unroll
            for (int m = 0; m < 4; ++m) {
                const int row = rowb + m * 16;
                float sq = 0.f;
#pragma unroll
                for (int bj = 0; bj < 2; ++bj)
#pragma unroll
                    for (int n = 0; n < 2; ++n) {
                        const int c = col0 + bj * 128 + n * 16;
                        const f32x4 v = pre[m][bj][n] + acc[ai][bj][m][n] * scale;
                        if (write_f32) *(f32x4*)(xout + (size_t)row * DM + c) = v;
                        else { u32x2 w; w.x = cvt_pk_bf16(v[0], v[1]); w.y = cvt_pk_bf16(v[2], v[3]); *(u32x2*)(xb + (size_t)row * DM + c) = w; }
                        sq += (v[0] * v[0] + v[1] * v[1]) + (v[2] * v[2] + v[3] * v[3]);
                    }
                sq += shx(sq, fr + 16 * fq, 16); sq += shx(sq, fr + 16 * fq, 32);
                if (fq == 0 && !write_f32) atomicAdd(ssq + row, sq);
            }
        }
    }
};
struct EpiQK {
    static constexpr bool PERM = true, AFTER_DRAIN = false;
    const float* ssq; unsigned char* ws; float* out; KArgP kap; int l;
    __device__ __forceinline__ void operator()(const f32x4 (&acc)[2][2][4][2], const Unit& u, int wr, int wc, int fr, int fq) const {
        const int sec = u.pn >> 1, hd = 4 * (u.pn & 1) + wc;
        const float* gp = kap->in[12 + sec] + l * 64;
        const float* rope = (const float*)(ws + WS_ROPE);
        bf16_t* QA = (bf16_t*)(ws + WS_QA); bf16_t* QB = (bf16_t*)(ws + WS_QB); bf16_t* KAP = (bf16_t*)(ws + WS_KAP); bf16_t* KBP = (bf16_t*)(ws + WS_KBP);
        bf16_t* KSA = (bf16_t*)(ws + WS_KSA) + (size_t)l * 32 * KSA_ROWS * 512; bf16_t* KSB = (bf16_t*)(ws + WS_KSB) + (size_t)l * 32 * KSB_ROWS * 512;
        float* oPAK = out + OUT_PAK + (size_t)l * 16 * 512 * 512; float* oPBK = out + OUT_PBK + (size_t)l * MP * 512;
        float* oSAK = out + OUT_SAK + (size_t)l * MS * 512; float* oSBK = out + OUT_SBK + (size_t)l * MS * 512;
        f32x4 gl[2], gh[2];
#pragma unroll
        for (int n = 0; n < 2; ++n) { gl[n] = *(const f32x4*)(gp + 8 * fq + 4 * n); gh[n] = *(const f32x4*)(gp + 32 + 8 * fq + 4 * n); }
        const int cbase = hd * 64 + 8 * fq;
        float sqr[2][4];
#pragma unroll
        for (int ai = 0; ai < 2; ++ai)
#pragma unroll
            for (int m = 0; m < 4; ++m) sqr[ai][m] = ssq[u.pm * 256 + ai * 128 + wr * 64 + m * 16 + fr];
#pragma unroll
        for (int ai = 0; ai < 2; ++ai)
#pragma unroll
            for (int m = 0; m < 4; ++m) {
                if (!((u.hm >> ai) & 1)) continue;
                const int row = u.pm * 256 + ai * 128 + wr * 64 + m * 16 + fr;
                const float rstd = rsqrtf(sqr[ai][m] * (1.0f / DM) + EPS);
                f32x4 y[2][2]; float ss = 0.f;
#pragma unroll
                for (int bj = 0; bj < 2; ++bj)
#pragma unroll
                    for (int n = 0; n < 2; ++n) { const f32x4 v = acc[ai][bj][m][n] * rstd; y[bj][n] = v; ss += (v[0] * v[0] + v[1] * v[1]) + (v[2] * v[2] + v[3] * v[3]); }
                ss += shx(ss, fr + 16 * fq, 16); ss += shx(ss, fr + 16 * fq, 32);
                const float rr = rsqrtf(ss * (1.0f / 64.0f) + EPS);
#pragma unroll
                for (int n = 0; n < 2; ++n) { y[0][n] = y[0][n] * rr * gl[n]; y[1][n] = y[1][n] * rr * gh[n]; }
                const bool prompt = row < MP;
                const int sp = row & 2047, bp = row >> 11, ts = (row - MP) & 63, bs = (row - MP) >> 6;
                if (sec >= 2) {
                    const int pos = prompt ? sp : 2048 + ts;
                    const float* cs = rope + (size_t)pos * 64 + 8 * fq;
#pragma unroll
                    for (int n = 0; n < 2; ++n) {
                        const f32x4 c = *(const f32x4*)(cs + 4 * n), s = *(const f32x4*)(cs + 32 + 4 * n);
                        const f32x4 x1 = y[0][n], x2 = y[1][n];
                        y[0][n] = x1 * c - x2 * s; y[1][n] = x2 * c + x1 * s;
                    }
                }
                if (sec == 0 || sec == 2) {
                    bf16_t* dst = (sec == 0 ? QA : QB) + (size_t)row * 512 + cbase;
#pragma unroll
                    for (int bj = 0; bj < 2; ++bj) {
                        const f32x4 a = y[bj][0] * QSCALE, b = y[bj][1] * QSCALE;
                        u32x4 w; w.x = cvt_pk_bf16(a[0], a[1]); w.y = cvt_pk_bf16(a[2], a[3]); w.z = cvt_pk_bf16(b[0], b[1]); w.w = cvt_pk_bf16(b[2], b[3]);
                        *(u32x4*)(dst + 32 * bj) = w;
                    }
                } else {
                    bf16_t* dst; float* fo = nullptr;
                    if (sec == 1) {
                        if (prompt) { dst = KAP + (size_t)row * 512; if (sp >= 1536) fo = oPAK + (size_t)(bp * 512 + sp - 1536) * 512; }
                        else { dst = KSA + (size_t)(bs * KSA_ROWS + 512 + ts) * 512; fo = oSAK + (size_t)(row - MP) * 512; }
                    } else {
                        if (prompt) { dst = KBP + (size_t)row * 512; fo = oPBK + (size_t)row * 512; }
                        else { dst = KSB + (size_t)(bs * KSB_ROWS + 2048 + ts) * 512; fo = oSBK + (size_t)(row - MP) * 512; }
                    }
#pragma unroll
                    for (int bj = 0; bj < 2; ++bj) {
                        const f32x4 a = y[bj][0], b = y[bj][1];
                        u32x4 w; w.x = cvt_pk_bf16(a[0], a[1]); w.y = cvt_pk_bf16(a[2], a[3]); w.z = cvt_pk_bf16(b[0], b[1]); w.w = cvt_pk_bf16(b[2], b[3]);
                        *(u32x4*)(dst + cbase + 32 * bj) = w;
                        if (fo) { *(f32x4*)(fo + cbase + 32 * bj) = a; *(f32x4*)(fo + cbase + 32 * bj + 4) = b; }
                    }
                }
            }
    }
};
struct EpiVt {
    static constexpr bool PERM = true, AFTER_DRAIN = false;
    const float* ssq; unsigned char* ws; float* out; int l;
    __device__ __forceinline__ void operator()(const f32x4 (&acc)[2][2][4][2], const Unit& u, int wr, int wc, int fr, int fq) const {
        bf16_t* VAP = (bf16_t*)(ws + WS_VAP); bf16_t* VBP = (bf16_t*)(ws + WS_VBP);
        bf16_t* VSA = (bf16_t*)(ws + WS_VSA) + (size_t)l * 32 * 512 * KSA_ROWS; bf16_t* VSB = (bf16_t*)(ws + WS_VSB) + (size_t)l * 32 * 512 * KSB_ROWS;
        float* oPAV = out + OUT_PAV + (size_t)l * 16 * 512 * 512; float* oPBV = out + OUT_PBV + (size_t)l * MP * 512;
        float* oSAV = out + OUT_SAV + (size_t)l * MS * 512; float* oSBV = out + OUT_SBV + (size_t)l * MS * 512;
        const int grp = u.pm >> 1;
        const bool prompt = u.pn < (MP / 256);
        f32x4 rs[2][2];
#pragma unroll
        for (int bj = 0; bj < 2; ++bj)
#pragma unroll
            for (int n = 0; n < 2; ++n) {
                const f32x4 q = *(const f32x4*)(ssq + u.pn * 256 + bj * 128 + wc * 32 + 8 * fq + 4 * n);
                f32x4 r; r[0] = rsqrtf(q[0] * (1.0f / DM) + EPS); r[1] = rsqrtf(q[1] * (1.0f / DM) + EPS); r[2] = rsqrtf(q[2] * (1.0f / DM) + EPS); r[3] = rsqrtf(q[3] * (1.0f / DM) + EPS);
                rs[bj][n] = r;
            }
#pragma unroll
        for (int bj = 0; bj < 2; ++bj) {
            const int tok = u.pn * 256 + bj * 128 + wc * 32 + 8 * fq;
            const int bp = tok >> 11, sp = tok & 2047, tt = tok - MP, bs = tt >> 6, ts = tt & 63;
            bf16_t* vdst; size_t vld; float* fo = nullptr;
            if (prompt) { vdst = (grp == 0 ? VAP : VBP) + (size_t)bp * 512 * 2048 + sp; vld = 2048;
                if (grp == 0) { if (sp >= 1536) fo = oPAV + (size_t)(bp * 512 + sp - 1536) * 512; } else fo = oPBV + (size_t)tok * 512; }
            else { if (grp == 0) { vdst = VSA + (size_t)bs * 512 * KSA_ROWS + 512 + ts; vld = KSA_ROWS; fo = oSAV + (size_t)tt * 512; }
                   else { vdst = VSB + (size_t)bs * 512 * KSB_ROWS + 2048 + ts; vld = KSB_ROWS; fo = oSBV + (size_t)tt * 512; } }
#pragma unroll
            for (int ai = 0; ai < 2; ++ai)
#pragma unroll
                for (int m = 0; m < 4; ++m) {
                    if (!((u.hm >> ai) & 1)) continue;
                    const int hrow = (ai * 128 + wr * 64 + m * 16 + fr) + (u.pm & 1) * 256;
                    const f32x4 a = acc[ai][bj][m][0] * rs[bj][0], b = acc[ai][bj][m][1] * rs[bj][1];
                    u32x4 w; w.x = cvt_pk_bf16(a[0], a[1]); w.y = cvt_pk_bf16(a[2], a[3]); w.z = cvt_pk_bf16(b[0], b[1]); w.w = cvt_pk_bf16(b[2], b[3]);
                    *(u32x4*)(vdst + (size_t)hrow * vld) = w;
                    if (fo) {
#pragma unroll
                        for (int i = 0; i < 4; ++i) { fo[(size_t)i * 512 + hrow] = a[i]; fo[(size_t)(4 + i) * 512 + hrow] = b[i]; }
                    }
                }
        }
    }
};
#define XB_TMO      128
#define XB_XCNT(j)  (256  + 64 * (j))
#define XB_XSUB(j)  (1280 + 64 * (j))
#define XB_XGEN(j)  (2304 + 64 * (j))
#define XB_TOP      3328
#define XB_TOPGEN   3392
#define XCD_BAR_WORDS 3456
#define XB_SPIN_CAP (1u << 18)

__device__ __forceinline__ unsigned xb_ld(unsigned* p)              { return __hip_atomic_load(p, __ATOMIC_RELAXED, __HIP_MEMORY_SCOPE_AGENT); }
__device__ __forceinline__ unsigned xb_add(unsigned* p, unsigned v) { return __hip_atomic_fetch_add(p, v, __ATOMIC_RELAXED, __HIP_MEMORY_SCOPE_AGENT); }
__device__ __forceinline__ unsigned xb_xcc_id() { return (unsigned)__builtin_amdgcn_s_getreg((3 << 11) | 20) & 0xFu; }
#define XB_SPIN(cond, bar) do { unsigned _sp = 0; while (cond) { __builtin_amdgcn_s_sleep(1); \
    if ((++_sp & 255u) == 0u) { if (xb_ld(&(bar)[XB_TMO])) break; if (_sp > XB_SPIN_CAP) { atomicAdd(&(bar)[XB_TMO], 1u); break; } } } } while (0)

struct XcdBarrier {
    unsigned* bar; unsigned x;
    volatile LAS unsigned* st;
};

__device__ __forceinline__ XcdBarrier xcd_barrier_post(unsigned* bar, volatile LAS unsigned* st) {
    XcdBarrier b; b.bar = bar; b.x = xb_xcc_id(); b.st = st;
    if (threadIdx.x == 0) (void)xb_add(&bar[XB_XCNT(b.x)], 1u);
    return b;
}
__device__ __forceinline__ void xcd_barrier_complete(unsigned* bar, unsigned x, unsigned& nloc, unsigned& nx) {
    const unsigned G = gridDim.x * gridDim.y * gridDim.z;
    unsigned sum, cnt, mine, sp = 0u;
    for (;;) {
        sum = 0u; cnt = 0u; mine = 0u;
#pragma unroll
        for (unsigned j = 0; j < 16; ++j) { const unsigned c = xb_ld(&bar[XB_XCNT(j)]); sum += c; cnt += (c > 0u) ? 1u : 0u; mine = (j == x) ? c : mine; }
        if (sum == G) break;
        __builtin_amdgcn_s_sleep(1);
        if ((++sp & 255u) == 0u) { if (xb_ld(&bar[XB_TMO])) break; if (sp > XB_SPIN_CAP) { atomicAdd(&bar[XB_TMO], 1u); break; } }
    }
    nloc = mine > 0u ? mine : 1u; nx = cnt > 0u ? cnt : 1u;
}

__device__ __forceinline__ void xcd_barrier(const XcdBarrier& b) {
    asm volatile("s_waitcnt vmcnt(0)" ::: "memory");
    __syncthreads();
    if (threadIdx.x == 0) {
        unsigned* bar = b.bar;
        __builtin_amdgcn_s_waitcnt(0);
        unsigned nloc = b.st[0], nx = b.st[1];
        if (nloc == 0u) { xcd_barrier_complete(bar, b.x, nloc, nx); b.st[0] = nloc; b.st[1] = nx; }
        const unsigned old = xb_add(&bar[XB_XSUB(b.x)], 1u);
        const unsigned gen = old / nloc;
        if (old + 1u == (gen + 1u) * nloc) {
            __builtin_amdgcn_fence(__ATOMIC_RELEASE, "agent");
            asm volatile("s_waitcnt vmcnt(0)" ::: "memory");
            const unsigned og = xb_add(&bar[XB_TOP], 1u);
            const unsigned tg = og / nx;
            if (og + 1u == (tg + 1u) * nx) xb_add(&bar[XB_TOPGEN], 1u);
            else XB_SPIN(xb_ld(&bar[XB_TOPGEN]) == tg, bar);
            __builtin_amdgcn_fence(__ATOMIC_ACQUIRE, "agent");
            xb_add(&bar[XB_XGEN(b.x)], 1u);
            asm volatile("s_waitcnt vmcnt(0)" ::: "memory");
        } else {
            XB_SPIN(xb_ld(&bar[XB_XGEN(b.x)]) == gen, bar);
            __builtin_amdgcn_fence(__ATOMIC_ACQUIRE, "agent");
            asm volatile("s_waitcnt vmcnt(0)" ::: "memory");
        }
    }
    __syncthreads();
}
__device__ __forceinline__ int map_row(int kind, int n) {
    if (kind == 0) return n;
    if (kind == 1) return 256 * (n >> 7) + (n & 127);
    if (kind == 2) return 256 * (n >> 7) + 128 + (n & 127);
    const int sec = n >> 9, w = n & 511;
    if (sec == 2) return 2048 + w;
    if (sec == 5) return 2560 + w;
    const int qsec = sec == 0 ? 0 : sec == 1 ? 1 : sec == 3 ? 2 : 3;
    const int c = qsec * 512 + w, pn = c >> 8, ww = c & 255, hw = ww >> 6, d = ww & 63;
    return 256 * pn + 128 * (d >> 5) + 32 * hw + (d & 31);
}
__device__ __forceinline__ void transpose_item(const float* src, int ld_src, int k0, int n0, const float* gain, bf16_t* dst, size_t ld_dst, int kind, LAS float* scr, int lane) {
    float tv[32];
#pragma unroll
    for (int i = 0; i < 32; ++i) tv[i] = src[(size_t)(k0 + 2 * i + (lane >> 5)) * ld_src + n0 + (lane & 31)];
    if (gain) {
#pragma unroll
        for (int i = 0; i < 32; ++i) tv[i] *= gain[k0 + 2 * i + (lane >> 5)];
    }
#pragma unroll
    for (int i = 0; i < 32; ++i) scr[(2 * i + (lane >> 5)) * 33 + (lane & 31)] = tv[i];
    asm volatile("s_waitcnt lgkmcnt(0)" ::: "memory");
    const int c = lane & 7;
#pragma unroll
    for (int j = 0; j < 4; ++j) {
        const int n = (lane >> 3) + 8 * j; const LAS float* s = scr + (8 * c) * 33 + n;
        u32x4 o; o.x = cvt_pk_bf16(s[0 * 33], s[1 * 33]); o.y = cvt_pk_bf16(s[2 * 33], s[3 * 33]); o.z = cvt_pk_bf16(s[4 * 33], s[5 * 33]); o.w = cvt_pk_bf16(s[6 * 33], s[7 * 33]);
        if (kind == 4) { const int row = n0 + n; *(u32x4*)((char*)dst + (((size_t)(row >> 8) * (DFF / 64) + (k0 >> 6)) * 2 + ((row >> 7) & 1)) * 16384 + pg8::lds_byte(row & 127, 8 * c)) = o; }
        else *(u32x4*)(dst + (size_t)map_row(kind, n0 + n) * ld_dst + k0 + 8 * c) = o;
    }
    asm volatile("s_waitcnt lgkmcnt(0)" ::: "memory");
}
__device__ __forceinline__ void do_job(const float* src, int R, int C, const float* gain, bf16_t* dst, size_t ld_dst, int kind, int item, LAS float* scr, int lane) {
    const int nblk = C >> 5, kb = item / nblk, nb = item - kb * nblk;
    (void)R;
    transpose_item(src, C, 64 * kb, 32 * nb, gain, dst, ld_dst, kind, scr, lane);
}

__device__ __forceinline__ void convert_caches(KArgP A, LAS unsigned char* lds, int l, int gw, int NGW, int wave) {
    int lane_l = lane_id_fresh(); asm volatile("" : "+v"(lane_l)); const int lane = lane_l;
    unsigned char* ws = A->ws;
    LAS float* scr = (LAS float*)(lds + wave * 16384);
    constexpr int I_CAV = 32 * 128;
    for (int it = gw; it < I_CAV; it += NGW) {
        {
            const int lb = l * 32 + (it >> 7), item = it & 127;
            do_job(A->in[3] + (size_t)lb * 512 * 512, 512, 512, nullptr, (bf16_t*)(ws + WS_VSA) + (size_t)lb * 512 * KSA_ROWS, KSA_ROWS, 0, item, scr, lane);
        }
    }
    for (int r = gw; r < 32 * 512; r += NGW) {
        const float* s; bf16_t* d;
        if (r < 32 * 512) { const int lb = l * 32 + (r >> 9), key = r & 511; s = A->in[2] + ((size_t)lb * 512 + key) * 512; d = (bf16_t*)(ws + WS_KSA) + (size_t)(lb * KSA_ROWS + key) * 512; }
        else { const int q = r - 32 * 512, lb = l * 32 + (q >> 11), key = q & 2047; s = A->in[4] + ((size_t)lb * 2048 + key) * 512; d = (bf16_t*)(ws + WS_KSB) + (size_t)(lb * KSB_ROWS + key) * 512; }
        const f32x4 a = *(const f32x4*)(s + 8 * lane), b = *(const f32x4*)(s + 8 * lane + 4);
        u32x4 w; w.x = cvt_pk_bf16(a[0], a[1]); w.y = cvt_pk_bf16(a[2], a[3]); w.z = cvt_pk_bf16(b[0], b[1]); w.w = cvt_pk_bf16(b[2], b[3]);
        *(u32x4*)(d + 8 * lane) = w;
    }
}

__device__ __forceinline__ void prologue(KArgP A, LAS unsigned char* lds, int gw, int NGW, int wave) {
    int lane_l = lane_id_fresh(); asm volatile("" : "+v"(lane_l)); const int lane = lane_l;
    unsigned char* ws = A->ws;
    LAS float* scr = (LAS float*)(lds + wave * 16384);
    constexpr int I_GU = 16 * 88, I_D = 44 * 32, I_IN = 16 * 96, I_O = 16 * 32;
    constexpr int I_LAYER = 4 * I_GU + 2 * I_D + I_IN + I_O;
    constexpr int I_W = 2 * I_LAYER;
    for (int it = gw; it < I_W; it += NGW) {
        {
            const int l = it / I_LAYER; int r = it - l * I_LAYER;
            unsigned char* wl = ws + WS_W + (size_t)l * W_LAYER;
            const float* gf1 = A->in[6] + l * DM; const float* gmx = A->in[10] + l * DM; const float* gf2 = A->in[23] + l * DM;
            if (r < I_GU) { do_job(A->in[7] + (size_t)l * DM * DFF, DM, DFF, gf1, (bf16_t*)(wl + W_GU1), DM, 1, r, scr, lane); continue; } r -= I_GU;
            if (r < I_GU) { do_job(A->in[8] + (size_t)l * DM * DFF, DM, DFF, gf1, (bf16_t*)(wl + W_GU1), DM, 2, r, scr, lane); continue; } r -= I_GU;
            if (r < I_D)  { do_job(A->in[9] + (size_t)l * DM * DFF, DFF, DM, nullptr, (bf16_t*)(wl + W_D1), LDP, 4, r, scr, lane); continue; } r -= I_D;
            if (r < I_IN) { do_job(A->in[11] + (size_t)l * DM * 3072, DM, 3072, gmx, (bf16_t*)(wl + W_IN), DM, 3, r, scr, lane); continue; } r -= I_IN;
            if (r < I_O)  { do_job(A->in[22] + (size_t)l * DM * DM, DM, DM, nullptr, (bf16_t*)(wl + W_OUT), DM, 0, r, scr, lane); continue; } r -= I_O;
            if (r < I_GU) { do_job(A->in[24] + (size_t)l * DM * DFF, DM, DFF, gf2, (bf16_t*)(wl + W_GU2), DM, 1, r, scr, lane); continue; } r -= I_GU;
            if (r < I_GU) { do_job(A->in[25] + (size_t)l * DM * DFF, DM, DFF, gf2, (bf16_t*)(wl + W_GU2), DM, 2, r, scr, lane); continue; } r -= I_GU;
            do_job(A->in[26] + (size_t)l * DM * DFF, DFF, DM, nullptr, (bf16_t*)(wl + W_D2), LDP, 4, r, scr, lane);
        }
    }
    convert_caches(A, lds, 0, gw, NGW, wave);
    convert_caches(A, lds, 1, gw, NGW, wave);
    float* ssq = (float*)(ws + WS_SSQ);
    bf16_t* xb = (bf16_t*)(ws + WS_XB);
    for (int r0 = gw; r0 < MT; r0 += 2 * NGW) {
        const int r1 = r0 + NGW; const bool has1 = r1 < MT;
        const float* xa = (r0 < MP) ? A->in[0] + (size_t)r0 * DM : A->in[1] + (size_t)(r0 - MP) * DM;
        const float* xc = !has1 ? xa : (r1 < MP) ? A->in[0] + (size_t)r1 * DM : A->in[1] + (size_t)(r1 - MP) * DM;
        f32x4 va[4], vc[4];
#pragma unroll
        for (int j = 0; j < 4; ++j) { va[j] = *(const f32x4*)(xa + 256 * j + 4 * lane); vc[j] = *(const f32x4*)(xc + 256 * j + 4 * lane); }
        float sa = 0.f, sc = 0.f;
#pragma unroll
        for (int j = 0; j < 4; ++j) {
            sa += (va[j][0] * va[j][0] + va[j][1] * va[j][1]) + (va[j][2] * va[j][2] + va[j][3] * va[j][3]);
            sc += (vc[j][0] * vc[j][0] + vc[j][1] * vc[j][1]) + (vc[j][2] * vc[j][2] + vc[j][3] * vc[j][3]);
            u32x2 w; w.x = cvt_pk_bf16(va[j][0], va[j][1]); w.y = cvt_pk_bf16(va[j][2], va[j][3]);
            *(u32x2*)(xb + (size_t)r0 * DM + 256 * j + 4 * lane) = w;
            if (has1) { u32x2 w2; w2.x = cvt_pk_bf16(vc[j][0], vc[j][1]); w2.y = cvt_pk_bf16(vc[j][2], vc[j][3]); *(u32x2*)(xb + (size_t)r1 * DM + 256 * j + 4 * lane) = w2; }
        }
        sa = wave_sum(sa, lane); sc = wave_sum(sc, lane);
        if (lane == 0) { ssq[r0] = sa; if (has1) ssq[r1] = sc; }
    }
    for (int i = gw * 64 + lane; i < 6 * MT; i += NGW * 64) ssq[MT + i] = 0.f;
    float* rope = (float*)(ws + WS_ROPE);
    for (int i = gw * 64 + lane; i < 2112 * 32; i += NGW * 64) {
        const int pos = i >> 5, j = i & 31;
        const double a = (double)((float)pos * (float)ROPE_INV[j]);
        const double kq = __builtin_rint(a * 0.63661977236758134308);
        const double rr = (a - kq * 1.5707963267948966192) - kq * 6.123233995736766e-17;
        const double r2 = rr * rr;
        const double sn = rr * (1.0 + r2 * (-1.0 / 6 + r2 * (1.0 / 120 + r2 * (-1.0 / 5040 + r2 * (1.0 / 362880 + r2 * (-1.0 / 39916800 + r2 * (1.0 / 6227020800.0)))))));
        const double cn = 1.0 + r2 * (-0.5 + r2 * (1.0 / 24 + r2 * (-1.0 / 720 + r2 * (1.0 / 40320 + r2 * (-1.0 / 3628800 + r2 * (1.0 / 479001600 + r2 * (-1.0 / 87178291200.0)))))));
        const int q = ((int)kq) & 3;
        const double c = q == 0 ? cn : q == 1 ? -sn : q == 2 ? -cn : sn;
        const double s = q == 0 ? sn : q == 1 ? cn : q == 2 ? -sn : -cn;
        rope[(size_t)pos * 64 + j] = (float)c; rope[(size_t)pos * 64 + 32 + j] = (float)s;
    }
    if (gw == 0) {
        unsigned* ctl = (unsigned*)(ws + WS_CTL);
        float* cst = (float*)(ws + WS_CTL + 4096);
        if (lane < 16) ctl[lane] = 0u;
        for (int i = lane; i < XCD_BAR_WORDS; i += 64) ((unsigned*)(ws + WS_BAR))[i] = 0u;
        for (int l = 0; l < 2; ++l) {
            const float mqa = wave_max(fabsf(A->in[12][l * 64 + lane]), lane), mka = wave_max(fabsf(A->in[13][l * 64 + lane]), lane);
            const float mqb = wave_max(fabsf(A->in[14][l * 64 + lane]), lane), mkb = wave_max(fabsf(A->in[15][l * 64 + lane]), lane);
            float mb = 0.f;
            for (int i = lane; i < 8 * 257; i += 64) mb = fmaxf(mb, fabsf(A->in[16][l * 8 * 257 + i]));
            mb = wave_max(mb, lane);
            const float d1 = wave_sum(A->in[17][l * 64 + lane] * A->in[18][l * 64 + lane], lane), d2 = wave_sum(A->in[19][l * 64 + lane] * A->in[20][l * 64 + lane], lane);
            const float lam_init = l == 0 ? 0.2f : 0.35550906759096934f;
            if (lane == 0) {
                cst[l * 8 + 0] = LOG2E * (8.0f * mqa * mka + mb);
                cst[l * 8 + 1] = LOG2E * (8.0f * mqb * mkb);
                cst[l * 8 + 2] = expf(d1) - expf(d2) + lam_init;
                cst[l * 8 + 3] = 1.0f - lam_init;
            }
        }
    }
}

__device__ __forceinline__ int swap23(int r) { return (r & 19) | ((r & 4) << 1) | ((r & 8) >> 1); }
__device__ __forceinline__ f32x16 mfma32(bf16x8 a, bf16x8 b, f32x16 c) { return __builtin_amdgcn_mfma_f32_32x32x16_bf16(a, b, c, 0, 0, 0); }
__device__ __forceinline__ bf16x8 pack8(const f32x16& p, int s) {
    u32x4 w; w.x = cvt_pk_bf16(p[8 * s + 0], p[8 * s + 1]); w.y = cvt_pk_bf16(p[8 * s + 2], p[8 * s + 3]); w.z = cvt_pk_bf16(p[8 * s + 4], p[8 * s + 5]); w.w = cvt_pk_bf16(p[8 * s + 6], p[8 * s + 7]);
    return __builtin_bit_cast(bf16x8, w);
}
constexpr int ATT_BUF = 32768, ATT_WAVE = 65536, ATT_BW = 131072 + 64;

__device__ __forceinline__ void attn_a_block(const bf16_t* Qw, const bf16_t* Kb, const bf16_t* Vtb, int ldv, int T, int t_lo, int t_hi, int t_self, int qoff,
                                             bf16_t* Outw, LAS unsigned char* lds, int wave, int lane_in) {
    int lane = lane_in; asm volatile("" : "+v"(lane));
    const int r32 = lane & 31, hi = lane >> 5;
    const bool active = t_lo <= t_hi;
    const LAS float* E = (const LAS float*)(lds + ATT_WAVE + wave * 8192);
    bf16x8 qf[4];
#pragma unroll
    for (int d0 = 0; d0 < 4; ++d0) qf[d0] = active ? *(const bf16x8*)(Qw + (size_t)r32 * 512 + 16 * d0 + 8 * hi) : (bf16x8){0, 0, 0, 0, 0, 0, 0, 0};
    f32x16 o0, o1;
#pragma unroll
    for (int r = 0; r < 16; ++r) { o0[r] = 0.f; o1[r] = 0.f; }
    float l = 0.f;
    const float cfar = E[192];
    const int key_l = 8 * wave + (lane & 7), c8 = lane >> 3;
    const bf16_t* kg = Kb + (size_t)key_l * 512 + 8 * c8;
    const bf16_t* vg = Vtb + (size_t)key_l * ldv + 8 * c8;
    const int koff = ((key_l >> 5) * 4 + (c8 >> 1)) * 1024 + (swap23(key_l & 31) + 32 * (c8 & 1)) * 16;
    const int voff = 8192 + (((c8 >> 2) * 2 + (key_l >> 5)) * 2 + ((c8 >> 1) & 1)) * 1024 + ((key_l & 31) + 32 * (c8 & 1)) * 16;
    constexpr int ABUF = 16384;
    u32x4 skA = *(const u32x4*)kg, svA = *(const u32x4*)vg, skB = skA, svB = svA;
    if (T > 1) { skB = *(const u32x4*)(kg + (size_t)64 * 512); svB = *(const u32x4*)(vg + 64); }
    *(LAS u32x4*)(lds + koff) = skA; *(LAS u32x4*)(lds + voff) = svA;
    __syncthreads();
    int cb = 0;
#define A_STEP(t, LK, LV, WK, WV) do { \
        if ((t) + 2 < T) { LK = *(const u32x4*)(kg + (size_t)((t) + 2) * 64 * 512); LV = *(const u32x4*)(vg + ((t) + 2) * 64); } \
        if ((t) >= t_lo && (t) <= t_hi) { \
            const LAS bf16x8* KF = (const LAS bf16x8*)(lds + cb * ABUF); \
            const LAS bf16x8* VF = KF + 512; \
            _Pragma("unroll") for (int j = 0; j < 2; ++j) { \
                f32x16 sa; \
                const int relbase = 64 * (t_self - (t)) - 32 * j + qoff; \
                if (relbase - 31 >= 128) { _Pragma("unroll") for (int r = 0; r < 16; ++r) sa[r] = cfar; } \
                else { const int bi = relbase + 64 + r32 - 8 * hi - 23; _Pragma("unroll") for (int r = 0; r < 16; ++r) sa[r] = E[bi + 23 - (r & 7) - 16 * (r >> 3)]; } \
                _Pragma("unroll") for (int d0 = 0; d0 < 4; ++d0) sa = mfma32(KF[(j * 4 + d0) * 64 + lane], qf[d0], sa); \
                float ps = 0.f; \
                _Pragma("unroll") for (int r = 0; r < 16; ++r) { sa[r] = fast_exp2(sa[r]); ps += sa[r]; } \
                l += ps; \
                const bf16x8 p0 = pack8(sa, 0), p1 = pack8(sa, 1); \
                o0 = mfma32(VF[((j * 2 + 0) * 2 + 0) * 64 + lane], p0, o0); o0 = mfma32(VF[((j * 2 + 0) * 2 + 1) * 64 + lane], p1, o0); \
                o1 = mfma32(VF[((j * 2 + 1) * 2 + 0) * 64 + lane], p0, o1); o1 = mfma32(VF[((j * 2 + 1) * 2 + 1) * 64 + lane], p1, o1); \
            } \
        } \
        const int nb = cb == 2 ? 0 : cb + 1; \
        if ((t) + 1 < T) { *(LAS u32x4*)(lds + nb * ABUF + koff) = WK; *(LAS u32x4*)(lds + nb * ABUF + voff) = WV; } \
        cb = nb; \
        __syncthreads(); \
    } while (0)
    for (int t = 0; t < T; t += 2) {
        A_STEP(t, skA, svA, skB, svB);
        if (t + 1 < T) A_STEP(t + 1, skB, svB, skA, svA);
    }
#undef A_STEP
    if (active) {
        const int le = lane_id_fresh(), r32e = le & 31, hie = le >> 5;
        l += shx(l, le, 32);
        const float inv = 1.0f / l;
#pragma unroll
        for (int g = 0; g < 4; ++g) {
            u32x2 w0, w1;
            w0.x = cvt_pk_bf16(o0[4 * g] * inv, o0[4 * g + 1] * inv); w0.y = cvt_pk_bf16(o0[4 * g + 2] * inv, o0[4 * g + 3] * inv);
            w1.x = cvt_pk_bf16(o1[4 * g] * inv, o1[4 * g + 1] * inv); w1.y = cvt_pk_bf16(o1[4 * g + 2] * inv, o1[4 * g + 3] * inv);
            *(u32x2*)(Outw + (size_t)r32e * DM + 8 * g + 4 * hie) = w0;
            *(u32x2*)(Outw + (size_t)r32e * DM + 32 + 8 * g + 4 * hie) = w1;
        }
    }
}
__device__ __forceinline__ void attn_b_block(const bf16_t* Qw, const bf16_t* Kb, const bf16_t* Vtb, int ldv, int T, int tlim, float nshift, float lam, float post, const float* gsub,
                                             bf16_t* Outw, LAS unsigned char* lds, int wave, int lane_in) {
    int lane = lane_in; asm volatile("" : "+v"(lane));
    const int r32 = lane & 31, hi = lane >> 5;
    LAS bf16x8* Qs = (LAS bf16x8*)(lds + ATT_WAVE + wave * 8192);
    if (tlim > 0) {
#pragma unroll
        for (int m = 0; m < 2; ++m)
#pragma unroll
            for (int d0 = 0; d0 < 4; ++d0) Qs[(m * 4 + d0) * 64 + lane] = *(const bf16x8*)(Qw + (size_t)r32 * 512 + 64 * m + 16 * d0 + 8 * hi);
    }
    f32x16 o1[4], o2[4];
#pragma unroll
    for (int db = 0; db < 4; ++db)
#pragma unroll
        for (int r = 0; r < 16; ++r) { o1[db][r] = 0.f; o2[db][r] = 0.f; }
    float l1 = 0.f, l2 = 0.f;
    const int key_l = 8 * wave + (lane & 7), c8 = lane >> 3;
    const bf16_t* kg = Kb + (size_t)key_l * 512 + 8 * c8;
    const int koff = ((key_l >> 5) * 8 + (c8 >> 1)) * 1024 + (swap23(key_l & 31) + 32 * (c8 & 1)) * 16;
    const int d_l = 16 * wave + (lane & 7);
    const bf16_t* vg = Vtb + (size_t)d_l * ldv + 8 * c8;
    const int voff = 16384 + (((c8 >> 2) * 4 + (d_l >> 5)) * 2 + ((c8 >> 1) & 1)) * 1024 + ((d_l & 31) + 32 * (c8 & 1)) * 16;
    u32x4 sk0 = *(const u32x4*)kg, sk1 = *(const u32x4*)(kg + 64), sv0 = *(const u32x4*)vg, sv1 = *(const u32x4*)(vg + (size_t)8 * ldv);
    *(LAS u32x4*)(lds + koff) = sk0; *(LAS u32x4*)(lds + koff + 4096) = sk1; *(LAS u32x4*)(lds + voff) = sv0; *(LAS u32x4*)(lds + voff + 128) = sv1;
    __syncthreads();
    for (int t = 0; t < T; ++t) {
        const bool more = t + 1 < T;
        if (more) {
            const bf16_t* kn = kg + (size_t)(t + 1) * 64 * 512; const bf16_t* vn = vg + (t + 1) * 64;
            sk0 = *(const u32x4*)kn; sk1 = *(const u32x4*)(kn + 64); sv0 = *(const u32x4*)vn; sv1 = *(const u32x4*)(vn + (size_t)8 * ldv);
        }
        if (t < tlim) {
            const LAS bf16x8* KF = (const LAS bf16x8*)(lds + (t & 1) * ATT_BUF);
            const LAS bf16x8* VF = KF + 1024;
#pragma unroll
            for (int j = 0; j < 2; ++j) {
                bf16x8 pa[2], pb[2];
                {
                    f32x16 sa;
#pragma unroll
                    for (int r = 0; r < 16; ++r) sa[r] = nshift;
#pragma unroll
                    for (int d0 = 0; d0 < 4; ++d0) sa = mfma32(KF[((j * 2 + 0) * 4 + d0) * 64 + lane], Qs[d0 * 64 + lane], sa);
                    float ps = 0.f;
#pragma unroll
                    for (int r = 0; r < 16; ++r) { sa[r] = fast_exp2(sa[r]); ps += sa[r]; }
                    l1 += ps; pa[0] = pack8(sa, 0); pa[1] = pack8(sa, 1);
                }
                {
                    f32x16 sa;
#pragma unroll
                    for (int r = 0; r < 16; ++r) sa[r] = nshift;
#pragma unroll
                    for (int d0 = 0; d0 < 4; ++d0) sa = mfma32(KF[((j * 2 + 1) * 4 + d0) * 64 + lane], Qs[(4 + d0) * 64 + lane], sa);
                    float ps = 0.f;
#pragma unroll
                    for (int r = 0; r < 16; ++r) { sa[r] = fast_exp2(sa[r]); ps += sa[r]; }
                    l2 += ps; pb[0] = pack8(sa, 0); pb[1] = pack8(sa, 1);
                }
#pragma unroll
                for (int db = 0; db < 4; ++db)
#pragma unroll
                    for (int s = 0; s < 2; ++s) {
                        const bf16x8 vf = VF[((j * 4 + db) * 2 + s) * 64 + lane];
                        o1[db] = mfma32(vf, pa[s], o1[db]); o2[db] = mfma32(vf, pb[s], o2[db]);
                    }
            }
        }
        if (more) {
            LAS unsigned char* nb = lds + ((t + 1) & 1) * ATT_BUF;
            *(LAS u32x4*)(nb + koff) = sk0; *(LAS u32x4*)(nb + koff + 4096) = sk1; *(LAS u32x4*)(nb + voff) = sv0; *(LAS u32x4*)(nb + voff + 128) = sv1;
        }
        __syncthreads();
    }
    if (tlim > 0) {
        const int le = lane_id_fresh(), r32e = le & 31, hie = le >> 5;
        l1 += shx(l1, le, 32); l2 += shx(l2, le, 32);
        const float i1 = 1.0f / l1, i2 = lam / l2;
        float ss = 0.f;
#pragma unroll
        for (int db = 0; db < 4; ++db)
#pragma unroll
            for (int r = 0; r < 16; ++r) { const float v = o1[db][r] * i1 - o2[db][r] * i2; o1[db][r] = v; ss += v * v; }
        ss += shx(ss, le, 32);
        const float rr = rsqrtf(ss * (1.0f / 128.0f) + EPS) * post;
#pragma unroll
        for (int db = 0; db < 4; ++db)
#pragma unroll
            for (int g = 0; g < 4; ++g) {
                const int d = 32 * db + 8 * g + 4 * hie;
                const f32x4 gs = *(const f32x4*)(gsub + d);
                u32x2 w; w.x = cvt_pk_bf16(o1[db][4 * g] * rr * gs[0], o1[db][4 * g + 1] * rr * gs[1]); w.y = cvt_pk_bf16(o1[db][4 * g + 2] * rr * gs[2], o1[db][4 * g + 3] * rr * gs[3]);
                *(u32x2*)(Outw + (size_t)r32e * DM + d) = w;
            }
    }
}
__device__ __forceinline__ void attn_bs_block(KArgP A, int l, int b, int h, float nshift, float lam, float post, const float* gsub, LAS unsigned char* lds, int wave, int lane_in) {
    int lane = lane_in; asm volatile("" : "+v"(lane));
    unsigned char* ws = A->ws;
    const int lb = l * 32 + b;
    constexpr int T = 33;
    const float* ck = A->in[4] + (size_t)lb * 2048 * 512 + h * 128;
    const float* cv = A->in[5] + (size_t)lb * 2048 * 512 + h * 128;
    const bf16_t* nk = (const bf16_t*)(ws + WS_KSB) + ((size_t)lb * KSB_ROWS + 2048) * 512 + h * 128;
    const bf16_t* nv = (const bf16_t*)(ws + WS_VSB) + ((size_t)lb * 512 + h * 128) * KSB_ROWS + 2048;
    const int li = (wave - 2) * 64 + lane;
#define BS_FILL(t) do { \
        LAS unsigned char* fb = lds + ((t) & 1) * ATT_BUF; \
        if ((t) < 32) { \
            _Pragma("unroll") for (int i = 0; i < 3; ++i) { const int ci = li + 384 * i; \
                if (ci < 1024) { const int key = ci >> 4, c16 = ci & 15, c8 = c16 & 7; \
                    const float* src = ck + (size_t)(64 * (t) + key) * 512 + 8 * c16; \
                    const f32x4 a = *(const f32x4*)src, c = *(const f32x4*)(src + 4); \
                    u32x4 w; w.x = cvt_pk_bf16(a[0], a[1]); w.y = cvt_pk_bf16(a[2], a[3]); w.z = cvt_pk_bf16(c[0], c[1]); w.w = cvt_pk_bf16(c[2], c[3]); \
                    *(LAS u32x4*)(fb + ((key >> 5) * 8 + (c16 >> 3) * 4 + (c8 >> 1)) * 1024 + (swap23(key & 31) + 32 * (c8 & 1)) * 16) = w; } } \
            if (li < 256) { const int g = li >> 5, d4 = li & 31; \
                f32x4 r[8]; \
                _Pragma("unroll") for (int kk = 0; kk < 8; ++kk) r[kk] = *(const f32x4*)(cv + (size_t)(64 * (t) + 8 * g + kk) * 512 + 4 * d4); \
                _Pragma("unroll") for (int i = 0; i < 4; ++i) { const int d = 4 * d4 + i; \
                    u32x4 w; w.x = cvt_pk_bf16(r[0][i], r[1][i]); w.y = cvt_pk_bf16(r[2][i], r[3][i]); w.z = cvt_pk_bf16(r[4][i], r[5][i]); w.w = cvt_pk_bf16(r[6][i], r[7][i]); \
                    *(LAS u32x4*)(fb + 16384 + (((g >> 2) * 4 + (d >> 5)) * 2 + ((g >> 1) & 1)) * 1024 + ((d & 31) + 32 * (g & 1)) * 16) = w; } } \
        } else { \
            _Pragma("unroll") for (int i = 0; i < 3; ++i) { const int ci = li + 384 * i; \
                if (ci < 1024) { const int key = ci >> 4, c16 = ci & 15, c8 = c16 & 7; \
                    const u32x4 w = *(const u32x4*)(nk + (size_t)key * 512 + 8 * c16); \
                    *(LAS u32x4*)(fb + ((key >> 5) * 8 + (c16 >> 3) * 4 + (c8 >> 1)) * 1024 + (swap23(key & 31) + 32 * (c8 & 1)) * 16) = w; \
                    const int d = ci >> 3, g = ci & 7; \
                    const u32x4 v = *(const u32x4*)(nv + (size_t)d * KSB_ROWS + 8 * g); \
                    *(LAS u32x4*)(fb + 16384 + (((g >> 2) * 4 + (d >> 5)) * 2 + ((g >> 1) & 1)) * 1024 + ((d & 31) + 32 * (g & 1)) * 16) = v; } } \
        } \
    } while (0)
    if (wave >= 2) {
        BS_FILL(0);
        __syncthreads();
        for (int t = 0; t < T; ++t) {
            if (t + 1 < T) BS_FILL(t + 1);
            __syncthreads();
        }
    } else {
        const int r32 = lane & 31, hi = lane >> 5;
        const int row0 = MP + b * 64 + 32 * wave;
        const bf16_t* Qw = (const bf16_t*)(ws + WS_QB) + (size_t)row0 * 512 + h * 128;
        LAS bf16x8* Qs = (LAS bf16x8*)(lds + ATT_WAVE + wave * 8192);
#pragma unroll
        for (int m = 0; m < 2; ++m)
#pragma unroll
            for (int d0 = 0; d0 < 4; ++d0) Qs[(m * 4 + d0) * 64 + lane] = *(const bf16x8*)(Qw + (size_t)r32 * 512 + 64 * m + 16 * d0 + 8 * hi);
        f32x16 o1[4], o2[4];
#pragma unroll
        for (int db = 0; db < 4; ++db)
#pragma unroll
            for (int r = 0; r < 16; ++r) { o1[db][r] = 0.f; o2[db][r] = 0.f; }
        float l1 = 0.f, l2 = 0.f;
        __syncthreads();
        for (int t = 0; t < T; ++t) {
            const LAS bf16x8* KF = (const LAS bf16x8*)(lds + (t & 1) * ATT_BUF);
            const LAS bf16x8* VF = KF + 1024;
#pragma unroll
            for (int j = 0; j < 2; ++j) {
                bf16x8 pa[2], pb[2];
                {
                    f32x16 sa;
#pragma unroll
                    for (int r = 0; r < 16; ++r) sa[r] = nshift;
#pragma unroll
                    for (int d0 = 0; d0 < 4; ++d0) sa = mfma32(KF[((j * 2 + 0) * 4 + d0) * 64 + lane], Qs[d0 * 64 + lane], sa);
                    float ps = 0.f;
#pragma unroll
                    for (int r = 0; r < 16; ++r) { sa[r] = fast_exp2(sa[r]); ps += sa[r]; }
                    l1 += ps; pa[0] = pack8(sa, 0); pa[1] = pack8(sa, 1);
                }
                {
                    f32x16 sa;
#pragma unroll
                    for (int r = 0; r < 16; ++r) sa[r] = nshift;
#pragma unroll
                    for (int d0 = 0; d0 < 4; ++d0) sa = mfma32(KF[((j * 2 + 1) * 4 + d0) * 64 + lane], Qs[(4 + d0) * 64 + lane], sa);
                    float ps = 0.f;
#pragma unroll
                    for (int r = 0; r < 16; ++r) { sa[r] = fast_exp2(sa[r]); ps += sa[r]; }
                    l2 += ps; pb[0] = pack8(sa, 0); pb[1] = pack8(sa, 1);
                }
#pragma unroll
                for (int db = 0; db < 4; ++db)
#pragma unroll
                    for (int s = 0; s < 2; ++s) {
                        const bf16x8 vf = VF[((j * 4 + db) * 2 + s) * 64 + lane];
                        o1[db] = mfma32(vf, pa[s], o1[db]); o2[db] = mfma32(vf, pb[s], o2[db]);
                    }
            }
            __syncthreads();
        }
        const int le = lane_id_fresh(), r32e = le & 31, hie = le >> 5;
        l1 += shx(l1, le, 32); l2 += shx(l2, le, 32);
        const float i1 = 1.0f / l1, i2 = lam / l2;
        float ss = 0.f;
#pragma unroll
        for (int db = 0; db < 4; ++db)
#pragma unroll
            for (int r = 0; r < 16; ++r) { const float v = o1[db][r] * i1 - o2[db][r] * i2; o1[db][r] = v; ss += v * v; }
        ss += shx(ss, le, 32);
        const float rr = rsqrtf(ss * (1.0f / 128.0f) + EPS) * post;
        bf16_t* Outw = (bf16_t*)(ws + WS_O) + (size_t)row0 * DM + 512 + h * 128;
#pragma unroll
        for (int db = 0; db < 4; ++db)
#pragma unroll
            for (int g = 0; g < 4; ++g) {
                const int d = 32 * db + 8 * g + 4 * hie;
                const f32x4 gs = *(const f32x4*)(gsub + d);
                u32x2 w; w.x = cvt_pk_bf16(o1[db][4 * g] * rr * gs[0], o1[db][4 * g + 1] * rr * gs[1]); w.y = cvt_pk_bf16(o1[db][4 * g + 2] * rr * gs[2], o1[db][4 * g + 3] * rr * gs[3]);
                *(u32x2*)(Outw + (size_t)r32e * DM + d) = w;
            }
    }
#undef BS_FILL
}
constexpr int U_BS = 128, U_BP = 512, U_AP = 1024, U_AS = 256, U_B = U_BS + U_BP, U_ALL = U_B + U_AP + U_AS;
__device__ __forceinline__ void attn_phase(KArgP A, int l, LAS unsigned char* lds, int wave, int cidx) {
    unsigned char* ws = A->ws;
    unsigned* ctr = (unsigned*)(ws + WS_CTL) + cidx;
    const float* cst = (const float*)(ws + WS_CTL + 4096) + l * 8;
#define SGPR_F(x) __builtin_bit_cast(float, __builtin_amdgcn_readfirstlane(__builtin_bit_cast(int, (x))))
    const float shA = SGPR_F(cst[0]), shB = SGPR_F(cst[1]), lam = SGPR_F(cst[2]), post = SGPR_F(cst[3]);
#undef SGPR_F
    volatile LAS int* bw = (volatile LAS int*)(lds + ATT_BW);
    const bf16_t* QA = (const bf16_t*)(ws + WS_QA); const bf16_t* QB = (const bf16_t*)(ws + WS_QB);
    bf16_t* O = (bf16_t*)(ws + WS_O);
    const float* bias = A->in[16] + (size_t)l * 8 * 257;
    const float* gsub = A->in[21] + l * 128;
    for (;;) {
        int lane_l = lane_id_fresh(); asm volatile("" : "+v"(lane_l)); const int lane = lane_l;
        __syncthreads();
        if (wave == 0 && lane == 0) bw[0] = (int)atomicAdd(ctr, 1u);
        __syncthreads();
        const int uid = __builtin_amdgcn_readfirstlane(bw[0]);
        if (uid >= U_ALL) break;
        if (uid < U_BS) {
            attn_bs_block(A, l, uid >> 2, uid & 3, -shB, lam, post, gsub, lds, wave, lane);
        } else if (uid < U_B) {
            int b, h, T, tlim, row0, ldv; const bf16_t* K; const bf16_t* Vt;
            if (uid < U_BS) { b = uid >> 2; h = uid & 3; T = 33; tlim = wave < 2 ? 33 : 0; row0 = MP + b * 64 + 32 * (wave & 1); ldv = KSB_ROWS;
                K = (const bf16_t*)(ws + WS_KSB) + (size_t)(l * 32 + b) * KSB_ROWS * 512 + h * 128;
                Vt = (const bf16_t*)(ws + WS_VSB) + ((size_t)(l * 32 + b) * 512 + h * 128) * KSB_ROWS; }
            else { const int v = uid - U_BS, qb = 7 - (v >> 6), w = v & 63; b = w >> 2; h = w & 3; T = 4 * qb + 4; tlim = 4 * qb + (wave >> 1) + 1; row0 = b * 2048 + 256 * qb + 32 * wave; ldv = 2048;
                K = (const bf16_t*)(ws + WS_KBP) + (size_t)b * 2048 * 512 + h * 128;
                Vt = (const bf16_t*)(ws + WS_VBP) + ((size_t)b * 512 + h * 128) * 2048; }
            attn_b_block(QB + (size_t)row0 * 512 + h * 128, K, Vt, ldv, T, tlim, -shB, lam, post, gsub, O + (size_t)row0 * DM + 512 + h * 128, lds, wave, lane);
        } else {
            int b, h, T, t_lo, t_hi, t_self, row0, ldv; const bf16_t* K; const bf16_t* Vt;
            if (uid >= U_B + U_AS) { const int v = uid - U_B - U_AS, cq = 7 - (v >> 7), w = v & 127; b = w >> 3; h = w & 7;
                const int kc0 = cq >= 2 ? 4 * cq - 8 : 0, cw = 4 * cq + (wave >> 1);
                T = 4 * cq + 4 - kc0; t_self = cw - kc0; t_hi = t_self; t_lo = cw - 8 - kc0 > 0 ? cw - 8 - kc0 : 0; row0 = b * 2048 + 256 * cq + 32 * wave; ldv = 2048;
                K = (const bf16_t*)(ws + WS_KAP) + ((size_t)b * 2048 + 64 * kc0) * 512 + h * 64;
                Vt = (const bf16_t*)(ws + WS_VAP) + ((size_t)b * 512 + h * 64) * 2048 + 64 * kc0; }
            else { const int v = uid - U_B; b = v >> 3; h = v & 7; T = 9; t_self = 8; t_lo = wave < 2 ? 0 : 1; t_hi = wave < 2 ? 8 : 0; row0 = MP + b * 64 + 32 * (wave & 1); ldv = KSA_ROWS;
                K = (const bf16_t*)(ws + WS_KSA) + (size_t)(l * 32 + b) * KSA_ROWS * 512 + h * 64;
                Vt = (const bf16_t*)(ws + WS_VSA) + ((size_t)(l * 32 + b) * 512 + h * 64) * KSA_ROWS; }
            LAS float* E = (LAS float*)(lds + ATT_WAVE + wave * 8192);
#pragma unroll
            for (int j = 0; j < 5; ++j) { const int i = lane + 64 * j; int rel = i - 64; rel = rel < -128 ? -128 : (rel > 128 ? 128 : rel); E[i] = LOG2E * bias[h * 257 + rel + 128] - shA; }
            attn_a_block(QA + (size_t)row0 * 512 + h * 64, K, Vt, ldv, T, t_lo, t_hi, t_self, 32 * (wave & 1), O + (size_t)row0 * DM + h * 64, lds, wave, lane);
        }
    }
}

__device__ __forceinline__ bool in_phase(int p) { KArgP k = (KArgP)__builtin_amdgcn_kernarg_segment_ptr(); asm volatile("" : "+s"(k)); return k->ph_lo <= p && p < k->ph_hi; }
__global__ void __launch_bounds__(512, 2) mega_fwd(Args KA) {
    extern __shared__ __attribute__((aligned(16))) unsigned char lds_raw[];
    LAS unsigned char* lds = (LAS unsigned char*)lds_raw;
    const int tid = threadIdx.x, wave = __builtin_amdgcn_readfirstlane(tid >> 6);
    const int G = gridDim.x, bx = blockIdx.x;
    const int vcu = (G % 8 == 0) ? (bx % 8) * (G / 8) + bx / 8 : bx;
    (void)KA;
    if (tid == 0) { ((volatile LAS unsigned*)(lds + ATT_BW + 64))[0] = 0u; ((volatile LAS unsigned*)(lds + ATT_BW + 64))[1] = 0u; ((volatile LAS unsigned*)(lds + ATT_BW + 64))[2] = (unsigned)bx; }
    __syncthreads();
#define FRESH_KAP(name) KArgP name = (KArgP)__builtin_amdgcn_kernarg_segment_ptr(); asm volatile("" : "+s"(name))
#define IN_PH(p) in_phase(p)
#define SEAM(p) do { FRESH_KAP(ks_); if (ks_->coop && (p) + 1 < ks_->ph_hi) { XcdBarrier xb_; xb_.bar = (unsigned*)(ks_->ws + WS_BAR); xb_.x = xb_xcc_id(); xb_.st = (volatile LAS unsigned*)(lds + ATT_BW + 64); xcd_barrier(xb_); } } while (0)
#define KARGS() KArgP kap = (KArgP)__builtin_amdgcn_kernarg_segment_ptr(); asm volatile("" : "+s"(kap)); unsigned char* ws = kap->ws; float* out = kap->out; \
    float* ssq = (float*)(ws + WS_SSQ); bf16_t* xb = (bf16_t*)(ws + WS_XB); bf16_t* ab = (bf16_t*)(ws + WS_A); unsigned char* wl = ws + WS_W + (size_t)l * W_LAYER; (void)ssq; (void)xb; (void)ab; (void)wl; (void)out; \
    const int cx = __builtin_amdgcn_readfirstlane((int)((volatile LAS unsigned*)(lds + ATT_BW + 64))[2])
    if (IN_PH(0)) {
        KArgP kap = (KArgP)__builtin_amdgcn_kernarg_segment_ptr(); asm volatile("" : "+s"(kap));
        prologue(kap, lds, vcu * 8 + wave, G * 8, wave);
#ifdef PROBE_PRO2
        prologue(kap, lds, vcu * 8 + wave, G * 8, wave);
#endif
        { FRESH_KAP(ks_); if (ks_->coop && 1 < ks_->ph_hi) { cg::this_grid().sync();
            if (tid == 0) { unsigned* bar_ = (unsigned*)(ks_->ws + WS_BAR); const unsigned x_ = xb_xcc_id(); const unsigned r_ = xb_add(&bar_[XB_XCNT(x_)], 1u);
                if (G == 256 && r_ < 32u && x_ < 8u) ((volatile LAS unsigned*)(lds + ATT_BW + 64))[2] = r_ * 8u + x_; }
            __syncthreads(); } }
    }
#pragma unroll 1
    for (int l = 0; l < 2; ++l) {
        const int p0 = 1 + 7 * l;
        if (IN_PH(p0 + 0)) {
            KARGS();
            pg8::Gemm g{xb, (const bf16_t*)(wl + W_GU1), MT, 2 * DFF, DM, DM, 0};
            pg8::StaticOrder S; S.init(MT, 2 * DFF, G, cx);
            EpiSwiGLU E{ab, ssq + (size_t)(3 * l) * MT};
            pg8::gemm_phase<EpiSwiGLU, pg8::StaticOrder, true, true>(lds, g, S, E, wave);
#ifdef PROBE_UP2
            pg8::gemm_phase<EpiSwiGLU, pg8::StaticOrder, true, true>(lds, g, S, E, wave);
#endif
            SEAM(p0 + 0);
        }
        if (IN_PH(p0 + 1)) {
            KARGS();
            pg8::Gemm g{ab, (const bf16_t*)(wl + W_D1), MT, DM, DFF, LDP, 2};
            pg8::TailSplitOrder S; S.init(MT, DM, G, cx, 0, DOWN_WGM);
            EpiResid E{kap->in[0], kap->in[1], out, xb, ssq + (size_t)(3 * l + 1) * MT, 0.5f, 1, 0};
            pg8::gemm_phase<EpiResid, pg8::TailSplitOrder, true, true>(lds, g, S, E, wave);
            SEAM(p0 + 1);
        }
        if (IN_PH(p0 + 2)) {
            {
                KARGS();
                pg8::Gemm g{xb, (const bf16_t*)(wl + W_IN), MT, 2048, DM, DM, 0};
                pg8::TailSplitOrder S; S.init(MT, 2048, G, cx);
                EpiQK E{ssq + (size_t)(3 * l + 1) * MT, ws, out, kap, l};
                pg8::gemm_phase<EpiQK, pg8::TailSplitOrder, true, true>(lds, g, S, E, wave);
#ifdef PROBE_QK2
                pg8::gemm_phase<EpiQK, pg8::TailSplitOrder, true, true>(lds, g, S, E, wave);
#endif
            }
            {
                KARGS();
                pg8::Gemm g{(const bf16_t*)(wl + W_IN) + (size_t)2048 * DM, xb, 1024, MT, DM, DM, 0};
                pg8::TailSplitOrder S; S.init(1024, MT, G, cx);
                EpiVt E{ssq + (size_t)(3 * l + 1) * MT, ws, out, l};
                pg8::gemm_phase<EpiVt, pg8::TailSplitOrder, true, true>(lds, g, S, E, wave);
#ifdef PROBE_VT2
                pg8::gemm_phase<EpiVt, pg8::TailSplitOrder, true, true>(lds, g, S, E, wave);
#endif
            }
            SEAM(p0 + 2);
        }
        if (IN_PH(p0 + 3)) {
            KArgP kap = (KArgP)__builtin_amdgcn_kernarg_segment_ptr(); asm volatile("" : "+s"(kap));
            attn_phase(kap, l, lds, wave, l);
#ifdef PROBE_ATTN2
            attn_phase(kap, l, lds, wave, 2 + l);
#endif
            SEAM(p0 + 3);
        }
        if (IN_PH(p0 + 4)) {
            KARGS();
            pg8::Gemm g{(const bf16_t*)(ws + WS_O), (const bf16_t*)(wl + W_OUT), MT, DM, DM, DM, 0};
            pg8::TailSplitOrder S; S.init(MT, DM, G, cx);
            EpiResid E{out, out + (size_t)MP * DM, out, xb, ssq + (size_t)(3 * l + 2) * MT, 1.0f, 1, 0};
            pg8::gemm_phase<EpiResid, pg8::TailSplitOrder, true, true>(lds, g, S, E, wave);
            SEAM(p0 + 4);
        }
        if (IN_PH(p0 + 5)) {
            KARGS();
            pg8::Gemm g{xb, (const bf16_t*)(wl + W_GU2), MT, 2 * DFF, DM, DM, 0};
            pg8::StaticOrder S; S.init(MT, 2 * DFF, G, cx);
            EpiSwiGLU E{ab, ssq + (size_t)(3 * l + 2) * MT};
            pg8::gemm_phase<EpiSwiGLU, pg8::StaticOrder, true, true>(lds, g, S, E, wave);
            SEAM(p0 + 5);
        }
        if (IN_PH(p0 + 6)) {
            KARGS();
            pg8::Gemm g{ab, (const bf16_t*)(wl + W_D2), MT, DM, DFF, LDP, 2};
            pg8::TailSplitOrder S; S.init(MT, DM, G, cx, 0, DOWN_WGM);
            EpiResid E{out, out + (size_t)MP * DM, out, xb, ssq + (size_t)(3 * l + 3) * MT, 0.5f, 1, l == 1 ? 1 : 0};
            pg8::gemm_phase<EpiResid, pg8::TailSplitOrder, true, true>(lds, g, S, E, wave);
            SEAM(p0 + 6);
        }
    }
}

#ifndef N_LAUNCH_MODE_GUARD_
#define N_LAUNCH_MODE_GUARD_
#endif
#ifndef N_LAUNCH_MODE
#define N_LAUNCH_MODE 0
#endif
extern "C" void kernel_launch(void* const* d_in, const int* in_sizes, int n_in, void* d_out, int out_size, void* d_ws, size_t ws_size, hipStream_t stream) {
    static int grid = 0;
    if (grid == 0) {
        if (n_in != 27 || ws_size < WS_END) { fprintf(stderr, "kernel_launch: unexpected inputs (n_in %d, ws %zu)\n", n_in, ws_size); grid = -1; return; }
        int dev = 0, cus = 0, per_cu = 0;
        hipGetDevice(&dev);
        hipDeviceGetAttribute(&cus, hipDeviceAttributeMultiprocessorCount, dev);
        hipFuncSetAttribute((const void*)mega_fwd, hipFuncAttributeMaxDynamicSharedMemorySize, LDS_BYTES);
        hipOccupancyMaxActiveBlocksPerMultiprocessor(&per_cu, (const void*)mega_fwd, 512, LDS_BYTES);
        (void)hipGetLastError();
        if (per_cu < 1) per_cu = 1;
        grid = cus;
        if (grid != 256) fprintf(stderr, "kernel_launch: note: %d CUs\n", grid);
    }
    if (grid < 0) return;
    Args a{};
    for (int i = 0; i < 27; ++i) a.in[i] = (const float*)d_in[i];
    a.out = (float*)d_out; a.ws = (unsigned char*)d_ws;
#if N_LAUNCH_MODE == 1
    for (int ph = 0; ph < NPHASE; ++ph) {
        a.ph_lo = ph; a.ph_hi = ph + 1; a.coop = 0;
        hipLaunchKernelGGL(mega_fwd, dim3(grid), dim3(512), LDS_BYTES, stream, a);
    }
#else
    a.ph_lo = 0; a.ph_hi = NPHASE; a.coop = 1;
    void* args[] = {&a};
    hipError_t e = hipLaunchCooperativeKernel((const void*)mega_fwd, dim3(grid), dim3(512), args, LDS_BYTES, stream);
    if (e != hipSuccess) fprintf(stderr, "cooperative launch failed: %s (grid %d)\n", hipGetErrorString(e), grid);
#endif
}
```
